# Optimizing an MI355X kernel written in HIP

```python
import math
import jax, jax.numpy as jnp
from jax import lax
import numpy as np

D_MODEL = 1024
BATCH = 16
SEQ = 2048
DEPTH = 1

N_META = 16
A_HEADS = 4
A_DK = 64
A_DV = 2 * A_DK
B_HEADS = 4
B_DQ = 128
B_DC = 256
B_DV = 128
IDX_HEADS = 8
IDX_DIM = 64
IDX_TOPK_MAX = 256
REL_BUCKETS = 32
REL_MAX_DIST = 128
N_BIAS_HEADS = A_HEADS + B_HEADS
D_FF = 2816
Q_BLOCK = 128
EPS = 1e-6
A_SCALE = A_DK ** -0.5
B_SCALE = B_DC ** -0.5

IN_SIZES = (
    A_HEADS * 2 * A_DK,
    A_HEADS * 2 * A_DK,
    A_HEADS * A_DV,
    B_HEADS * B_DQ,
    B_DC,
    IDX_HEADS * IDX_DIM,
    IDX_DIM,
    IDX_HEADS,
)
N_IN = sum(IN_SIZES)
IN_SPLITS = [int(v) for v in np.cumsum(IN_SIZES)[:-1]]
D_MIX = A_HEADS * A_DV + B_HEADS * B_DV

kernel_name = 'hymba_diffattn_dsa_macaron'


def rmsnorm(x, g):
    xf = x.astype(jnp.float32)
    y = xf * lax.rsqrt(jnp.mean(xf * xf, axis=-1, keepdims=True) + EPS)
    return (y * g.astype(jnp.float32)).astype(x.dtype)


def swiglu(x, w_gate, w_up, w_down):
    return (jax.nn.silu(x @ w_gate) * (x @ w_up)) @ w_down


def rel_bucket(q_pos, k_pos):
    max_exact = REL_BUCKETS // 2
    n = jnp.maximum(q_pos - k_pos, 0)
    nf = jnp.maximum(n, 1).astype(jnp.float32)
    large = max_exact + (jnp.log(nf / max_exact) / math.log(REL_MAX_DIST / max_exact)
                         * (REL_BUCKETS - max_exact)).astype(jnp.int32)
    large = jnp.minimum(large, REL_BUCKETS - 1)
    return jnp.where(n < max_exact, n, large)


def diff_attention(q, k, v, lam, bias_a, subln_g, lam_init):
    bsz, length = q.shape[0], q.shape[1]
    outs = []
    for start in range(0, length, Q_BLOCK):
        stop = min(start + Q_BLOCK, length)
        q_pos = jnp.arange(start, stop)
        k_pos = jnp.arange(stop)
        bias = bias_a[rel_bucket(q_pos[:, None], k_pos[None, :])].transpose(2, 0, 1)
        s = jnp.einsum('bqhmd,bkhmd->bhmqk', q[:, start:stop], k[:, :stop]).astype(jnp.float32)
        s = s * A_SCALE + bias[None, :, None].astype(jnp.float32)
        s = jnp.where(k_pos[None, :] <= q_pos[:, None], s, -jnp.inf)
        p = jax.nn.softmax(s, axis=-1)
        a = p[:, :, 0] - lam * p[:, :, 1]
        outs.append(jnp.einsum('bhqk,bkhd->bqhd', a.astype(v.dtype), v[:, :stop]))
    o = jnp.concatenate(outs, axis=1)
    o = rmsnorm(o, subln_g) * (1.0 - lam_init)
    return o.reshape(bsz, length, A_HEADS * A_DV)


def dsa_attention(q_lat, c, iq, ik, iw, w_uv, bias_b, topk):
    bsz, length = q_lat.shape[0], q_lat.shape[1]
    gather = jax.vmap(lambda cb, ib: cb[ib])
    outs = []
    for start in range(0, length, Q_BLOCK):
        stop = min(start + Q_BLOCK, length)
        q_pos = jnp.arange(start, stop)
        k_pos = jnp.arange(stop)
        dots = jnp.einsum('bqhd,bkd->bqhk', iq[:, start:stop], ik[:, :stop]).astype(jnp.float32)
        w = iw[:, start:stop].astype(jnp.float32) * (IDX_HEADS ** -0.5)
        score = jnp.einsum('bqh,bqhk->bqk', w, jax.nn.relu(dots * (IDX_DIM ** -0.5)))
        score = jnp.where(k_pos[None, None, :] <= q_pos[None, :, None], score, -jnp.inf)
        _, sel = lax.top_k(score, min(topk, stop))
        valid = sel <= q_pos[None, :, None]
        g = gather(c, sel)
        bias = bias_b[rel_bucket(q_pos[None, :, None], sel)].transpose(0, 3, 1, 2)
        s = jnp.einsum('bqhc,bqkc->bhqk', q_lat[:, start:stop], g).astype(jnp.float32)
        s = s * B_SCALE + bias.astype(jnp.float32)
        s = jnp.where(valid[:, None], s, -jnp.inf)
        p = jax.nn.softmax(s, axis=-1)
        o_lat = jnp.einsum('bhqk,bqkc->bqhc', p.astype(g.dtype), g)
        outs.append(jnp.einsum('bqhc,hcd->bqhd', o_lat, w_uv))
    o = jnp.concatenate(outs, axis=1)
    return o.reshape(bsz, length, B_HEADS * B_DV)


def setup_inputs(seed: int = 0) -> dict:
    key = jax.random.key(seed)
    ks = jax.random.split(key, 32)
    f32 = jnp.float32

    def nrm(k, shape, scale):
        return jax.random.normal(k, shape, f32) * scale

    def gain(k, shape):
        return 1.0 + 0.02 * jax.random.normal(k, shape, f32)

    L = DEPTH
    return {
        'x': nrm(ks[0], (BATCH, SEQ, D_MODEL), 1.0),
        'meta_tokens': nrm(ks[1], (N_META, D_MODEL), 1.0),
        'rel_bias': nrm(ks[2], (REL_BUCKETS, N_BIAS_HEADS), 0.1),
        'ffn1_norm': gain(ks[3], (L, D_MODEL)),
        'ffn1_w_gate': nrm(ks[4], (L, D_MODEL, D_FF), D_MODEL ** -0.5),
        'ffn1_w_up': nrm(ks[5], (L, D_MODEL, D_FF), D_MODEL ** -0.5),
        'ffn1_w_down': nrm(ks[6], (L, D_FF, D_MODEL), D_FF ** -0.5),
        'mix_norm': gain(ks[7], (L, D_MODEL)),
        'w_in': nrm(ks[8], (L, D_MODEL, N_IN), D_MODEL ** -0.5),
        'a_q_norm': gain(ks[9], (L, A_DK)),
        'a_k_norm': gain(ks[10], (L, A_DK)),
        'a_lambda_q1': nrm(ks[11], (L, A_DK), 0.1),
        'a_lambda_k1': nrm(ks[12], (L, A_DK), 0.1),
        'a_lambda_q2': nrm(ks[13], (L, A_DK), 0.1),
        'a_lambda_k2': nrm(ks[14], (L, A_DK), 0.1),
        'a_subln': gain(ks[15], (L, A_DV)),
        'b_kv_norm': gain(ks[16], (L, B_DC)),
        'b_w_uk': nrm(ks[17], (L, B_HEADS, B_DQ, B_DC), B_DQ ** -0.5),
        'b_q_norm': gain(ks[18], (L, B_DC)),
        'b_w_uv': nrm(ks[19], (L, B_HEADS, B_DC, B_DV), B_DC ** -0.5),
        'w_out': nrm(ks[20], (L, D_MIX, D_MODEL), D_MIX ** -0.5),
        'ffn2_norm': gain(ks[21], (L, D_MODEL)),
        'ffn2_w_gate': nrm(ks[22], (L, D_MODEL, D_FF), D_MODEL ** -0.5),
        'ffn2_w_up': nrm(ks[23], (L, D_MODEL, D_FF), D_MODEL ** -0.5),
        'ffn2_w_down': nrm(ks[24], (L, D_FF, D_MODEL), D_FF ** -0.5),
    }


def reference(x, meta_tokens, rel_bias, ffn1_norm, ffn1_w_gate, ffn1_w_up, ffn1_w_down,
              mix_norm, w_in, a_q_norm, a_k_norm, a_lambda_q1, a_lambda_k1, a_lambda_q2,
              a_lambda_k2, a_subln, b_kv_norm, b_w_uk, b_q_norm, b_w_uv, w_out,
              ffn2_norm, ffn2_w_gate, ffn2_w_up, ffn2_w_down):
    bsz, seq = x.shape[0], x.shape[1]
    topk = min(IDX_TOPK_MAX, seq // 4)
    meta = jnp.broadcast_to(meta_tokens.astype(x.dtype)[None], (bsz, N_META, D_MODEL))
    h = jnp.concatenate([meta, x], axis=1)
    length = h.shape[1]
    bias_a = rel_bias[:, :A_HEADS]
    bias_b = rel_bias[:, A_HEADS:]

    for l in range(DEPTH):
        h = h + 0.5 * swiglu(rmsnorm(h, ffn1_norm[l]), ffn1_w_gate[l], ffn1_w_up[l], ffn1_w_down[l])

        u = rmsnorm(h, mix_norm[l]) @ w_in[l]
        qa, ka, va, qb, ckv, iq, ik, iw = jnp.split(u, IN_SPLITS, axis=-1)

        qa = rmsnorm(qa.reshape(bsz, length, A_HEADS, 2, A_DK), a_q_norm[l])
        ka = rmsnorm(ka.reshape(bsz, length, A_HEADS, 2, A_DK), a_k_norm[l])
        va = va.reshape(bsz, length, A_HEADS, A_DV)
        lam_init = 0.8 - 0.6 * math.exp(-0.3 * l)
        lam = (jnp.exp(jnp.sum(a_lambda_q1[l].astype(jnp.float32) * a_lambda_k1[l].astype(jnp.float32)))
               - jnp.exp(jnp.sum(a_lambda_q2[l].astype(jnp.float32) * a_lambda_k2[l].astype(jnp.float32)))
               + lam_init)
        o_a = diff_attention(qa, ka, va, lam, bias_a, a_subln[l], lam_init)

        qb = qb.reshape(bsz, length, B_HEADS, B_DQ)
        q_lat = rmsnorm(jnp.einsum('blhd,hdc->blhc', qb, b_w_uk[l]), b_q_norm[l])
        c = rmsnorm(ckv, b_kv_norm[l])
        iq = iq.reshape(bsz, length, IDX_HEADS, IDX_DIM)
        o_b = dsa_attention(q_lat, c, iq, ik, iw, b_w_uv[l], bias_b, topk)

        h = h + jnp.concatenate([o_a, o_b], axis=-1) @ w_out[l]

        h = h + 0.5 * swiglu(rmsnorm(h, ffn2_norm[l]), ffn2_w_gate[l], ffn2_w_up[l], ffn2_w_down[l])

    return h[:, N_META:]
```

```cpp
#include <hip/hip_runtime.h>
#include <hip/hip_cooperative_groups.h>
#include <cstdio>
#include <cstdint>
namespace cg = cooperative_groups;

#define LAS __attribute__((address_space(3)))
typedef unsigned short bf16;
typedef short bf16x8 __attribute__((ext_vector_type(8)));
typedef short s16x4 __attribute__((ext_vector_type(4)));
typedef float f32x4 __attribute__((ext_vector_type(4)));
typedef float f32x16 __attribute__((ext_vector_type(16)));
typedef unsigned u32x4 __attribute__((ext_vector_type(4)));
typedef unsigned u32x2 __attribute__((ext_vector_type(2)));
typedef float f32x2_t __attribute__((ext_vector_type(2)));
typedef __bf16 bf16x2_t __attribute__((ext_vector_type(2)));

constexpr int DM = 1024, NB = 16, SEQ = 2048, MX = NB * SEQ, FF = 2816, NGU = 2 * FF, NINP = 3072, NIN = 2888;
constexpr int KROWS = 2112, MK = NB * KROWS;
constexpr int SELW = 68;
constexpr int SCP = 2112;
constexpr float EPS = 1e-6f, LOG2E = 1.4426950408889634f;
constexpr float A_QSCALE = 0.125f * LOG2E;
constexpr float B_QSCALE = 0.0625f * LOG2E;
constexpr float IW_SCALE = 0.35355339059327373f * 0.125f;
constexpr float SUBLN_SCALE = 0.8f;
constexpr float LAM_INIT = 0.2f;

constexpr size_t MiB = 1u << 20;
constexpr size_t WS_CTL = 0, CTL_BYTES = 1 * MiB;
constexpr size_t WS_WGU1 = 1 * MiB, WS_WD1 = 12 * MiB, WS_WIN = WS_WD1 + (size_t)DM * FF * 2, WS_WKV = WS_WIN + (size_t)NINP * DM * 2, WS_WUKT = WS_WKV + 512 * 1024,
                 WS_WOUT = WS_WUKT + 256 * 1024, WS_WGU2 = WS_WOUT + 2 * MiB, WS_WD2 = WS_WGU2 + 11 * MiB;
constexpr size_t WS_SS = 43 * MiB, WS_IW = 45 * MiB, WS_META = 46 * MiB, WS_SCR = 48 * MiB, WS_HB = 180 * MiB, WS_ACT = 244 * MiB;
constexpr size_t WS_QA = WS_ACT, WS_QB = WS_QA + 32 * MiB, WS_IQ = WS_QB + 32 * MiB, WS_KA = WS_IQ + 32 * MiB, WS_VA = WS_KA + 33 * MiB, WS_SEL = WS_VA + 33 * MiB;
constexpr size_t WS_C = 420 * MiB, WS_IK = WS_C + (size_t)MK * 256 * 2, WS_KK = 441 * MiB, WS_VV = 474 * MiB, WS_H2B = 420 * MiB, WS_END = 512 * MiB;
static_assert(WS_WD2 + (size_t)DM * FF * 2 <= WS_SS, "weights");
static_assert(WS_SCR + (size_t)256 * 64 * SCP * 4 <= WS_HB, "scratch");
static_assert(WS_SEL + (size_t)MX * SELW * 4 <= WS_C && WS_IK + (size_t)MK * 64 * 2 <= WS_KK && WS_VV + (size_t)MK * 512 * 2 <= WS_END, "map");
constexpr size_t MO_HBM = 0, MO_SSM0 = 32 * 1024, MO_ACTM = 36 * 1024, MO_H1MB = 128 * 1024, MO_SSM1 = 160 * 1024;

constexpr int LDS_BYTES = 155648;
constexpr int LDS_XCH = 131072;
constexpr int LDS_LUT = 66560;
constexpr int LDS_MISC = 150 * 1024;

static_assert(LDS_LUT + 512 <= 67072 && 67072 + 64 * 1040 <= LDS_MISC && 8 * 32 * 272 <= LDS_MISC && LDS_XCH + 4096 <= LDS_MISC && LDS_MISC + 64 <= LDS_BYTES && LDS_BYTES <= 160 * 1024, "LDS map");
#define LDS_WAIT() asm volatile("s_waitcnt lgkmcnt(0)" ::: "memory")
#define VM_WAIT() asm volatile("s_waitcnt vmcnt(0)" ::: "memory")
__device__ __forceinline__ unsigned pk2(float lo, float hi) { f32x2_t v = {lo, hi}; bf16x2_t b = __builtin_convertvector(v, bf16x2_t); return __builtin_bit_cast(unsigned, b); }
__device__ __forceinline__ float wave_sum(float v) {
#pragma unroll
    for (int o = 1; o < 64; o <<= 1) v += __shfl_xor(v, o);
    return v;
}
__device__ __forceinline__ float rsqrt_acc(float x) { return 1.0f / sqrtf(x); }
__device__ __forceinline__ int crow(int r, int hi) { return (r & 3) + 8 * (r >> 2) + 4 * hi; }
#define MFMA32(a, b, c) __builtin_amdgcn_mfma_f32_32x32x16_bf16((a), (b), (c), 0, 0, 0)
#define MFMA16(a, b, c) __builtin_amdgcn_mfma_f32_16x16x32_bf16((a), (b), (c), 0, 0, 0)
namespace pg8 {
#define PG8_LAS __attribute__((address_space(3)))
typedef unsigned short bf16_t;
typedef short bf16x8 __attribute__((ext_vector_type(8)));
typedef float f32x4 __attribute__((ext_vector_type(4)));
typedef unsigned u32x4 __attribute__((ext_vector_type(4)));
constexpr int BM = 256, BK = 64, HALF = 128, HTB = HALF * BK * 2  , STAGE_BYTES = 8 * HTB, NXCD = 8, WGM = 8;

__host__ __device__ __forceinline__ int lds_byte(int r, int c) { const int st = (r >> 4) * 2 + (c >> 5), rr = r & 15, cc = c & 31, ob = rr * 64 + cc * 2; return st * 1024 + (ob ^ (((ob >> 9) & 1) << 5)); }
__host__ __device__ __forceinline__ void stage_rc(int b, int& R, int& C) { const int st = b / 1024, sb = b % 1024, swz = sb ^ (((sb >> 9) & 1) << 5); R = (st >> 1) * 16 + swz / 64; C = (st & 1) * 32 + (swz % 64) / 2; }
__host__ __device__ __forceinline__ int perm32(int rho) { const int n = rho >> 4, i = rho & 15; return 8 * (i >> 2) + 4 * n + (i & 3); }

__device__ __forceinline__ int lane_id() { int l; asm volatile("v_mbcnt_lo_u32_b32 %0, -1, 0\n\tv_mbcnt_hi_u32_b32 %0, -1, %0" : "=v"(l)); return l; }
struct Unit { int pm, pn; };
struct Gemm { const bf16_t* A; const bf16_t* Bt; int M, N, K; };

struct StaticOrder {
    int nM, nN, nwg, G, c;
    __host__ __device__ void init(int M, int N, int G_, int c_) { nM = M / BM; nN = N / BM; nwg = nM * nN; G = G_; c = c_; }
    __host__ __device__ bool next(int i, Unit& u) const {
        const long L = (long)i * G + c; if (L >= nwg) return false;
        int wgid = (int)L; { const int q = nwg / NXCD, r = nwg % NXCD, xcd = wgid % NXCD, off = wgid / NXCD; wgid = (xcd < r ? xcd * (q + 1) : r * (q + 1) + (xcd - r) * q) + off; }
        const int nig = WGM * nN, gid = wgid / nig, fm = gid * WGM, gsz = (nM - fm) < WGM ? (nM - fm) : WGM;
        u.pm = fm + ((wgid % nig) % gsz); u.pn = (wgid % nig) / gsz; return true;
    }
    __host__ __device__ int arow(int pm) const { return pm * BM; }
    __device__ __forceinline__ void a_ready(const Unit&) const {}
    __device__ __forceinline__ void done(const Unit&) const {}
};
__device__ __forceinline__ unsigned cvt_pk_bf16(float lo, float hi) { unsigned r; asm volatile("v_cvt_pk_bf16_f32 %0, %1, %2" : "=v"(r) : "v"(lo), "v"(hi)); return r; }
template <class Epi, class Sched, bool ALIGN_EPI = false, bool SP2 = false>
__device__ __forceinline__ void gemm_phase(PG8_LAS unsigned char* lds, const Gemm g, const Sched& S, const Epi& E, int wave_s) {
    int tid_ = wave_s * 64 + lane_id(); asm volatile("" : "+v"(tid_));
    const int tid = tid_, wid = __builtin_amdgcn_readfirstlane(tid >> 6), lane = tid & 63, wr = wid >> 2, wc = wid & 3, fr = lane & 15, fq = lane >> 4;
    const int K = g.K, nt = K / BK;
    unsigned voffA[2], voffB[2];
#pragma unroll
    for (int i = 0; i < 2; ++i) { int R, C; stage_rc(tid * 16 + i * 8192, R, C); const int Rb = Epi::PERM ? ((R & ~31) + perm32(R & 31)) : R;
        voffA[i] = (unsigned)(R * K + C) * 2u; voffB[i] = (unsigned)(Rb * K + C) * 2u; }
    const size_t kstep = (size_t)(BK * 2);
    const size_t hstep = (size_t)HALF * K * 2;
    const size_t tstep = 2 * hstep;
    const unsigned ldsw = (unsigned)wid * 1024u;
    const int aoff = lds_byte(wr * 64 + fr, fq * 8), boff = lds_byte(wc * 32 + fr, fq * 8);
#define PG8_SA(b, h) (((b) * 2 + (h)) * HTB)
#define PG8_SB(b, h) ((4 + (b) * 2 + (h)) * HTB)
#define PG8_STAGE(bufoff, gbase, voff) do { _Pragma("unroll") for (int _i = 0; _i < 2; ++_i) \
        __builtin_amdgcn_global_load_lds((const unsigned*)((const char*)(gbase) + (voff)[_i]), (PG8_LAS unsigned*)(lds + (bufoff) + ldsw + _i * 8192), 16, 0, 0); } while (0)
#define PG8_LDA(dst, b, h) do { _Pragma("unroll") for (int m = 0; m < 4; ++m) _Pragma("unroll") for (int k = 0; k < 2; ++k) dst[m][k] = *(const PG8_LAS bf16x8*)(lds + PG8_SA(b, h) + aoff + m * 2048 + k * 1024); } while (0)
#define PG8_LDB(dst, b, h) do { _Pragma("unroll") for (int n = 0; n < 2; ++n) _Pragma("unroll") for (int k = 0; k < 2; ++k) dst[n][k] = *(const PG8_LAS bf16x8*)(lds + PG8_SB(b, h) + boff + n * 2048 + k * 1024); } while (0)
#define PG8_MMA(ai, bj, At, Bt) do { __builtin_amdgcn_s_setprio(1); _Pragma("unroll") for (int m = 0; m < 4; ++m) _Pragma("unroll") for (int n = 0; n < 2; ++n) _Pragma("unroll") for (int k = 0; k < 2; ++k) \
        acc[ai][bj][m][n] = __builtin_amdgcn_mfma_f32_16x16x32_bf16(Bt[n][k], At[m][k], acc[ai][bj][m][n], 0, 0, 0); __builtin_amdgcn_s_setprio(0); } while (0)
#define PG8_WAIT_V(n) asm volatile("s_waitcnt vmcnt(" #n ")" ::: "memory")
#define PG8_WAIT_L(n) asm volatile("s_waitcnt lgkmcnt(" #n ")" ::: "memory")
#define PG8_BAR __builtin_amdgcn_s_barrier()
#define PG8_SCHED __builtin_amdgcn_sched_barrier(0)
    Unit cur, nxt; int ui = 0;
    if (!S.next(0, cur)) return;
    f32x4 acc[2][2][4][2];
#pragma unroll
    for (int a = 0; a < 2; ++a)
#pragma unroll
        for (int b = 0; b < 2; ++b)
#pragma unroll
            for (int m = 0; m < 4; ++m)
#pragma unroll
                for (int n = 0; n < 2; ++n) acc[a][b][m][n] = (f32x4){0.f, 0.f, 0.f, 0.f};
    bf16x8 At[4][2], B0[2][2], B1[2][2];
    const char* cA = (const char*)g.A + (size_t)S.arow(cur.pm) * K * 2; const char* cB = (const char*)g.Bt + (size_t)cur.pn * tstep;
    S.a_ready(cur);
    if constexpr (SP2) {
        PG8_STAGE(PG8_SB(0, 0), cB, voffB); PG8_STAGE(PG8_SB(0, 1), cB + hstep, voffB); PG8_STAGE(PG8_SA(0, 0), cA, voffA); PG8_STAGE(PG8_SA(0, 1), cA + hstep, voffA);
        if (wr == 1) PG8_BAR;
        PG8_WAIT_V(2); PG8_BAR;
        PG8_STAGE(PG8_SB(1, 0), cB + kstep, voffB); PG8_STAGE(PG8_SA(1, 0), cA + kstep, voffA); PG8_STAGE(PG8_SB(1, 1), cB + hstep + kstep, voffB);
        PG8_WAIT_V(6); PG8_BAR;
    } else {
        PG8_STAGE(PG8_SB(0, 0), cB, voffB); PG8_STAGE(PG8_SA(0, 0), cA, voffA); PG8_STAGE(PG8_SB(0, 1), cB + hstep, voffB); PG8_STAGE(PG8_SA(0, 1), cA + hstep, voffA);
        if (wr == 1) PG8_BAR;
        PG8_WAIT_V(4); PG8_BAR;
        PG8_STAGE(PG8_SB(1, 0), cB + kstep, voffB); PG8_STAGE(PG8_SA(1, 0), cA + kstep, voffA); PG8_STAGE(PG8_SB(1, 1), cB + hstep + kstep, voffB);
        PG8_WAIT_V(6); PG8_BAR;
    }
    for (;;) {
        const bool has_next = S.next(ui + 1, nxt);
        const char* nA = has_next ? (const char*)g.A + (size_t)S.arow(nxt.pm) * K * 2 : cA; const char* nB = has_next ? (const char*)g.Bt + (size_t)nxt.pn * tstep : cB;
        for (int t = 0; t < nt; t += 2) {
            const bool last = (t == nt - 2);
            const char* a1 = cA + (size_t)(t + 1) * kstep;
            const char* a2 = last ? nA : cA + (size_t)(t + 2) * kstep; const char* b2 = last ? nB : cB + (size_t)(t + 2) * kstep;
            const char* a3 = a2 + kstep; const char* b3 = b2 + kstep;
            if (last && has_next) S.a_ready(nxt);
            if constexpr (SP2) {
            PG8_LDB(B0, 0, 0); PG8_LDB(B1, 0, 1); PG8_SCHED; PG8_LDA(At, 0, 0); PG8_STAGE(PG8_SA(1, 1), a1 + hstep, voffA);
            PG8_WAIT_V(8); PG8_WAIT_L(0); PG8_BAR; PG8_MMA(0, 0, At, B0); PG8_MMA(0, 1, At, B1); PG8_BAR; PG8_SCHED;
            PG8_LDA(At, 0, 1); PG8_STAGE(PG8_SB(0, 0), b2, voffB); PG8_STAGE(PG8_SB(0, 1), b2 + hstep, voffB); PG8_STAGE(PG8_SA(0, 0), a2, voffA);
            PG8_WAIT_V(8); PG8_WAIT_L(0); PG8_BAR; PG8_MMA(1, 0, At, B0); PG8_MMA(1, 1, At, B1); PG8_BAR; PG8_SCHED;
            PG8_LDB(B0, 1, 0); PG8_LDB(B1, 1, 1); PG8_SCHED; PG8_LDA(At, 1, 0); PG8_STAGE(PG8_SA(0, 1), a2 + hstep, voffA);
            PG8_WAIT_V(8); PG8_WAIT_L(0); PG8_BAR; PG8_MMA(0, 0, At, B0); PG8_MMA(0, 1, At, B1); PG8_BAR; PG8_SCHED;
            PG8_LDA(At, 1, 1); PG8_STAGE(PG8_SB(1, 0), b3, voffB); PG8_STAGE(PG8_SB(1, 1), b3 + hstep, voffB); PG8_STAGE(PG8_SA(1, 0), a3, voffA);
            PG8_WAIT_V(8); PG8_WAIT_L(0); PG8_BAR; PG8_MMA(1, 0, At, B0); PG8_MMA(1, 1, At, B1); PG8_BAR; PG8_SCHED;
            } else {
            PG8_LDB(B0, 0, 0); PG8_SCHED; PG8_LDA(At, 0, 0); PG8_STAGE(PG8_SA(1, 1), a1 + hstep, voffA);
            PG8_WAIT_L(8); PG8_BAR; PG8_WAIT_L(0); PG8_MMA(0, 0, At, B0); PG8_BAR; PG8_SCHED;
            PG8_LDB(B1, 0, 1); PG8_STAGE(PG8_SB(0, 0), b2, voffB);
            PG8_BAR; PG8_WAIT_L(0); PG8_MMA(0, 1, At, B1); PG8_BAR;
            PG8_LDA(At, 0, 1); PG8_STAGE(PG8_SA(0, 0), a2, voffA);
            PG8_BAR; PG8_WAIT_L(0); PG8_MMA(1, 0, At, B0); PG8_BAR; PG8_SCHED;
            PG8_STAGE(PG8_SB(0, 1), b2 + hstep, voffB);
            PG8_WAIT_V(6); PG8_BAR; PG8_MMA(1, 1, At, B1); PG8_BAR;
            PG8_LDB(B0, 1, 0); PG8_SCHED; PG8_LDA(At, 1, 0); PG8_STAGE(PG8_SA(0, 1), a2 + hstep, voffA);
            PG8_WAIT_L(8); PG8_BAR; PG8_WAIT_L(0); PG8_MMA(0, 0, At, B0); PG8_BAR; PG8_SCHED;
            PG8_LDB(B1, 1, 1); PG8_STAGE(PG8_SB(1, 0), b3, voffB);
            PG8_BAR; PG8_WAIT_L(0); PG8_MMA(0, 1, At, B1); PG8_BAR;
            PG8_LDA(At, 1, 1); PG8_STAGE(PG8_SA(1, 0), a3, voffA);
            PG8_BAR; PG8_WAIT_L(0); PG8_MMA(1, 0, At, B0); PG8_BAR; PG8_SCHED;
            PG8_STAGE(PG8_SB(1, 1), b3 + hstep, voffB);
            PG8_WAIT_V(6); PG8_BAR; PG8_MMA(1, 1, At, B1); PG8_BAR;
            }
        }
        if constexpr (ALIGN_EPI) { if (wr == 0) PG8_BAR; }
        if constexpr (!Epi::AFTER_DRAIN) { E(acc, cur, wr, wc, fr, fq); S.done(cur); }
        if (!has_next) break;
#pragma unroll
        for (int a = 0; a < 2; ++a)
#pragma unroll
            for (int b = 0; b < 2; ++b)
#pragma unroll
                for (int m = 0; m < 4; ++m)
#pragma unroll
                    for (int n = 0; n < 2; ++n) acc[a][b][m][n] = (f32x4){0.f, 0.f, 0.f, 0.f};
        cur = nxt; cA = nA; cB = nB; ++ui;
        if constexpr (ALIGN_EPI) { if (wr == 1) PG8_BAR; }
    }
    PG8_WAIT_V(0);
    if constexpr (!ALIGN_EPI) { if (wr == 0) PG8_BAR; }
    PG8_BAR;
    if constexpr (Epi::AFTER_DRAIN) { E.fused(acc, cur, wr, wc, fr, fq, lds, wid, lane); S.done(cur); }
#undef PG8_SA
#undef PG8_SB
#undef PG8_STAGE
#undef PG8_LDA
#undef PG8_LDB
#undef PG8_MMA
#undef PG8_WAIT_V
#undef PG8_WAIT_L
#undef PG8_BAR
#undef PG8_SCHED
}
__device__ __forceinline__ float rstd_slots(const float* ss, int row, int fq) {
    const f32x4 v = *(const f32x4*)(ss + (size_t)row * 16 + 4 * fq);
    float s = (v[0] + v[1]) + (v[2] + v[3]);
    s += __shfl_xor(s, 16); s += __shfl_xor(s, 32);
    return 1.0f / sqrtf(s * (1.0f / 1024.0f) + 1e-6f);
}
__device__ __forceinline__ f32x4 slots_load(const float* ss, int row, int fq) { return *(const f32x4*)(ss + (size_t)row * 16 + 4 * fq); }
__device__ __forceinline__ float slots_rstd(const f32x4 v) { float s = (v[0] + v[1]) + (v[2] + v[3]); s += __shfl_xor(s, 16); s += __shfl_xor(s, 32); return 1.0f / sqrtf(s * (1.0f / 1024.0f) + 1e-6f); }
__device__ __forceinline__ float silu_mul(float g, float u) { return g * __builtin_amdgcn_rcpf(1.0f + __builtin_amdgcn_exp2f(-1.4426950408889634f * g)) * u; }
__device__ __forceinline__ unsigned pkbf(float lo, float hi) { typedef float v2f __attribute__((ext_vector_type(2))); typedef __bf16 v2b __attribute__((ext_vector_type(2))); v2f v = {lo, hi}; v2b b = __builtin_convertvector(v, v2b); return __builtin_bit_cast(unsigned, b); }

struct EpiGU {
    static constexpr bool PERM = true, AFTER_DRAIN = false;
    bf16_t* act; const float* ss; int abl;
    __device__ __forceinline__ void operator()(const f32x4 (&acc)[2][2][4][2], const Unit& u, int wr, int wc, int fr, int fq) const {
        if (abl & 1) return;
        const int row0 = u.pm * BM + wr * 64 + fr, col0 = u.pn * 128 + wc * 32 + 8 * fq;
        f32x4 sv[2][4];
#pragma unroll
        for (int ai = 0; ai < 2; ++ai)
#pragma unroll
            for (int m = 0; m < 4; ++m) sv[ai][m] = slots_load(ss, row0 + ai * HALF + m * 16, fq);
#pragma unroll
        for (int ai = 0; ai < 2; ++ai)
#pragma unroll
            for (int m = 0; m < 4; ++m) { const int row = row0 + ai * HALF + m * 16; const float rs = slots_rstd(sv[ai][m]);
                const f32x4 g0 = acc[ai][0][m][0] * rs, g1 = acc[ai][0][m][1] * rs, u0 = acc[ai][1][m][0] * rs, u1 = acc[ai][1][m][1] * rs;
                u32x4 w; w.x = pkbf(silu_mul(g0[0], u0[0]), silu_mul(g0[1], u0[1])); w.y = pkbf(silu_mul(g0[2], u0[2]), silu_mul(g0[3], u0[3]));
                w.z = pkbf(silu_mul(g1[0], u1[0]), silu_mul(g1[1], u1[1])); w.w = pkbf(silu_mul(g1[2], u1[2]), silu_mul(g1[3], u1[3]));
                *(u32x4*)(act + (size_t)row * 2816 + col0) = w; }
    }
};
template <bool HB, bool SS> struct EpiRes {
    static constexpr bool PERM = false, AFTER_DRAIN = false;
    const float* res; float* out; bf16_t* hb; float* ss; float alpha;
    __device__ __forceinline__ void operator()(const f32x4 (&acc)[2][2][4][2], const Unit& u, int wr, int wc, int fr, int fq) const {
        const int row0 = u.pm * BM + wr * 64 + fr, col0 = u.pn * BM + wc * 32 + 4 * fq;
#pragma unroll
        for (int ai = 0; ai < 2; ++ai)
#pragma unroll
            for (int m = 0; m < 4; ++m) { const int row = row0 + ai * HALF + m * 16; const size_t off = (size_t)row * 1024 + col0; float sq = 0.f;
#pragma unroll
                for (int bj = 0; bj < 2; ++bj)
#pragma unroll
                    for (int n = 0; n < 2; ++n) { const f32x4 r4 = *(const f32x4*)(res + off + bj * HALF + n * 16); const f32x4 v = r4 + acc[ai][bj][m][n] * alpha;
                        *(f32x4*)(out + off + bj * HALF + n * 16) = v;
                        if (HB) { typedef unsigned u32x2v __attribute__((ext_vector_type(2))); u32x2v w; w.x = pkbf(v[0], v[1]); w.y = pkbf(v[2], v[3]); *(u32x2v*)(hb + off + bj * HALF + n * 16) = w; }
                        if (SS) sq += (v[0] * v[0] + v[1] * v[1]) + (v[2] * v[2] + v[3] * v[3]); }
                if (SS) { sq += __shfl_xor(sq, 16); sq += __shfl_xor(sq, 32); if (fq == 0) ss[(size_t)row * 16 + u.pn * 4 + wc] = sq; }
                if (m == 3) asm volatile("" ::: "memory"); }
    }
};
template <bool OUTF32, bool SS> struct EpiResB {
    static constexpr bool PERM = true, AFTER_DRAIN = false;
    const bf16_t* res; bf16_t* outb; float* outf; float* ss; float alpha;
    __device__ __forceinline__ void operator()(const f32x4 (&acc)[2][2][4][2], const Unit& u, int wr, int wc, int fr, int fq) const {
        const int row0 = u.pm * BM + wr * 64 + fr, col0 = u.pn * BM + wc * 32 + 8 * fq;
        u32x4 rv[2][4][2];
#pragma unroll
        for (int ai = 0; ai < 2; ++ai)
#pragma unroll
            for (int m = 0; m < 4; ++m)
#pragma unroll
                for (int bj = 0; bj < 2; ++bj) rv[ai][m][bj] = *(const u32x4*)(res + (size_t)(row0 + ai * HALF + m * 16) * 1024 + col0 + bj * HALF);
#pragma unroll
        for (int ai = 0; ai < 2; ++ai)
#pragma unroll
            for (int m = 0; m < 4; ++m) { const int row = row0 + ai * HALF + m * 16; const size_t off = (size_t)row * 1024 + col0; float sq = 0.f;
#pragma unroll
                for (int bj = 0; bj < 2; ++bj) { const u32x4 r = rv[ai][m][bj];
                    f32x4 v0, v1;
                    v0[0] = __uint_as_float(r.x << 16); v0[1] = __uint_as_float(r.x & 0xffff0000u); v0[2] = __uint_as_float(r.y << 16); v0[3] = __uint_as_float(r.y & 0xffff0000u);
                    v1[0] = __uint_as_float(r.z << 16); v1[1] = __uint_as_float(r.z & 0xffff0000u); v1[2] = __uint_as_float(r.w << 16); v1[3] = __uint_as_float(r.w & 0xffff0000u);
                    v0 = v0 + acc[ai][bj][m][0] * alpha; v1 = v1 + acc[ai][bj][m][1] * alpha;
                    if (OUTF32) { *(f32x4*)(outf + off + bj * HALF) = v0; *(f32x4*)(outf + off + bj * HALF + 4) = v1; }
                    else { u32x4 w; w.x = pkbf(v0[0], v0[1]); w.y = pkbf(v0[2], v0[3]); w.z = pkbf(v1[0], v1[1]); w.w = pkbf(v1[2], v1[3]); *(u32x4*)(outb + off + bj * HALF) = w; }
                    if (SS) sq += ((v0[0] * v0[0] + v0[1] * v0[1]) + (v0[2] * v0[2] + v0[3] * v0[3])) + ((v1[0] * v1[0] + v1[1] * v1[1]) + (v1[2] * v1[2] + v1[3] * v1[3])); }
                if (SS) { sq += __shfl_xor(sq, 16); sq += __shfl_xor(sq, 32); if (fq == 0) ss[(size_t)row * 16 + u.pn * 4 + wc] = sq; } }
    }
};
struct EpiIn {
    static constexpr bool PERM = true, AFTER_DRAIN = false;
    bf16_t *qa, *ka, *va, *qb, *cc, *iq, *ik; float* iw; const float* ss; const float *g_aq, *g_ak, *g_kv; PG8_LAS float* xch;
    __device__ __forceinline__ void operator()(const f32x4 (&acc)[2][2][4][2], const Unit& u, int wr, int wc, int fr, int fq) const {
        const int row0 = u.pm * BM + wr * 64 + fr, pn = u.pn, lc0 = 64 * wc + 8 * fq;
        if (pn == 8) {
            float rsv[2][4]; f32x4 sv[2][4];
#pragma unroll
            for (int ai = 0; ai < 2; ++ai)
#pragma unroll
                for (int m = 0; m < 4; ++m) sv[ai][m] = slots_load(ss, row0 + ai * HALF + m * 16, fq);
#pragma unroll
            for (int ai = 0; ai < 2; ++ai)
#pragma unroll
                for (int m = 0; m < 4; ++m) { const float rs = slots_rstd(sv[ai][m]); rsv[ai][m] = rs; float sq = 0.f;
#pragma unroll
                    for (int bj = 0; bj < 2; ++bj)
#pragma unroll
                        for (int n = 0; n < 2; ++n) { const f32x4 v = acc[ai][bj][m][n] * rs; sq += (v[0] * v[0] + v[1] * v[1]) + (v[2] * v[2] + v[3] * v[3]); }
                    sq += __shfl_xor(sq, 16); sq += __shfl_xor(sq, 32);
                    if (fq == 0) xch[(ai * HALF + wr * 64 + m * 16 + fr) * 4 + wc] = sq; }
            asm volatile("s_waitcnt lgkmcnt(0)" ::: "memory"); __builtin_amdgcn_s_barrier(); asm volatile("" ::: "memory");
            f32x4 gv[2][2];
#pragma unroll
            for (int bj = 0; bj < 2; ++bj)
#pragma unroll
                for (int n = 0; n < 2; ++n) gv[bj][n] = *(const f32x4*)(g_kv + lc0 + 32 * bj + 4 * n);
#pragma unroll
            for (int ai = 0; ai < 2; ++ai)
#pragma unroll
                for (int m = 0; m < 4; ++m) { const int row = row0 + ai * HALF + m * 16, rl = ai * HALF + wr * 64 + m * 16 + fr; const f32x4 t = *(const PG8_LAS f32x4*)(xch + rl * 4);
                    const float r2 = rsv[ai][m] / sqrtf(((t[0] + t[1]) + (t[2] + t[3])) * (1.0f / 256.0f) + 1e-6f);
                    const size_t kr = (size_t)(row >> 11) * 2112 + 64 + (row & 2047);
#pragma unroll
                    for (int bj = 0; bj < 2; ++bj) { const f32x4 a = acc[ai][bj][m][0] * r2 * gv[bj][0], b = acc[ai][bj][m][1] * r2 * gv[bj][1];
                        u32x4 w; w.x = pkbf(a[0], a[1]); w.y = pkbf(a[2], a[3]); w.z = pkbf(b[0], b[1]); w.w = pkbf(b[2], b[3]);
                        *(u32x4*)(cc + kr * 256 + lc0 + 32 * bj) = w; } }
            asm volatile("s_waitcnt lgkmcnt(0)" ::: "memory"); __builtin_amdgcn_s_barrier(); asm volatile("" ::: "memory");
            return;
        }
        const bool headnorm = pn < 4;
        f32x4 gv[2][2];
        if (headnorm) { const float* gp = (pn < 2) ? g_aq : g_ak; const float sc = (pn < 2) ? (0.125f * 1.4426950408889634f) : 1.0f;
#pragma unroll
            for (int bj = 0; bj < 2; ++bj)
#pragma unroll
                for (int n = 0; n < 2; ++n) gv[bj][n] = *(const f32x4*)(gp + 32 * bj + 8 * fq + 4 * n) * sc; }
        f32x4 sv[2][4];
#pragma unroll
        for (int ai = 0; ai < 2; ++ai)
#pragma unroll
            for (int m = 0; m < 4; ++m) sv[ai][m] = slots_load(ss, row0 + ai * HALF + m * 16, fq);
#pragma unroll
        for (int ai = 0; ai < 2; ++ai)
#pragma unroll
            for (int m = 0; m < 4; ++m) { const int row = row0 + ai * HALF + m * 16; const float rs = slots_rstd(sv[ai][m]);
                const size_t kr = (size_t)(row >> 11) * 2112 + 64 + (row & 2047);
                f32x4 v[2][2];
#pragma unroll
                for (int bj = 0; bj < 2; ++bj)
#pragma unroll
                    for (int n = 0; n < 2; ++n) v[bj][n] = acc[ai][bj][m][n] * rs;
                if (headnorm) { float sq = 0.f;
#pragma unroll
                    for (int bj = 0; bj < 2; ++bj)
#pragma unroll
                        for (int n = 0; n < 2; ++n) sq += (v[bj][n][0] * v[bj][n][0] + v[bj][n][1] * v[bj][n][1]) + (v[bj][n][2] * v[bj][n][2] + v[bj][n][3] * v[bj][n][3]);
                    sq += __shfl_xor(sq, 16); sq += __shfl_xor(sq, 32);
                    const float r2 = 1.0f / sqrtf(sq * (1.0f / 64.0f) + 1e-6f);
#pragma unroll
                    for (int bj = 0; bj < 2; ++bj)
#pragma unroll
                        for (int n = 0; n < 2; ++n) v[bj][n] = v[bj][n] * r2 * gv[bj][n]; }
                bf16_t* dst; bool st = true;
                if (pn < 2) dst = qa + (size_t)row * 512 + pn * 256 + lc0;
                else if (pn < 4) dst = ka + kr * 512 + (pn - 2) * 256 + lc0;
                else if (pn < 6) dst = va + kr * 512 + (pn - 4) * 256 + lc0;
                else if (pn < 8) dst = qb + (size_t)row * 512 + (pn - 6) * 256 + lc0;
                else if (pn < 11) dst = iq + (size_t)row * 512 + (pn - 9) * 256 + lc0;
                else { dst = ik + kr * 64 + lc0; st = (wc == 0);
                    if (wc == 1 && fq == 0) { const float s = 0.35355339059327373f * 0.125f; *(f32x4*)(iw + (size_t)row * 8) = v[0][0] * s; *(f32x4*)(iw + (size_t)row * 8 + 4) = v[0][1] * s; } }
                if (st) {
#pragma unroll
                    for (int bj = 0; bj < 2; ++bj) { u32x4 w; w.x = pkbf(v[bj][0][0], v[bj][0][1]); w.y = pkbf(v[bj][0][2], v[bj][0][3]); w.z = pkbf(v[bj][1][0], v[bj][1][1]); w.w = pkbf(v[bj][1][2], v[bj][1][3]);
                        *(u32x4*)(dst + 32 * bj) = w; } } }
    }
};
struct EpiKV {
    static constexpr bool PERM = true, AFTER_DRAIN = false;
    bf16_t *kk, *vv;
    __device__ __forceinline__ void operator()(const f32x4 (&acc)[2][2][4][2], const Unit& u, int wr, int wc, int fr, int fq) const {
        const int row0 = (u.pm >> 3) * 2112 + 64 + (u.pm & 7) * BM + wr * 64 + fr; bf16_t* base = (u.pn < 2 ? kk : vv) + (u.pn & 1) * 256 + wc * 32 + 8 * fq;
#pragma unroll
        for (int ai = 0; ai < 2; ++ai)
#pragma unroll
            for (int m = 0; m < 4; ++m) { bf16_t* rowp = base + (size_t)(row0 + ai * HALF + m * 16) * 512;
#pragma unroll
                for (int bj = 0; bj < 2; ++bj) { const f32x4 a = acc[ai][bj][m][0], b = acc[ai][bj][m][1];
                    u32x4 w; w.x = pkbf(a[0], a[1]); w.y = pkbf(a[2], a[3]); w.z = pkbf(b[0], b[1]); w.w = pkbf(b[2], b[3]);
                    *(u32x4*)(rowp + bj * HALF) = w; } }
    }
};
}
struct Args {
    const float* in[25]; float* out; unsigned char* ws; int dup; int pad;
};
typedef const __attribute__((address_space(4))) Args* CArgsP;
__device__ __forceinline__ CArgsP get_args() { CArgsP p = (CArgsP)__builtin_amdgcn_kernarg_segment_ptr(); asm volatile("" : "+s"(p)); return p; }
struct Frame {
    LAS unsigned char* lds; int tid, lane, wave, G, vcu;
};

__device__ __forceinline__ Frame make_frame(LAS unsigned char* lds, int wave_s) {
    Frame F; int t = wave_s * 64 + pg8::lane_id(); asm volatile("" : "+v"(t));
    F.lds = lds; F.tid = t; F.lane = t & 63; F.wave = __builtin_amdgcn_readfirstlane(t >> 6);
    F.G = gridDim.x; { const int bx = blockIdx.x; F.vcu = (F.G % 8 == 0) ? (bx % 8) * (F.G / 8) + bx / 8 : bx; }
    return F;
}
__device__ __forceinline__ void tr_item(const float* __restrict__ W, int ld, int col, int nvalid, const float* __restrict__ gain, int k0, bf16* out, int Kpitch, LAS float* scr, int lane) {
    const int c = lane & 31; const bool okc = c < nvalid;
    const float* wp = W + (size_t)(k0 + (lane >> 5)) * ld + col + (okc ? c : 0);
    float v[32];
#pragma unroll
    for (int i = 0; i < 32; ++i) v[i] = okc ? wp[(size_t)(2 * i) * ld] : 0.f;
    if (gain) {
#pragma unroll
        for (int i = 0; i < 32; ++i) v[i] *= gain[k0 + 2 * i + (lane >> 5)]; }
#pragma unroll
    for (int i = 0; i < 32; ++i) scr[(2 * i + (lane >> 5)) * 33 + c] = v[i];
    LDS_WAIT(); asm volatile("" ::: "memory");
    const int c8 = lane & 7;
#pragma unroll
    for (int j = 0; j < 4; ++j) { const int n = (lane >> 3) + 8 * j; const LAS float* s = scr + (8 * c8) * 33 + n;
        u32x4 o; o.x = pk2(s[0 * 33], s[1 * 33]); o.y = pk2(s[2 * 33], s[3 * 33]); o.z = pk2(s[4 * 33], s[5 * 33]); o.w = pk2(s[6 * 33], s[7 * 33]);
        *(u32x4*)(out + (size_t)n * Kpitch + 8 * c8) = o; }
    LDS_WAIT(); asm volatile("" ::: "memory");
}
__device__ __forceinline__ void p0_gu_item(const float* Wg, const float* Wu, const float* gain, bf16* WT, int r, LAS float* scr, int lane) {
    const int kb = r / 176, nb = r % 176, n0 = 32 * nb, pn = n0 >> 8, j = n0 & 255, bj = j >> 7, jj = j & 127;
    tr_item(bj ? Wu : Wg, FF, 128 * pn + jj, 32, gain, 64 * kb, WT + (size_t)n0 * DM + 64 * kb, DM, scr, lane);
}
__device__ __forceinline__ void p0_plain_item(const float* W, int K, int N, const float* gain, bf16* WT, int r, LAS float* scr, int lane) {
    const int nblk = N / 32, kb = r / nblk, nb = r % nblk;
    tr_item(W, N, 32 * nb, 32, gain, 64 * kb, WT + (size_t)(32 * nb) * K + 64 * kb, K, scr, lane);
}
__device__ __forceinline__ void p0_in_item(const float* W, const float* gain, bf16* WT, int r, LAS float* scr, int lane) {
    const int kb = r / 96, nb = r % 96, n0 = 32 * nb, pn = n0 >> 8, j = n0 & 255, bj = j >> 7, wc = (j >> 5) & 3, L = 256 * pn + 64 * wc + 32 * bj;
    int nv = NIN - L; nv = nv < 0 ? 0 : (nv > 32 ? 32 : nv);
    tr_item(W, NIN, L, nv, gain, 64 * kb, WT + (size_t)n0 * DM + 64 * kb, DM, scr, lane);
}
__device__ __forceinline__ void row_to_bf16(const float* xrow, bf16* orow, float* ssrow, int lane) {
    const f32x4* xr = (const f32x4*)xrow + lane; f32x4 v[4]; float s = 0.f;
#pragma unroll
    for (int j = 0; j < 4; ++j) { v[j] = xr[64 * j]; s += (v[j][0] * v[j][0] + v[j][1] * v[j][1]) + (v[j][2] * v[j][2] + v[j][3] * v[j][3]); }
    u32x2* o8 = (u32x2*)orow + lane;
#pragma unroll
    for (int j = 0; j < 4; ++j) { u32x2 w; w.x = pk2(v[j][0], v[j][1]); w.y = pk2(v[j][2], v[j][3]); o8[64 * j] = w; }
    const float tot = wave_sum(s);
    if (lane < 16) ssrow[lane] = (lane == 0) ? tot : 0.f;
}
__device__ __forceinline__ void p0_prologue(const Frame& F, CArgsP a) {
    unsigned char* ws = a->ws;
    LAS float* scr = (LAS float*)(F.lds + F.wave * 16384);
    const int gw = F.vcu * 8 + F.wave, NGW = F.G * 8, lane = F.lane;
    constexpr int I0 = 2816, I1 = 1408, I2 = 1536, I3 = 512, I4 = 2816, I5 = 1408, I6 = 64, I7 = 64, NIT = I0 + I1 + I2 + I3 + I4 + I5 + I6 + I7;
    for (int it = gw; it < NIT; it += NGW) {
        int r = it;
        if (r < I0) { p0_gu_item(a->in[4], a->in[5], a->in[3], (bf16*)(ws + WS_WGU1), r, scr, lane); continue; } r -= I0;
        if (r < I1) { p0_plain_item(a->in[6], FF, DM, nullptr, (bf16*)(ws + WS_WD1), r, scr, lane); continue; } r -= I1;
        if (r < I2) { p0_in_item(a->in[8], a->in[7], (bf16*)(ws + WS_WIN), r, scr, lane); continue; } r -= I2;
        if (r < I3) { p0_plain_item(a->in[20], DM, DM, nullptr, (bf16*)(ws + WS_WOUT), r, scr, lane); continue; } r -= I3;
        if (r < I4) { p0_gu_item(a->in[22], a->in[23], a->in[21], (bf16*)(ws + WS_WGU2), r, scr, lane); continue; } r -= I4;
        if (r < I5) { p0_plain_item(a->in[24], FF, DM, nullptr, (bf16*)(ws + WS_WD2), r, scr, lane); continue; } r -= I5;
        if (r < I6) { const int h = r >> 4, q = r & 15, kb = q >> 2, nb = q & 3;
            tr_item(a->in[19] + (size_t)h * 256 * 128, 128, 32 * nb, 32, nullptr, 64 * kb, (bf16*)(ws + WS_WKV) + (size_t)(512 + 128 * h + 32 * nb) * 256 + 64 * kb, 256, scr, lane); continue; } r -= I6;
        { const int h = r >> 4, q = r & 15, kb = q >> 3, nb = q & 7;
            tr_item(a->in[17] + (size_t)h * 128 * 256, 256, 32 * nb, 32, nullptr, 64 * kb, (bf16*)(ws + WS_WUKT) + (size_t)h * 256 * 128 + (size_t)(32 * nb) * 128 + 64 * kb, 128, scr, lane); }
    }
    {
        const int gid = F.vcu * 512 + F.tid;
        for (int e = gid; e < 512 * 256 / 2; e += F.G * 512) { const int i = 2 * e, c = i & 255; const float* w = a->in[17] + i; const float* g = a->in[18] + c;
            ((unsigned*)(ws + WS_WKV))[e] = pk2(w[0] * g[0], w[1] * g[1]); }
    }
    for (int m0 = gw * 4; m0 < MX; m0 += NGW * 4) {
        f32x4 v[4][4]; float sq[4];
#pragma unroll
        for (int r = 0; r < 4; ++r) { const f32x4* xr = (const f32x4*)(a->in[0] + (size_t)(m0 + r) * DM) + lane;
#pragma unroll
            for (int j = 0; j < 4; ++j) v[r][j] = __builtin_nontemporal_load(xr + 64 * j); }
#pragma unroll
        for (int r = 0; r < 4; ++r) { float s = 0.f; u32x2* o8 = (u32x2*)((bf16*)(ws + WS_HB) + (size_t)(m0 + r) * DM) + lane;
#pragma unroll
            for (int j = 0; j < 4; ++j) { s += (v[r][j][0] * v[r][j][0] + v[r][j][1] * v[r][j][1]) + (v[r][j][2] * v[r][j][2] + v[r][j][3] * v[r][j][3]);
                u32x2 w; w.x = pk2(v[r][j][0], v[r][j][1]); w.y = pk2(v[r][j][2], v[r][j][3]); o8[64 * j] = w; }
            sq[r] = wave_sum(s); }
#pragma unroll
        for (int r = 0; r < 4; ++r) if (lane < 16) ((float*)(ws + WS_SS))[(size_t)(m0 + r) * 16 + lane] = (lane == 0) ? sq[r] : 0.f;
    }
    if (gw < 16) row_to_bf16(a->in[1] + (size_t)gw * DM, (bf16*)(ws + WS_META + MO_HBM) + (size_t)gw * DM, (float*)(ws + WS_META + MO_SSM0) + gw * 16, lane);
    {
        const int gid = F.vcu * 512 + F.tid, NT = F.G * 512; const u32x4 z = {0u, 0u, 0u, 0u};
        for (int e = gid; e < NB * 48 * 64; e += NT) { const int b = e / (48 * 64), q = e % (48 * 64); const size_t o = ((size_t)b * KROWS) * 1024 + (size_t)q * 16;
            *(u32x4*)(ws + WS_KA + o) = z; *(u32x4*)(ws + WS_VA + o) = z; *(u32x4*)(ws + WS_KK + o) = z; *(u32x4*)(ws + WS_VV + o) = z; }
        for (int e = gid; e < NB * 48 * 32; e += NT) { const int b = e / (48 * 32), q = e % (48 * 32); *(u32x4*)(ws + WS_C + ((size_t)b * KROWS) * 512 + (size_t)q * 16) = z; }
        for (int e = gid; e < NB * 48 * 8; e += NT) { const int b = e / (48 * 8), q = e % (48 * 8); *(u32x4*)(ws + WS_IK + ((size_t)b * KROWS) * 128 + (size_t)q * 16) = z; }
    }
}

template <int KS, int NT, int BS> __device__ __forceinline__ void meta_block_mm(const Frame& F, const bf16* __restrict__ A16, const bf16* __restrict__ Bt, const int (&prow)[NT], int K, float (&v)[4][NT]) {
    const int lane = F.lane, col = lane & 15, kq = lane >> 4, k0 = F.wave * KS * 32;
    const bf16* ap = A16 + (size_t)col * K + k0 + 8 * kq;
    const bf16* bp[NT]; f32x4 acc[NT];
#pragma unroll
    for (int j = 0; j < NT; ++j) { bp[j] = Bt + (size_t)(prow[j] + col) * K + k0 + 8 * kq; acc[j] = (f32x4){0.f, 0.f, 0.f, 0.f}; }
#pragma unroll
    for (int s0 = 0; s0 < KS; s0 += BS) {
        bf16x8 av[BS], bv[NT][BS];
#pragma unroll
        for (int s = 0; s < BS; ++s) if (s0 + s < KS) { av[s] = *(const bf16x8*)(ap + 32 * (s0 + s));
#pragma unroll
            for (int j = 0; j < NT; ++j) bv[j][s] = *(const bf16x8*)(bp[j] + 32 * (s0 + s)); }
#pragma unroll
        for (int s = 0; s < BS; ++s) if (s0 + s < KS) {
#pragma unroll
            for (int j = 0; j < NT; ++j) acc[j] = MFMA16(av[s], bv[j][s], acc[j]); }
    }
    LAS float* red = (LAS float*)F.lds;
#pragma unroll
    for (int j = 0; j < NT; ++j)
#pragma unroll
        for (int r = 0; r < 4; ++r) red[(F.wave * 16 + 4 * kq + r) * (16 * NT) + 16 * j + col] = acc[j][r];
    __syncthreads();
    if (F.wave == 0) {
#pragma unroll
        for (int r = 0; r < 4; ++r)
#pragma unroll
            for (int j = 0; j < NT; ++j) { float t = 0.f;
#pragma unroll
                for (int w = 0; w < 8; ++w) t += red[(w * 16 + 4 * kq + r) * (16 * NT) + 16 * j + col];
                v[r][j] = t; } }
    __syncthreads();
}
template <int N> __device__ __forceinline__ float meta_rstd(const float* ssm, int row) { float s = 0.f;
#pragma unroll
    for (int i = 0; i < N; ++i) s += ssm[row * N + i];
    return 1.0f / sqrtf(s * (1.0f / 1024.0f) + EPS); }
__device__ __forceinline__ void meta_store_rows(const Frame& F, const float (&v)[4][4], bf16* dst, int pitch, int cb, int nb) {
    const int lane = F.lane; LAS unsigned char* st = F.lds + 96 * 1024;
#pragma unroll
    for (int r = 0; r < 4; ++r)
#pragma unroll
        for (int j = 0; j < 4; ++j) *(LAS bf16*)(st + (4 * (lane >> 4) + r) * 144 + 2 * (16 * j + (lane & 15))) = (bf16)(pk2(v[r][j], 0.f) & 0xffffu);
    LDS_WAIT();
#pragma unroll
    for (int i = 0; i < 2; ++i) { const int c = lane + 64 * i, row = c >> 3, ch = c & 7; const u32x4 x = *(const LAS u32x4*)(st + row * 144 + 16 * ch);
        for (int b = 0; b < nb; ++b) *(u32x4*)(dst + ((size_t)b * KROWS + 48 + row) * pitch + cb + 8 * ch) = x; }
    LDS_WAIT();
}
__device__ __forceinline__ void meta_p1(const Frame& F, CArgsP a) {
    unsigned char* ws = a->ws;
    const int t = F.vcu; if (t >= 88) return;
    const int lane = F.lane, f0 = 32 * t, pn = f0 >> 7, jj = f0 & 127; const int prow[4] = {256 * pn + jj, 256 * pn + jj + 16, 256 * pn + 128 + jj, 256 * pn + 128 + jj + 16};
    float v[4][4]; meta_block_mm<4, 4, 4>(F, (const bf16*)(ws + WS_META + MO_HBM), (const bf16*)(ws + WS_WGU1), prow, DM, v);
    if (F.wave != 0) return;
    bf16* actm = (bf16*)(ws + WS_META + MO_ACTM); const float* ssm = (const float*)(ws + WS_META + MO_SSM0);
#pragma unroll
    for (int r = 0; r < 4; ++r) { const int row = 4 * (lane >> 4) + r; const float rs = meta_rstd<16>(ssm, row);
        const float a0 = pg8::silu_mul(v[r][0] * rs, v[r][2] * rs), a1 = pg8::silu_mul(v[r][1] * rs, v[r][3] * rs);
        actm[row * FF + f0 + (lane & 15)] = (bf16)(pk2(a0, 0.f) & 0xffffu); actm[row * FF + f0 + 16 + (lane & 15)] = (bf16)(pk2(a1, 0.f) & 0xffffu); }
}
__device__ __forceinline__ void meta_p2(const Frame& F, CArgsP a) {
    unsigned char* ws = a->ws;
    if (F.vcu >= 64) return;
    const int t = F.vcu, lane = F.lane; const int prow[1] = {16 * t};
    float v[4][1]; meta_block_mm<11, 1, 11>(F, (const bf16*)(ws + WS_META + MO_ACTM), (const bf16*)(ws + WS_WD1), prow, FF, v);
    if (F.wave != 0) return;
    bf16* h1mb = (bf16*)(ws + WS_META + MO_H1MB); float* ssm1 = (float*)(ws + WS_META + MO_SSM1);
#pragma unroll
    for (int r = 0; r < 4; ++r) { const int row = 4 * (lane >> 4) + r; const int c = 16 * t + (lane & 15);
        const float h = a->in[1][row * DM + c] + 0.5f * v[r][0]; float sq = h * h; h1mb[row * DM + c] = (bf16)(pk2(h, 0.f) & 0xffffu);
        sq += __shfl_xor(sq, 1); sq += __shfl_xor(sq, 2); sq += __shfl_xor(sq, 4); sq += __shfl_xor(sq, 8);
        if ((lane & 15) == 0) ssm1[row * 64 + t] = sq; }
}
__device__ __forceinline__ void meta_p3(const Frame& F, CArgsP a) {
    unsigned char* ws = a->ws; const int lane = F.lane;
    if (F.vcu > 17) return;
    const bf16* A16 = (const bf16*)(ws + WS_META + MO_H1MB); const bf16* Wt = (const bf16*)(ws + WS_WIN); const float* ssm1 = (const float*)(ws + WS_META + MO_SSM1);
    if (F.vcu < 17) { const int t = F.vcu; int L, kind; if (t < 8) { L = 512 + 64 * t; kind = 1; } else if (t < 16) { L = 1024 + 64 * (t - 8); kind = 2; } else { L = 2816; kind = 3; }
        const int pn = L >> 8, wc = (L & 255) >> 6, base = 256 * pn + 32 * wc; const int prow[4] = {base, base + 16, base + 128, base + 144};
        float v[4][4]; meta_block_mm<4, 4, 4>(F, A16, Wt, prow, DM, v);
        if (F.wave != 0) return;
#pragma unroll
        for (int r = 0; r < 4; ++r) { const float rs = meta_rstd<64>(ssm1, 4 * (lane >> 4) + r);
#pragma unroll
            for (int j = 0; j < 4; ++j) v[r][j] *= rs;
            if (kind == 1) { float sq = (v[r][0] * v[r][0] + v[r][1] * v[r][1]) + (v[r][2] * v[r][2] + v[r][3] * v[r][3]);
                sq += __shfl_xor(sq, 1); sq += __shfl_xor(sq, 2); sq += __shfl_xor(sq, 4); sq += __shfl_xor(sq, 8);
                const float r2 = 1.0f / sqrtf(sq * (1.0f / 64.0f) + EPS);
#pragma unroll
                for (int j = 0; j < 4; ++j) v[r][j] *= r2 * a->in[10][16 * j + (lane & 15)]; } }
        if (kind == 1) meta_store_rows(F, v, (bf16*)(ws + WS_KA), 512, L - 512, NB);
        else if (kind == 2) meta_store_rows(F, v, (bf16*)(ws + WS_VA), 512, L - 1024, NB);
        else meta_store_rows(F, v, (bf16*)(ws + WS_IK), 64, 0, NB);
    } else {
        float v8[2][4][8]; float sq[4] = {0.f, 0.f, 0.f, 0.f};
#pragma unroll
        for (int c = 0; c < 2; ++c) { const int b0 = 2048 + 32 * (2 * c), b1 = 2048 + 32 * (2 * c + 1); const int prow[8] = {b0, b0 + 16, b0 + 128, b0 + 144, b1, b1 + 16, b1 + 128, b1 + 144};
            meta_block_mm<4, 8, 4>(F, A16, Wt, prow, DM, v8[c]); }
        if (F.wave != 0) return;
        float v[4][4][4];
#pragma unroll
        for (int r = 0; r < 4; ++r) { const float rs = meta_rstd<64>(ssm1, 4 * (lane >> 4) + r);
#pragma unroll
            for (int g = 0; g < 4; ++g)
#pragma unroll
                for (int j = 0; j < 4; ++j) { v[g][r][j] = v8[g >> 1][r][4 * (g & 1) + j] * rs; sq[r] += v[g][r][j] * v[g][r][j]; }
            sq[r] += __shfl_xor(sq[r], 1); sq[r] += __shfl_xor(sq[r], 2); sq[r] += __shfl_xor(sq[r], 4); sq[r] += __shfl_xor(sq[r], 8);
            const float r2 = 1.0f / sqrtf(sq[r] * (1.0f / 256.0f) + EPS);
#pragma unroll
            for (int g = 0; g < 4; ++g)
#pragma unroll
                for (int j = 0; j < 4; ++j) v[g][r][j] *= r2 * a->in[16][64 * g + 16 * j + (lane & 15)]; }
#pragma unroll
        for (int g = 0; g < 4; ++g) meta_store_rows(F, v[g], (bf16*)(ws + WS_C), 256, 64 * g, 1);
    }
}

__device__ __forceinline__ void meta_p4(const Frame& F, CArgsP a) {
    unsigned char* ws = a->ws; const int lane = F.lane;
    if (F.vcu >= 16) return;
    const int t = F.vcu; const int prow[4] = {64 * t, 64 * t + 16, 64 * t + 32, 64 * t + 48};
    float v[4][4]; meta_block_mm<1, 4, 1>(F, (const bf16*)(ws + WS_C) + (size_t)48 * 256, (const bf16*)(ws + WS_WKV), prow, 256, v);
    if (F.wave != 0) return;
    meta_store_rows(F, v, (bf16*)(ws + (t < 8 ? WS_KK : WS_VV)), 512, 64 * (t & 7), NB);
}

#define XB_TMO      128
#define XB_XCNT(j)  (256  + 64 * (j))
#define XB_XSUB(j)  (1280 + 64 * (j))
#define XB_XGEN(j)  (2304 + 64 * (j))
#define XB_TOP      3328
#define XB_TOPGEN   3392
#define XCD_BAR_WORDS 3456
#define XB_SPIN_CAP (1u << 18)

__device__ __forceinline__ unsigned xb_ld(unsigned* p)              { return __hip_atomic_load(p, __ATOMIC_RELAXED, __HIP_MEMORY_SCOPE_AGENT); }
__device__ __forceinline__ unsigned xb_add(unsigned* p, unsigned v) { return __hip_atomic_fetch_add(p, v, __ATOMIC_RELAXED, __HIP_MEMORY_SCOPE_AGENT); }
__device__ __forceinline__ unsigned xb_xcc_id() { return (unsigned)__builtin_amdgcn_s_getreg((3 << 11) | 20) & 0xFu; }
#define XB_SPIN(cond, bar) do { unsigned _sp = 0; while (cond) { __builtin_amdgcn_s_sleep(1); \
    if ((++_sp & 255u) == 0u) { if (xb_ld(&(bar)[XB_TMO])) break; if (_sp > XB_SPIN_CAP) { atomicAdd(&(bar)[XB_TMO], 1u); break; } } } } while (0)

struct XcdBarrier {
    unsigned* bar; unsigned x; int w;
    volatile LAS unsigned* st;
};

__device__ __forceinline__ XcdBarrier xcd_barrier_post(unsigned* bar, volatile LAS unsigned* st) {
    XcdBarrier b; b.bar = bar; b.x = xb_xcc_id(); b.st = st;
    if (threadIdx.x == 0) (void)xb_add(&bar[XB_XCNT(b.x)], 1u);
    return b;
}
__device__ __forceinline__ void xcd_barrier_complete(unsigned* bar, unsigned x, unsigned& nloc, unsigned& nx) {
    const unsigned G = gridDim.x * gridDim.y * gridDim.z;
    unsigned sum, cnt, mine, sp = 0u;
    for (;;) {
        sum = 0u; cnt = 0u; mine = 0u;
#pragma unroll
        for (unsigned j = 0; j < 16; ++j) { const unsigned c = xb_ld(&bar[XB_XCNT(j)]); sum += c; cnt += (c > 0u) ? 1u : 0u; mine = (j == x) ? c : mine; }
        if (sum == G) break;
        __builtin_amdgcn_s_sleep(1);
        if ((++sp & 255u) == 0u) { if (xb_ld(&bar[XB_TMO])) break; if (sp > XB_SPIN_CAP) { atomicAdd(&bar[XB_TMO], 1u); break; } }
    }
    nloc = mine > 0u ? mine : 1u; nx = cnt > 0u ? cnt : 1u;
}

__device__ __forceinline__ void xcd_barrier(const XcdBarrier& b) {
    asm volatile("s_waitcnt vmcnt(0)" ::: "memory");
    __syncthreads();
    if (b.w == 0 && pg8::lane_id() == 0) {
        unsigned* bar = b.bar;
        __builtin_amdgcn_s_waitcnt(0);
        unsigned nloc = b.st[0], nx = b.st[1];
        if (nloc == 0u) { xcd_barrier_complete(bar, b.x, nloc, nx); b.st[0] = nloc; b.st[1] = nx; }
        const unsigned old = xb_add(&bar[XB_XSUB(b.x)], 1u);
        const unsigned gen = old / nloc;
        if (old + 1u == (gen + 1u) * nloc) {
            __builtin_amdgcn_fence(__ATOMIC_RELEASE, "agent");
            asm volatile("s_waitcnt vmcnt(0)" ::: "memory");
            const unsigned og = xb_add(&bar[XB_TOP], 1u);
            const unsigned tg = og / nx;
            if (og + 1u == (tg + 1u) * nx) xb_add(&bar[XB_TOPGEN], 1u);
            else XB_SPIN(xb_ld(&bar[XB_TOPGEN]) == tg, bar);
            __builtin_amdgcn_fence(__ATOMIC_ACQUIRE, "agent");
            xb_add(&bar[XB_XGEN(b.x)], 1u);
            asm volatile("s_waitcnt vmcnt(0)" ::: "memory");
        } else {
            XB_SPIN(xb_ld(&bar[XB_XGEN(b.x)]) == gen, bar);
            __builtin_amdgcn_fence(__ATOMIC_ACQUIRE, "agent");
            asm volatile("s_waitcnt vmcnt(0)" ::: "memory");
        }
    }
    __syncthreads();
}
constexpr int G4 = 1040, TROW = 272, TILEB = 16 * G4  , BUFB = 2 * TILEB  ;
__device__ __forceinline__ unsigned offg(unsigned row, unsigned ch) { return (row >> 2) * (unsigned)G4 + (row & 3u) * 256u + 16u * (ch ^ (4u * (row & 3u))); }
__device__ __constant__ unsigned char kBucket[128] = {
    0, 1, 2, 3, 4, 5, 6, 7, 8, 9, 10, 11, 12, 13, 14, 15, 16, 16, 16, 17, 17, 18, 18, 18, 19, 19, 19, 20, 20, 20, 20, 21, 21, 21, 21, 22, 22, 22, 22, 22, 23, 23, 23, 23, 23, 23, 24, 24, 24, 24, 24, 24,
    25, 25, 25, 25, 25, 25, 25, 26, 26, 26, 26, 26, 26, 26, 26, 27, 27, 27, 27, 27, 27, 27, 27, 27, 27, 28, 28, 28, 28, 28, 28, 28, 28, 28, 28, 29, 29, 29, 29, 29, 29, 29, 29, 29, 29, 29, 29,
    30, 30, 30, 30, 30, 30, 30, 30, 30, 30, 30, 30, 30, 30, 31, 31, 31, 31, 31, 31, 31, 31, 31, 31, 31, 31, 31, 31, 31};
__device__ __forceinline__ unsigned piece_src(int lane, unsigned RP) { const unsigned j = (unsigned)lane >> 4; return j * RP + 16u * (((unsigned)lane & 15u) ^ (4u * j)); }
__device__ __forceinline__ void dma_piece(const void* gbase  , unsigned voff, unsigned m0v  ) {
    unsigned keep;
    asm volatile("s_mov_b32 %0, m0\n\ts_mov_b32 m0, %3\n\ts_nop 0\n\tglobal_load_lds_dwordx4 %1, %2\n\ts_mov_b32 m0, %0" : "=&s"(keep) : "v"(voff), "s"(gbase), "s"(m0v) : "memory");
}
__device__ __forceinline__ void tile_dma(const bf16* Kg, const bf16* Vg, LAS unsigned char* buf, int wid, int lane) {
    const bf16* k0 = Kg + (size_t)(8 * wid) * 512; const bf16* k1 = k0 + 4 * 512; const bf16* v0 = Vg + (size_t)(8 * wid) * 512; const bf16* v1 = v0 + 4 * 512;
    const unsigned mk = (unsigned)__builtin_amdgcn_readfirstlane((int)(unsigned)(uintptr_t)(buf + 2 * wid * G4)), mv = mk + TILEB;
    const unsigned vo = piece_src(lane, 1024u); unsigned keep;
    asm volatile("s_mov_b32 %0, m0\n\t"
                 "s_mov_b32 m0, %6\n\ts_nop 0\n\tglobal_load_lds_dwordx4 %1, %2\n\t"
                 "s_add_u32 m0, m0, 0x410\n\ts_nop 0\n\tglobal_load_lds_dwordx4 %1, %3\n\t"
                 "s_mov_b32 m0, %7\n\ts_nop 0\n\tglobal_load_lds_dwordx4 %1, %4\n\t"
                 "s_add_u32 m0, m0, 0x410\n\ts_nop 0\n\tglobal_load_lds_dwordx4 %1, %5\n\t"
                 "s_mov_b32 m0, %0"
                 : "=&s"(keep) : "v"(vo), "s"(k0), "s"(k1), "s"(v0), "s"(v1), "s"(mk), "s"(mv) : "memory", "scc");
}
#define DMA_WAIT() asm volatile("s_waitcnt vmcnt(0)" ::: "memory")
__device__ __forceinline__ void store_rows_via_lds(const f32x16 (&o)[4], float sc, const float* gain, LAS unsigned char* stage, bf16* grow0  , int lane) {
    const int r32 = lane & 31, hi = lane >> 5;
#pragma unroll
    for (int dt = 0; dt < 4; ++dt)
#pragma unroll
        for (int g = 0; g < 4; ++g) { const int d0 = 32 * dt + 8 * g + 4 * hi; f32x4 gn = {1.f, 1.f, 1.f, 1.f}; if (gain) gn = *(const f32x4*)(gain + d0);
            u32x2 w; w.x = pk2(o[dt][4 * g] * sc * gn[0], o[dt][4 * g + 1] * sc * gn[1]); w.y = pk2(o[dt][4 * g + 2] * sc * gn[2], o[dt][4 * g + 3] * sc * gn[3]);
            *(LAS u32x2*)(stage + r32 * TROW + d0 * 2) = w; }
    LDS_WAIT();
#pragma unroll
    for (int i = 0; i < 8; ++i) { const int row = 4 * i + (lane >> 4), ch = lane & 15; const u32x4 v = *(const LAS u32x4*)(stage + row * TROW + ch * 16);
        *(u32x4*)(grow0 + (size_t)row * 1024 + ch * 8) = v; }
}
__device__ __forceinline__ unsigned xch(int c, int j) { return 16u * (unsigned)(c ^ (4 * j)); }
typedef short v4i16_t __attribute__((ext_vector_type(4)));
__device__ __forceinline__ s16x4 vtr(const LAS unsigned char* p) { return __builtin_bit_cast(s16x4, __builtin_amdgcn_ds_read_tr16_b64_v4i16((LAS v4i16_t*)p)); }
__device__ __forceinline__ bf16x8 vfrag(const LAS unsigned char* Vb, int lane, int kb, int sp, int dt) {
    const int hi = lane >> 5, blk = (lane >> 4) & 1, qq = (lane & 15) >> 2, p = lane & 3;
    const unsigned ch = 4 * dt + 2 * blk + (p >> 1);
    const unsigned r0 = 32 * kb + 16 * sp + 4 * hi + qq;
    const s16x4 lo = vtr(Vb + offg(r0, ch) + 8 * (p & 1)), hh = vtr(Vb + offg(r0 + 8, ch) + 8 * (p & 1));
    return (bf16x8){lo[0], lo[1], lo[2], lo[3], hh[0], hh[1], hh[2], hh[3]};
}
__device__ __forceinline__ bf16x8 pack8(const f32x16& x, int s) {
    u32x4 p; p.x = pk2(x[8 * s], x[8 * s + 1]); p.y = pk2(x[8 * s + 2], x[8 * s + 3]); p.z = pk2(x[8 * s + 4], x[8 * s + 5]); p.w = pk2(x[8 * s + 6], x[8 * s + 7]);
    return __builtin_bit_cast(bf16x8, p);
}
__device__ __forceinline__ void build_lut(LAS float* lut, const float* rel_bias, int col, int tid) {
    if (tid < 128) lut[tid] = rel_bias[kBucket[tid] * 8 + col] * LOG2E;
}

constexpr int LDS_AQ = 67072;
__device__ __forceinline__ void exp_block(f32x16& s, const LAS float* lut, bool interior, int kr0, int qrow, int hi, float& l) {
    if (interior) {
#pragma unroll
        for (int r = 0; r < 16; ++r) { s[r] = __builtin_amdgcn_exp2f(s[r]); l += s[r]; } }
    else {
#pragma unroll
        for (int r = 0; r < 16; ++r) { const int kr = kr0 + crow(r, hi), n = qrow - kr; const bool ok = (n >= 0) && (kr >= 48);
            const int idx = n < 0 ? 0 : (n > 127 ? 127 : n); const float e = __builtin_amdgcn_exp2f(s[r] + lut[idx]);
            s[r] = ok ? e : 0.f; l += s[r];
            if ((r & 3) == 3) asm volatile("" ::: "memory"); } }
}
__device__ __forceinline__ void attnA_unit(const Frame& F, CArgsP a, int b, int head, int qb8, float lam, int abl) {
    unsigned char* ws = a->ws; const int tid = F.tid, lane = F.lane, wid = F.wave, r32 = lane & 31, hi = lane >> 5;
    LAS unsigned char* lds = F.lds; LAS float* lut = (LAS float*)(lds + LDS_LUT);
    const int qrow0 = 64 + 256 * qb8 + 32 * wid, qrow = qrow0 + r32;
    const size_t gq = (size_t)b * SEQ + 256 * qb8 + 32 * wid + r32;
    const bf16* Kg = (const bf16*)(ws + WS_KA) + (size_t)b * KROWS * 512 + head * 128;
    const bf16* Vg = (const bf16*)(ws + WS_VA) + (size_t)b * KROWS * 512 + head * 128;
    const int nt = 4 * qb8 + 5, wlast = (qrow0 + 31) >> 6;
    tile_dma(Kg, Vg, lds, wid, lane);
    build_lut(lut, a->in[2], head, tid);
    { const bf16* qg = (const bf16*)(ws + WS_QA) + ((size_t)b * SEQ + 256 * qb8 + 32 * wid) * 512 + head * 128;
      const unsigned mq = (unsigned)__builtin_amdgcn_readfirstlane((int)(unsigned)(uintptr_t)(lds + LDS_AQ + 8 * wid * G4)); const unsigned vo = piece_src(lane, 1024u);
#pragma unroll
      for (int i = 0; i < 8; ++i) dma_piece(qg + (size_t)(4 * i) * 512, vo, mq + i * G4); }
    const int j4 = r32 & 3;
    const LAS unsigned char* qb_ = lds + LDS_AQ + (8 * wid + (r32 >> 2)) * G4 + j4 * 256;
    float l1 = 0.f, l2 = 0.f;
    f32x16 o1[4], o2[4];
#pragma unroll
    for (int dt = 0; dt < 4; ++dt) { o1[dt] = (f32x16){}; o2[dt] = (f32x16){}; }
    DMA_WAIT(); __syncthreads();
#pragma unroll 1
    for (int jt = 0; jt < nt; ++jt) {
        LAS unsigned char* cur = lds + (jt & 1) * BUFB; LAS unsigned char* nxt = lds + ((jt + 1) & 1) * BUFB;
        if (jt + 1 < nt && !(abl & 1)) tile_dma(Kg + (size_t)(jt + 1) * 64 * 512, Vg + (size_t)(jt + 1) * 64 * 512, nxt, wid, lane);
        if (jt <= wlast && !(abl & 2)) {
#pragma unroll 1
            for (int kb = 0; kb < 2; ++kb) { const int kr0 = 64 * jt + 32 * kb;
                if (kr0 <= qrow0 + 31) {
                    const LAS unsigned char* kbase = cur + (8 * kb + (r32 >> 2)) * G4 + j4 * 256;
                    const bool interior = (kr0 >= 64) && (kr0 + 31 + 113 <= qrow0);
                    bf16x8 p1a, p1b, p2a, p2b;
                    const float c0 = interior ? lut[127] : 0.f;
                    f32x16 s1, s2;
#pragma unroll
                    for (int r = 0; r < 16; ++r) { s1[r] = c0; s2[r] = c0; }
#pragma unroll
                    for (int s = 0; s < 4; ++s) { const unsigned x = xch(2 * s + hi, j4); const bf16x8 kf = *(const LAS bf16x8*)(kbase + x); const bf16x8 qf = *(const LAS bf16x8*)(qb_ + x); s1 = MFMA32(kf, qf, s1); }
#pragma unroll
                    for (int s = 0; s < 4; ++s) { const unsigned x = xch(8 + 2 * s + hi, j4); const bf16x8 kf = *(const LAS bf16x8*)(kbase + x); const bf16x8 qf = *(const LAS bf16x8*)(qb_ + x); s2 = MFMA32(kf, qf, s2); }
                    exp_block(s1, lut, interior, kr0, qrow, hi, l1); p1a = pack8(s1, 0); p1b = pack8(s1, 1);
                    exp_block(s2, lut, interior, kr0, qrow, hi, l2); p2a = pack8(s2, 0); p2b = pack8(s2, 1);
                    const LAS unsigned char* vb = cur + TILEB + kb * (8 * G4);
#pragma unroll
                    for (int dt = 0; dt < 4; ++dt) { const bf16x8 v0 = vfrag(vb, lane, 0, 0, dt), v1 = vfrag(vb, lane, 0, 1, dt);
                        o1[dt] = MFMA32(v0, p1a, o1[dt]); o2[dt] = MFMA32(v0, p2a, o2[dt]); o1[dt] = MFMA32(v1, p1b, o1[dt]); o2[dt] = MFMA32(v1, p2b, o2[dt]); }
                } }
        }
        DMA_WAIT(); __syncthreads();
    }
    l1 += __shfl_xor(l1, 32); l2 += __shfl_xor(l2, 32);
    const float c1 = 1.0f / l1, c2 = lam / l2;
    float sq = 0.f;
#pragma unroll
    for (int dt = 0; dt < 4; ++dt)
#pragma unroll
        for (int r = 0; r < 16; ++r) { o1[dt][r] = o1[dt][r] * c1 - o2[dt][r] * c2; sq += o1[dt][r] * o1[dt][r]; }
    sq += __shfl_xor(sq, 32);
    const float rs = SUBLN_SCALE / sqrtf(sq * (1.0f / 128.0f) + EPS);
    store_rows_via_lds(o1, rs, a->in[15], lds + wid * (32 * TROW), (bf16*)a->out + (gq - r32) * 1024 + head * 128, lane);
    __syncthreads();
}

__device__ __forceinline__ void attnB_unit(const Frame& F, CArgsP a, int b, int head, int qb8, int abl) {
    unsigned char* ws = a->ws; const int tid = F.tid, lane = F.lane, wid = F.wave, r32 = lane & 31, hi = lane >> 5;
    LAS unsigned char* lds = F.lds; LAS float* lut = (LAS float*)(lds + LDS_LUT);
    const int qrow0 = 64 + 256 * qb8 + 32 * wid, qrow = qrow0 + r32;
    const size_t gq = (size_t)b * SEQ + 256 * qb8 + 32 * wid + r32;
    const bf16* Kg = (const bf16*)(ws + WS_KK) + (size_t)b * KROWS * 512 + head * 128;
    const bf16* Vg = (const bf16*)(ws + WS_VV) + (size_t)b * KROWS * 512 + head * 128;
    const unsigned* selp = (const unsigned*)(ws + WS_SEL) + gq * SELW;
    const int nt = 4 * qb8 + 5, wlast = (qrow0 + 31) >> 6;
    tile_dma(Kg, Vg, lds, wid, lane);
    build_lut(lut, a->in[2], 4 + head, tid);
    const int j4 = r32 & 3;
    bf16x8 qf[8];
    { const bf16* qp = (const bf16*)(ws + WS_QB) + gq * 512 + head * 128 + 8 * hi;
#pragma unroll
      for (int s = 0; s < 8; ++s) qf[s] = *(const bf16x8*)(qp + 16 * s); }
    float ysq = 0.f;
    if (!(abl & 128)) {
        { const unsigned char* wg = ws + WS_WUKT + (size_t)head * 256 * 256 + (size_t)(32 * wid) * 256;
          const unsigned mb = (unsigned)__builtin_amdgcn_readfirstlane((int)(unsigned)(uintptr_t)(lds + LDS_AQ + 8 * wid * G4)); const unsigned vo = piece_src(lane, 256u);
#pragma unroll
          for (int i = 0; i < 8; ++i) dma_piece(wg + i * 4 * 256, vo, mb + i * G4); }
        DMA_WAIT(); __syncthreads();
        const LAS unsigned char* wb = lds + LDS_AQ + (r32 >> 2) * G4 + j4 * 256;
#pragma unroll 2
        for (int ct = 0; ct < 8; ++ct) { f32x16 y = (f32x16){};
#pragma unroll
            for (int s = 0; s < 8; ++s) { const bf16x8 wf = *(const LAS bf16x8*)(wb + ct * (8 * G4) + xch(2 * s + hi, j4)); y = MFMA32(wf, qf[s], y); }
#pragma unroll
            for (int r = 0; r < 16; ++r) ysq += y[r] * y[r]; }
    }
    ysq += __shfl_xor(ysq, 32);
    const float scq = B_QSCALE / sqrtf(ysq * (1.0f / 256.0f) + EPS);
    float l = 0.f;
    f32x16 o[4];
#pragma unroll
    for (int dt = 0; dt < 4; ++dt) o[dt] = (f32x16){};
    u32x2 mw = *(const u32x2*)(selp), mwn = mw;
    DMA_WAIT(); __syncthreads();
#pragma unroll 1
    for (int jt = 0; jt < nt; ++jt) {
        LAS unsigned char* cur = lds + (jt & 1) * BUFB; LAS unsigned char* nxt = lds + ((jt + 1) & 1) * BUFB;
        if (jt + 1 < nt) { if (!(abl & 1)) tile_dma(Kg + (size_t)(jt + 1) * 64 * 512, Vg + (size_t)(jt + 1) * 64 * 512, nxt, wid, lane); mwn = *(const u32x2*)(selp + 2 * (jt + 1)); }
        if (wid >= 4 && 64 * jt + 63 + 113 <= qrow0 && !(abl & 2)) {
            const LAS unsigned char* kb0 = cur + (r32 >> 2) * G4 + j4 * 256; const float bf = lut[127];
            f32x16 sa = (f32x16){}, sb = (f32x16){};
#pragma unroll
            for (int s = 0; s < 8; ++s) { const bf16x8 kf = *(const LAS bf16x8*)(kb0 + xch(2 * s + hi, j4)); sa = MFMA32(kf, qf[s], sa); }
#pragma unroll
            for (int s = 0; s < 8; ++s) { const bf16x8 kf = *(const LAS bf16x8*)(kb0 + 8 * G4 + xch(2 * s + hi, j4)); sb = MFMA32(kf, qf[s], sb); }
            const int mha = (int)(mw.x >> (4 * hi)), mhb = (int)(mw.y >> (4 * hi));
#pragma unroll
            for (int r = 0; r < 16; ++r) { const float e = __builtin_amdgcn_exp2f(sa[r] * scq + bf); sa[r] = __uint_as_float(__float_as_uint(e) & (unsigned)__builtin_amdgcn_sbfe(mha, (r & 3) + 8 * (r >> 2), 1)); l += sa[r]; }
            { const bf16x8 pa0 = pack8(sa, 0), pa1 = pack8(sa, 1); const LAS unsigned char* vb = cur + TILEB;
#pragma unroll
              for (int dt = 0; dt < 4; ++dt) { const bf16x8 v0 = vfrag(vb, lane, 0, 0, dt), v1 = vfrag(vb, lane, 0, 1, dt); o[dt] = MFMA32(v0, pa0, o[dt]); o[dt] = MFMA32(v1, pa1, o[dt]); } }
#pragma unroll
            for (int r = 0; r < 16; ++r) { const float e = __builtin_amdgcn_exp2f(sb[r] * scq + bf); sb[r] = __uint_as_float(__float_as_uint(e) & (unsigned)__builtin_amdgcn_sbfe(mhb, (r & 3) + 8 * (r >> 2), 1)); l += sb[r]; }
            { const bf16x8 pa0 = pack8(sb, 0), pa1 = pack8(sb, 1); const LAS unsigned char* vb = cur + TILEB + 8 * G4;
#pragma unroll
              for (int dt = 0; dt < 4; ++dt) { const bf16x8 v0 = vfrag(vb, lane, 0, 0, dt), v1 = vfrag(vb, lane, 0, 1, dt); o[dt] = MFMA32(v0, pa0, o[dt]); o[dt] = MFMA32(v1, pa1, o[dt]); } }
        } else
        if (jt <= wlast && !(abl & 2)) {
#pragma unroll
            for (int kb = 0; kb < 2; ++kb) { const int kr0 = 64 * jt + 32 * kb;
                if (kr0 <= qrow0 + 31) {
                    const LAS unsigned char* kbase = cur + (8 * kb + (r32 >> 2)) * G4 + j4 * 256;
                    f32x16 s1 = (f32x16){};
#pragma unroll
                    for (int s = 0; s < 8; ++s) { const bf16x8 kf = *(const LAS bf16x8*)(kbase + xch(2 * s + hi, j4)); s1 = MFMA32(kf, qf[s], s1); }
                    const int mh = (int)((kb ? mw.y : mw.x) >> (4 * hi));
                    const bool interior = (kr0 + 31 + 113 <= qrow0);
                    if (interior) { const float bf = lut[127];
#pragma unroll
                        for (int r = 0; r < 16; ++r) { const float e = __builtin_amdgcn_exp2f(s1[r] * scq + bf); s1[r] = __uint_as_float(__float_as_uint(e) & (unsigned)__builtin_amdgcn_sbfe(mh, (r & 3) + 8 * (r >> 2), 1)); } }
                    else {
#pragma unroll
                        for (int r = 0; r < 16; ++r) { const int kr = kr0 + crow(r, hi), n = qrow - kr; const int idx = n < 0 ? 0 : (n > 127 ? 127 : n);
                            const float e = __builtin_amdgcn_exp2f(s1[r] * scq + lut[idx]); s1[r] = __uint_as_float(__float_as_uint(e) & (unsigned)__builtin_amdgcn_sbfe(mh, (r & 3) + 8 * (r >> 2), 1)); } }
#pragma unroll
                    for (int r = 0; r < 16; ++r) l += s1[r];
                    const bf16x8 pa0 = pack8(s1, 0), pa1 = pack8(s1, 1);
                    const LAS unsigned char* vb = cur + TILEB + kb * (8 * G4);
#pragma unroll
                    for (int dt = 0; dt < 4; ++dt) { const bf16x8 v0 = vfrag(vb, lane, 0, 0, dt), v1 = vfrag(vb, lane, 0, 1, dt);
                        o[dt] = MFMA32(v0, pa0, o[dt]); o[dt] = MFMA32(v1, pa1, o[dt]); }
                } }
        }
        mw = mwn;
        DMA_WAIT(); __syncthreads();
    }
    l += __shfl_xor(l, 32);
    const float il = 1.0f / l;
    if (!(abl & 256)) store_rows_via_lds(o, il, nullptr, lds + wid * (32 * TROW), (bf16*)a->out + (gq - r32) * 1024 + 512 + head * 128, lane);
    __syncthreads();
}
__device__ __forceinline__ unsigned lanes_below(unsigned long long m) { return __builtin_amdgcn_mbcnt_hi((unsigned)(m >> 32), __builtin_amdgcn_mbcnt_lo((unsigned)m, 0u)); }
#define DPP_STEP(OP, v, ctrl, rmask, ident) { const int t_ = __builtin_amdgcn_update_dpp((int)(ident), (int)(v), (ctrl), (rmask), 0xf, false); v = OP(v, (decltype(v))t_); }
__device__ __forceinline__ unsigned umax2(unsigned a, unsigned b) { return a > b ? a : b; }
__device__ __forceinline__ unsigned umin2(unsigned a, unsigned b) { return a < b ? a : b; }
__device__ __forceinline__ int iadd2(int a, int b) { return a + b; }
__device__ __forceinline__ unsigned wave_umax(unsigned v) { DPP_STEP(umax2, v, 0x111, 0xf, 0u) DPP_STEP(umax2, v, 0x112, 0xf, 0u) DPP_STEP(umax2, v, 0x114, 0xf, 0u) DPP_STEP(umax2, v, 0x118, 0xf, 0u) DPP_STEP(umax2, v, 0x142, 0xa, 0u) DPP_STEP(umax2, v, 0x143, 0xc, 0u)
    return (unsigned)__builtin_amdgcn_readlane((int)v, 63); }
__device__ __forceinline__ unsigned wave_umin(unsigned v) { DPP_STEP(umin2, v, 0x111, 0xf, 0xffffffffu) DPP_STEP(umin2, v, 0x112, 0xf, 0xffffffffu) DPP_STEP(umin2, v, 0x114, 0xf, 0xffffffffu) DPP_STEP(umin2, v, 0x118, 0xf, 0xffffffffu) DPP_STEP(umin2, v, 0x142, 0xa, 0xffffffffu) DPP_STEP(umin2, v, 0x143, 0xc, 0xffffffffu)
    return (unsigned)__builtin_amdgcn_readlane((int)v, 63); }
__device__ __forceinline__ int wave_isum(int v) { DPP_STEP(iadd2, v, 0x111, 0xf, 0) DPP_STEP(iadd2, v, 0x112, 0xf, 0) DPP_STEP(iadd2, v, 0x114, 0xf, 0) DPP_STEP(iadd2, v, 0x118, 0xf, 0) DPP_STEP(iadd2, v, 0x142, 0xa, 0) DPP_STEP(iadd2, v, 0x143, 0xc, 0)
    return __builtin_amdgcn_readlane(v, 63); }
#define WRITELANE(src, l, old) do { const int s__ = __builtin_amdgcn_readfirstlane(src); asm volatile("s_nop 3\n\tv_writelane_b32 %0, %1, %2" : "+v"(old) : "s"(s__), "n"(l)); } while (0)
template <int NI> __device__ __forceinline__ void select8(unsigned char* ws, const float* sc, int b, int q0, int wid, int lane, int abl) {
    unsigned raw[NI];
    { const unsigned* srow = (const unsigned*)(sc + (size_t)(8 * wid) * SCP);
#pragma unroll
      for (int i = 0; i < NI; ++i) raw[i] = __hip_atomic_load(srow + 64 * i + lane, __ATOMIC_RELAXED, __HIP_MEMORY_SCOPE_AGENT); }
#pragma unroll 1
    for (int qq = 0; qq < 8; ++qq) { const int ql = 8 * wid + qq, t = q0 + ql, qrow = 64 + t, nvalid = t + 17;
        unsigned w[NI];
#pragma unroll
        for (int i = 0; i < NI; ++i) { const int kr = 64 * i + lane; w[i] = ((kr >= 48) && (kr <= qrow)) ? raw[i] : 0u; }
        if (qq < 7 && !(abl & 64)) { const unsigned* srow = (const unsigned*)(sc + (size_t)(ql + 1) * SCP);
#pragma unroll
            for (int i = 0; i < NI; ++i) raw[i] = __hip_atomic_load(srow + 64 * i + lane, __ATOMIC_RELAXED, __HIP_MEMORY_SCOPE_AGENT); }
        unsigned thr = 0u; int quota = 0;
        if (nvalid > 256 && !(abl & 16)) {
            unsigned mn = 0x7fffffffu, mx = 0u;
#pragma unroll
            for (int i = 0; i < NI; ++i) { mx = w[i] > mx ? w[i] : mx; const unsigned v = w[i] ? w[i] : 0x7fffffffu; mn = v < mn ? v : mn; }
            mx = wave_umax(mx); mn = wave_umin(mn);
            unsigned lo = mn, hi = mx + 1u; int chi = 0; bool exact = false;
#pragma unroll 1
            while (hi - lo > 1u) { const unsigned cand = lo + ((hi - lo) >> 1);
                unsigned acc0 = 0u, acc1 = 0u;
#pragma unroll
                for (int i = 0; i < NI; ++i) { const unsigned d = w[i] - cand; if (i & 1) acc1 = __builtin_amdgcn_alignbit(acc1, d, 31); else acc0 = __builtin_amdgcn_alignbit(acc0, d, 31); }
                const int lt = wave_isum(__popc(acc0) + __popc(acc1));
                const int cnt = 64 * NI - lt;
                if (cnt == 256) { lo = cand; exact = true; break; }
                if (cnt > 256) lo = cand; else { hi = cand; chi = cnt; } }
            if (exact) { thr = lo - 1u; quota = 0; } else { thr = lo; quota = 256 - chi; }
        }
        int wlo = 0, whi = 0;
        if (!(abl & 32)) {
            if (quota == 0) {
#pragma unroll
                for (int i = 0; i < NI; ++i) { const unsigned long long bs = __ballot(w[i] > thr);
                    WRITELANE((int)(unsigned)bs, i, wlo); WRITELANE((int)(unsigned)(bs >> 32), i, whi); } }
            else { int tiebase = 0;
#pragma unroll
                for (int i = 0; i < NI; ++i) { const bool gt = w[i] > thr, eq = (w[i] == thr);
                    const unsigned long long be = __ballot(eq); const int rank = tiebase + (int)lanes_below(be);
                    const unsigned long long bs = __ballot(gt || (eq && rank < quota));
                    WRITELANE((int)(unsigned)bs, i, wlo); WRITELANE((int)(unsigned)(bs >> 32), i, whi);
                    tiebase += __popcll(be); } } }
        if (lane < 33) { u32x2 w2; w2.x = (unsigned)wlo; w2.y = (unsigned)whi; *(u32x2*)((unsigned*)(ws + WS_SEL) + ((size_t)b * SEQ + t) * SELW + 2 * lane) = w2; }
    }
}
__device__ __forceinline__ void index_unit(const Frame& F, CArgsP a, int b, int j64, int abl) {
    unsigned char* ws = a->ws; const int lane = F.lane, wid = F.wave, r32 = lane & 31, hi = lane >> 5;
    float* sc = (float*)(ws + WS_SCR) + (size_t)blockIdx.x * 64 * SCP;
    const int q0 = 64 * j64;
    {
        const bf16* ip = (const bf16*)(ws + WS_IQ) + ((size_t)b * SEQ + q0) * 512;
#pragma unroll
        for (int i = 0; i < 8; ++i) { const int c = F.tid + 512 * i, row = c >> 6, ch = c & 63; *(LAS u32x4*)(F.lds + 1040 * row + 16 * ch) = *(const u32x4*)(ip + (size_t)row * 512 + ch * 8); }
    }
    __syncthreads();
    if (!(abl & 4)) {
        const int qi = wid & 1, kbq = wid >> 1, qrow0 = 64 + q0 + 32 * qi; const size_t gq = (size_t)b * SEQ + q0 + 32 * qi + r32;
        float wv[8];
        { const f32x4 w0 = *(const f32x4*)((const float*)(ws + WS_IW) + gq * 8), w1 = *(const f32x4*)((const float*)(ws + WS_IW) + gq * 8 + 4);
          wv[0] = w0[0]; wv[1] = w0[1]; wv[2] = w0[2]; wv[3] = w0[3]; wv[4] = w1[0]; wv[5] = w1[1]; wv[6] = w1[2]; wv[7] = w1[3]; }
        const LAS unsigned char* iql = F.lds + 1040 * (32 * qi + r32) + 16 * hi;
        const int ng = (q0 + 128 + 127) >> 7;
        const bf16* ikb = (const bf16*)(ws + WS_IK) + (size_t)b * KROWS * 64 + (size_t)r32 * 64 + 8 * hi;
        LAS unsigned char* stg = F.lds + 66560 + wid * 4608;
        bf16x8 ikn[4];
#pragma unroll
        for (int s = 0; s < 4; ++s) ikn[s] = *(const bf16x8*)(ikb + (size_t)(32 * kbq) * 64 + 16 * s);
#pragma unroll 1
        for (int g = 0; g < ng; ++g) { const int kr0 = 128 * g + 32 * kbq;
            if (kr0 > qrow0 + 31) break;
            asm volatile("" ::: "memory");
            bf16x8 ikf[4];
#pragma unroll
            for (int s = 0; s < 4; ++s) ikf[s] = ikn[s];
            { const int krn = kr0 + 128 <= KROWS - 32 ? kr0 + 128 : kr0;
#pragma unroll
              for (int s = 0; s < 4; ++s) ikn[s] = *(const bf16x8*)(ikb + (size_t)krn * 64 + 16 * s); }
            f32x16 score = (f32x16){};
#pragma unroll
            for (int h = 0; h < 8; ++h) { f32x16 acc = (f32x16){};
#pragma unroll
                for (int s = 0; s < 4; ++s) { const bf16x8 qf = *(const LAS bf16x8*)(iql + 128 * h + 32 * s); acc = MFMA32(ikf[s], qf, acc); }
#pragma unroll
                for (int r = 0; r < 16; ++r) score[r] += wv[h] * fmaxf(acc[r], 0.f);
                if (h & 1) __builtin_amdgcn_sched_barrier(0); }
#pragma unroll
            for (int g4 = 0; g4 < 4; ++g4) { u32x4 kv;
#pragma unroll
                for (int e = 0; e < 4; ++e) { unsigned bits = __float_as_uint(score[4 * g4 + e]); if (bits == 0x80000000u) bits = 0u; kv[e] = ((bits & 0x80000000u) ? ~bits : (bits | 0x80000000u)) >> 1; }
                *(LAS u32x4*)(stg + r32 * 144 + 32 * g4 + 16 * hi) = kv; }
            LDS_WAIT();
#pragma unroll
            for (int i = 0; i < 4; ++i) { const int row = 8 * i + (lane >> 3), ch = lane & 7; const u32x4 v = *(const LAS u32x4*)(stg + row * 144 + 16 * ch);
                *(u32x4*)(sc + (size_t)(32 * qi + row) * SCP + kr0 + 4 * ch) = v; }
            LDS_WAIT();
        }
    }
    VM_WAIT(); __syncthreads();
    if (!(abl & 8)) { const int ni = ((64 + q0 + 8 * wid + 7) >> 6) + 1;
      switch ((ni - 2) >> 2) {
        case 0: select8<5>(ws, sc, b, q0, wid, lane, abl); break;
        case 1: select8<9>(ws, sc, b, q0, wid, lane, abl); break;
        case 2: select8<13>(ws, sc, b, q0, wid, lane, abl); break;
        case 3: select8<17>(ws, sc, b, q0, wid, lane, abl); break;
        case 4: select8<21>(ws, sc, b, q0, wid, lane, abl); break;
        case 5: select8<25>(ws, sc, b, q0, wid, lane, abl); break;
        case 6: select8<29>(ws, sc, b, q0, wid, lane, abl); break;
        default: select8<33>(ws, sc, b, q0, wid, lane, abl); break;
      } }
    __syncthreads();
}

struct KvOrder : pg8::StaticOrder { __host__ __device__ int arow(int pm) const { return (pm >> 3) * KROWS + 64 + (pm & 7) * 256; } };
struct AblOrder : pg8::StaticOrder { int abl;
    __device__ bool next(int i, pg8::Unit& u) const { const bool r = pg8::StaticOrder::next(i, u); if (abl & 2) u.pm = 0; if (abl & 4) u.pn = 0; return r; } };
#ifndef PH
#define PH 0xFFFF
#endif
#ifndef DUP
#define DUP 0
#endif
#ifndef TIMING_KNOBS
#define TIMING_KNOBS 0
#endif
#if TIMING_KNOBS
#define PHASE(bit) _Pragma("unroll 1") for (int rep_ = 0, nrep_ = ((PH & (bit)) ? 1 + ((get_args()->dup & (bit)) ? 1 : 0) : 0); rep_ < nrep_; ++rep_)
#define ABL() ((nrep_ == 2 && rep_ == 0) ? (get_args()->dup >> 16) : 0)
#else
#define PHASE(bit) if (PH & (bit))
#define ABL() 0
#endif
#ifndef USE_XCD
#define USE_XCD 1
#endif
#if USE_XCD
#define GRID_SYNC() xcd_barrier(xbar)
#else
#define GRID_SYNC() grid.sync()
#endif
__global__ void __launch_bounds__(512, 2) fwd_megakernel(Args args_by_value) {
    extern __shared__ __attribute__((aligned(16))) unsigned char lds_raw[];
#if !USE_XCD
    cg::grid_group grid = cg::this_grid();
#endif
    LAS unsigned char* const lds0 = (LAS unsigned char*)lds_raw;
    const int wave_s = __builtin_amdgcn_readfirstlane((int)(threadIdx.x >> 6));
#if USE_XCD
    if (threadIdx.x < 4) ((LAS unsigned*)(lds0 + LDS_MISC))[threadIdx.x] = 0u;
    __syncthreads();
    XcdBarrier xbar = xcd_barrier_post((unsigned*)(get_args()->ws + WS_CTL), (volatile LAS unsigned*)(lds0 + LDS_MISC)); xbar.w = wave_s;
#endif
#define PHASE_VARS const Frame F = make_frame(lds0, wave_s); CArgsP a = get_args(); unsigned char* ws = a->ws; float* out = a->out; pg8::bf16_t* HB = (pg8::bf16_t*)(ws + WS_HB); pg8::bf16_t* ACT = (pg8::bf16_t*)(ws + WS_ACT); float* SSB = (float*)(ws + WS_SS); \
    PG8_LAS unsigned char* ring = (PG8_LAS unsigned char*)F.lds; (void)out; (void)HB; (void)ACT; (void)SSB; (void)ring
    PHASE(1) { PHASE_VARS; p0_prologue(F, a); }
    GRID_SYNC();
    PHASE(2) { PHASE_VARS; meta_p1(F, a);
      pg8::Gemm g{HB, (const pg8::bf16_t*)(ws + WS_WGU1), MX, NGU, DM}; AblOrder S; S.init(MX, NGU, F.G, (int)blockIdx.x); S.abl = ABL(); pg8::EpiGU E{ACT, SSB, ABL()};
      pg8::gemm_phase<pg8::EpiGU, AblOrder, true, true>(ring, g, S, E, wave_s); }
    GRID_SYNC();
    PHASE(4) { PHASE_VARS; meta_p2(F, a);
      pg8::Gemm g{ACT, (const pg8::bf16_t*)(ws + WS_WD1), MX, DM, FF}; pg8::StaticOrder S; S.init(MX, DM, F.G, (int)blockIdx.x); pg8::EpiResB<false, true> E{HB, HB, nullptr, SSB, 0.5f};
      pg8::gemm_phase<pg8::EpiResB<false, true>, pg8::StaticOrder, true, true>(ring, g, S, E, wave_s); }
    GRID_SYNC();
    PHASE(8) { PHASE_VARS; meta_p3(F, a);
      pg8::Gemm g{HB, (const pg8::bf16_t*)(ws + WS_WIN), MX, NINP, DM}; pg8::StaticOrder S; S.init(MX, NINP, F.G, (int)blockIdx.x);
      pg8::EpiIn E{(pg8::bf16_t*)(ws + WS_QA), (pg8::bf16_t*)(ws + WS_KA), (pg8::bf16_t*)(ws + WS_VA), (pg8::bf16_t*)(ws + WS_QB), (pg8::bf16_t*)(ws + WS_C), (pg8::bf16_t*)(ws + WS_IQ), (pg8::bf16_t*)(ws + WS_IK),
                   (float*)(ws + WS_IW), SSB, a->in[9], a->in[10], a->in[16], (PG8_LAS float*)(F.lds + LDS_XCH)};
      pg8::gemm_phase<pg8::EpiIn, pg8::StaticOrder, true, true>(ring, g, S, E, wave_s); }
    GRID_SYNC();
    PHASE(16) { PHASE_VARS; meta_p4(F, a);
      int kkv = 256; asm volatile("" : "+s"(kkv)); pg8::Gemm g{(const pg8::bf16_t*)(ws + WS_C), (const pg8::bf16_t*)(ws + WS_WKV), MX, 1024, kkv}; KvOrder S; S.init(MX, 1024, F.G, (int)blockIdx.x);
      pg8::EpiKV E{(pg8::bf16_t*)(ws + WS_KK), (pg8::bf16_t*)(ws + WS_VV)};
      pg8::gemm_phase<pg8::EpiKV, KvOrder, true, true>(ring, g, S, E, wave_s); }
    __syncthreads();
    PHASE(32) { _Pragma("unroll 1") for (int k = 0; k < 2; ++k) { const Frame F = make_frame(lds0, wave_s); CArgsP a = get_args(); const int b = F.vcu >> 4, s = F.vcu & 15; index_unit(F, a, b, k ? 31 - s : s, ABL()); } }
    PHASE(64) { float lam; { const int ln = pg8::lane_id(); CArgsP a = get_args(); const float d1 = wave_sum(a->in[11][ln] * a->in[12][ln]), d2 = wave_sum(a->in[13][ln] * a->in[14][ln]);
        lam = __uint_as_float((unsigned)__builtin_amdgcn_readfirstlane((int)__float_as_uint(__expf(d1) - __expf(d2) + LAM_INIT))); }
      _Pragma("unroll 1") for (int k = 0; k < 2; ++k) { const Frame F = make_frame(lds0, wave_s); CArgsP a = get_args(); const int bh = F.vcu >> 2, s = F.vcu & 3; attnA_unit(F, a, bh >> 2, bh & 3, k ? 7 - s : s, lam, ABL()); } }
    GRID_SYNC();
    PHASE(128) { _Pragma("unroll 1") for (int k = 0; k < 2; ++k) { const Frame F = make_frame(lds0, wave_s); CArgsP a = get_args(); const int bh = F.vcu >> 2, s = F.vcu & 3; attnB_unit(F, a, bh >> 2, bh & 3, k ? 7 - s : s, ABL()); } }
    GRID_SYNC();
    PHASE(256) { PHASE_VARS; pg8::Gemm g{(const pg8::bf16_t*)out, (const pg8::bf16_t*)(ws + WS_WOUT), MX, DM, DM}; pg8::StaticOrder S; S.init(MX, DM, F.G, (int)blockIdx.x); pg8::EpiResB<false, true> E{HB, (pg8::bf16_t*)(ws + WS_H2B), nullptr, SSB, 1.0f};
      pg8::gemm_phase<pg8::EpiResB<false, true>, pg8::StaticOrder, true, true>(ring, g, S, E, wave_s); }
    GRID_SYNC();
    PHASE(512) { PHASE_VARS; pg8::Gemm g{(const pg8::bf16_t*)(ws + WS_H2B), (const pg8::bf16_t*)(ws + WS_WGU2), MX, NGU, DM}; pg8::StaticOrder S; S.init(MX, NGU, F.G, (int)blockIdx.x); pg8::EpiGU E{ACT, SSB, ABL()};
      pg8::gemm_phase<pg8::EpiGU, pg8::StaticOrder, true, true>(ring, g, S, E, wave_s); }
    GRID_SYNC();
    PHASE(1024) { PHASE_VARS; pg8::Gemm g{ACT, (const pg8::bf16_t*)(ws + WS_WD2), MX, DM, FF}; pg8::StaticOrder S; S.init(MX, DM, F.G, (int)blockIdx.x); pg8::EpiResB<true, false> E{(const pg8::bf16_t*)(ws + WS_H2B), nullptr, out, nullptr, 0.5f};
      pg8::gemm_phase<pg8::EpiResB<true, false>, pg8::StaticOrder, true, true>(ring, g, S, E, wave_s); }
}

extern "C" void kernel_launch(void* const* d_in, const int* in_sizes, int n_in, void* d_out, int out_size, void* d_ws, size_t ws_size, hipStream_t stream) {
    static int grid = 0;
    if (grid == 0) {
        if (n_in != 25 || out_size != MX * DM || ws_size < WS_END) { fprintf(stderr, "kernel_launch: unexpected shapes (n_in %d out %d ws %zu)\n", n_in, out_size, ws_size); grid = -1; return; }
        int dev = 0, cus = 0, per_cu = 0;
        if (hipGetDevice(&dev) != hipSuccess || hipDeviceGetAttribute(&cus, hipDeviceAttributeMultiprocessorCount, dev) != hipSuccess) { grid = -1; return; }
        if (hipFuncSetAttribute((const void*)fwd_megakernel, hipFuncAttributeMaxDynamicSharedMemorySize, LDS_BYTES) != hipSuccess) { fprintf(stderr, "kernel_launch: hipFuncSetAttribute failed\n"); grid = -1; return; }
        if (hipOccupancyMaxActiveBlocksPerMultiprocessor(&per_cu, (const void*)fwd_megakernel, 512, LDS_BYTES) != hipSuccess || per_cu < 1) { fprintf(stderr, "kernel_launch: occupancy query says %d blocks per CU\n", per_cu); (void)hipGetLastError(); grid = -1; return; }
        grid = cus;
        if (grid != 256) fprintf(stderr, "kernel_launch: note: %d CUs\n", grid);
    }
    if (grid < 0) return;
    (void)hipMemsetAsync((char*)d_ws + WS_CTL, 0, 16384, stream);
    Args a{};
    for (int i = 0; i < 25; ++i) a.in[i] = (const float*)d_in[i];
    a.out = (float*)d_out; a.ws = (unsigned char*)d_ws; a.dup = DUP; a.pad = 0;
    void* args[] = {&a};
#ifndef PLAIN_LAUNCH
#define PLAIN_LAUNCH 0
#endif
#if PLAIN_LAUNCH
    (void)args; hipLaunchKernelGGL(fwd_megakernel, dim3(grid), dim3(512), LDS_BYTES, stream, a); hipError_t e = hipPeekAtLastError();
#else
    hipError_t e = hipLaunchCooperativeKernel((const void*)fwd_megakernel, dim3(grid), dim3(512), args, LDS_BYTES, stream);
#endif
    if (e != hipSuccess) fprintf(stderr, "kernel_launch: cooperative launch failed: %s\n", hipGetErrorString(e));
}
```

```cpp
#include <hip/hip_runtime.h>
#include <hip/hip_cooperative_groups.h>
#include <cstdio>
#include <cstdint>
namespace cg = cooperative_groups;

#define LAS __attribute__((address_space(3)))
typedef unsigned short bf16;
typedef short bf16x8 __attribute__((ext_vector_type(8)));
typedef short s16x4 __attribute__((ext_vector_type(4)));
typedef float f32x4 __attribute__((ext_vector_type(4)));
typedef float f32x16 __attribute__((ext_vector_type(16)));
typedef unsigned u32x4 __attribute__((ext_vector_type(4)));
typedef unsigned u32x2 __attribute__((ext_vector_type(2)));
typedef float f32x2_t __attribute__((ext_vector_type(2)));
typedef __bf16 bf16x2_t __attribute__((ext_vector_type(2)));

constexpr int DM = 1024, NB = 16, SEQ = 2048, MX = NB * SEQ, FF = 2816, NGU = 2 * FF, NINP = 3072, NIN = 2888;
constexpr float ACT_SCALE = 8.0f, WD_SCALE = 2048.0f;
constexpr int KROWS = 2112, MK = NB * KROWS;
constexpr int SELW = 68;
constexpr int SCP = 2112;
constexpr float EPS = 1e-6f, LOG2E = 1.4426950408889634f;
constexpr float A_QSCALE = 0.125f * LOG2E;
constexpr float B_QSCALE = 0.0625f * LOG2E;
constexpr float IW_SCALE = 0.35355339059327373f * 0.125f;
constexpr float SUBLN_SCALE = 0.8f;
constexpr float LAM_INIT = 0.2f;

constexpr size_t MiB = 1u << 20;
constexpr size_t WS_CTL = 0, CTL_BYTES = 1 * MiB;
constexpr size_t WS_WGU1 = 1 * MiB, WS_WD1 = 12 * MiB, WS_WIN = WS_WD1 + (size_t)DM * FF * 2, WS_WKV = WS_WIN + (size_t)NINP * DM * 2, WS_WUKT = WS_WKV + 512 * 1024,
                 WS_WOUT = WS_WUKT + 256 * 1024, WS_WGU2 = WS_WOUT + 2 * MiB, WS_WD2 = WS_WGU2 + 11 * MiB;
constexpr size_t WS_SS = 43 * MiB, WS_IW = 45 * MiB, WS_META = 46 * MiB, WS_SCR = 48 * MiB, WS_HB = 180 * MiB, WS_ACT = 244 * MiB;
constexpr size_t WS_QA = WS_ACT, WS_QB = WS_QA + 32 * MiB, WS_IQ = WS_QB + 32 * MiB, WS_KA = WS_IQ + 32 * MiB, WS_VA = WS_KA + 33 * MiB, WS_SEL = WS_VA + 33 * MiB;
constexpr size_t WS_C = 420 * MiB, WS_IK = WS_C + (size_t)MK * 256 * 2, WS_KK = 441 * MiB, WS_VV = 474 * MiB, WS_H2B = 420 * MiB, WS_END = 512 * MiB;
static_assert(WS_WD2 + (size_t)DM * FF * 2 <= WS_SS, "weights");
static_assert(WS_SCR + (size_t)256 * 64 * SCP * 4 <= WS_HB, "scratch");
static_assert(WS_SEL + (size_t)MX * SELW * 4 <= WS_C && WS_IK + (size_t)MK * 64 * 2 <= WS_KK && WS_VV + (size_t)MK * 512 * 2 <= WS_END, "map");
constexpr size_t MO_HBM = 0, MO_SSM0 = 32 * 1024, MO_ACTM = 36 * 1024, MO_H1MB = 128 * 1024, MO_SSM1 = 160 * 1024;

constexpr int LDS_BYTES = 155648;
constexpr int LDS_XCH = 131072;
constexpr int LDS_LUT = 66560;
constexpr int LDS_MISC = 150 * 1024;

static_assert(LDS_LUT + 512 <= 67072 && 67072 + 64 * 1040 <= LDS_MISC && 8 * 32 * 272 <= LDS_MISC && LDS_XCH + 4096 <= LDS_MISC && LDS_MISC + 64 <= LDS_BYTES && LDS_BYTES <= 160 * 1024, "LDS map");
#define LDS_WAIT() asm volatile("s_waitcnt lgkmcnt(0)" ::: "memory")
#define VM_WAIT() asm volatile("s_waitcnt vmcnt(0)" ::: "memory")
__device__ __forceinline__ unsigned pk2(float lo, float hi) { f32x2_t v = {lo, hi}; bf16x2_t b = __builtin_convertvector(v, bf16x2_t); return __builtin_bit_cast(unsigned, b); }
__device__ __forceinline__ float wave_sum(float v) {
#pragma unroll
    for (int o = 1; o < 64; o <<= 1) v += __shfl_xor(v, o);
    return v;
}
__device__ __forceinline__ float rsqrt_acc(float x) { return 1.0f / sqrtf(x); }
__device__ __forceinline__ int crow(int r, int hi) { return (r & 3) + 8 * (r >> 2) + 4 * hi; }
#define MFMA32(a, b, c) __builtin_amdgcn_mfma_f32_32x32x16_bf16((a), (b), (c), 0, 0, 0)
#define MFMA16(a, b, c) __builtin_amdgcn_mfma_f32_16x16x32_bf16((a), (b), (c), 0, 0, 0)
namespace pg8 {
#define PG8_LAS __attribute__((address_space(3)))
typedef unsigned short bf16_t;
typedef short bf16x8 __attribute__((ext_vector_type(8)));
typedef float f32x4 __attribute__((ext_vector_type(4)));
typedef unsigned u32x4 __attribute__((ext_vector_type(4)));
typedef int i32x8 __attribute__((ext_vector_type(8)));
__device__ __forceinline__ i32x8 cat8(bf16x8 a, bf16x8 b) { typedef short s16 __attribute__((ext_vector_type(16))); return __builtin_bit_cast(i32x8, __builtin_shufflevector(a, b, 0, 1, 2, 3, 4, 5, 6, 7, 8, 9, 10, 11, 12, 13, 14, 15)); }
constexpr int BM = 256, BK = 64, HALF = 128, HTB = HALF * BK * 2  , STAGE_BYTES = 8 * HTB, NXCD = 8, WGM = 8;

__host__ __device__ __forceinline__ int lds_byte(int r, int c) { const int st = (r >> 4) * 2 + (c >> 5), rr = r & 15, cc = c & 31, ob = rr * 64 + cc * 2; return st * 1024 + (ob ^ (((ob >> 9) & 1) << 5)); }
__host__ __device__ __forceinline__ void stage_rc(int b, int& R, int& C) { const int st = b / 1024, sb = b % 1024, swz = sb ^ (((sb >> 9) & 1) << 5); R = (st >> 1) * 16 + swz / 64; C = (st & 1) * 32 + (swz % 64) / 2; }
__host__ __device__ __forceinline__ int perm32(int rho) { const int n = rho >> 4, i = rho & 15; return 8 * (i >> 2) + 4 * n + (i & 3); }

__device__ __forceinline__ void mfma8(f32x4& c, const i32x8 a, const i32x8 b, int sc) {
    asm volatile("v_mfma_scale_f32_16x16x128_f8f6f4 %0, %1, %2, %0, %3, %3 op_sel_hi:[0,0,0]" : "+v"(c) : "v"(a), "v"(b), "v"(sc)); }
__device__ __forceinline__ int lane_id() { int l; asm volatile("v_mbcnt_lo_u32_b32 %0, -1, 0\n\tv_mbcnt_hi_u32_b32 %0, -1, %0" : "=v"(l)); return l; }
struct Unit { int pm, pn; };
struct Gemm { const bf16_t* A; const bf16_t* Bt; int M, N, K; };

struct StaticOrder {
    int nM, nN, nwg, G, c;
    __host__ __device__ void init(int M, int N, int G_, int c_) { nM = M / BM; nN = N / BM; nwg = nM * nN; G = G_; c = c_; }
    __host__ __device__ bool next(int i, Unit& u) const {
        const long L = (long)i * G + c; if (L >= nwg) return false;
        int wgid = (int)L; { const int q = nwg / NXCD, r = nwg % NXCD, xcd = wgid % NXCD, off = wgid / NXCD; wgid = (xcd < r ? xcd * (q + 1) : r * (q + 1) + (xcd - r) * q) + off; }
        const int nig = WGM * nN, gid = wgid / nig, fm = gid * WGM, gsz = (nM - fm) < WGM ? (nM - fm) : WGM;
        u.pm = fm + ((wgid % nig) % gsz); u.pn = (wgid % nig) / gsz; return true;
    }
    __host__ __device__ int arow(int pm) const { return pm * BM; }
    __device__ __forceinline__ void a_ready(const Unit&) const {}
    __device__ __forceinline__ void done(const Unit&) const {}
};
__device__ __forceinline__ unsigned cvt_pk_bf16(float lo, float hi) { unsigned r; asm volatile("v_cvt_pk_bf16_f32 %0, %1, %2" : "=v"(r) : "v"(lo), "v"(hi)); return r; }
template <class Epi, class Sched, bool ALIGN_EPI = false, bool SP2 = false, bool F8 = false>
__device__ __forceinline__ void gemm_phase(PG8_LAS unsigned char* lds, const Gemm g, const Sched& S, const Epi& E, int wave_s) {
    int tid_ = wave_s * 64 + lane_id(); asm volatile("" : "+v"(tid_));
    const int tid = tid_, wid = __builtin_amdgcn_readfirstlane(tid >> 6), lane = tid & 63, wr = wid >> 2, wc = wid & 3, fr = lane & 15, fq = lane >> 4;
    const int K = g.K, nt = K / BK;
    unsigned voffA[2], voffB[2];
#pragma unroll
    for (int i = 0; i < 2; ++i) { int R, C; stage_rc(tid * 16 + i * 8192, R, C); const int Rb = Epi::PERM ? ((R & ~31) + perm32(R & 31)) : R;
        voffA[i] = (unsigned)(R * K + C) * 2u; voffB[i] = (unsigned)(Rb * K + C) * 2u; }
    const size_t kstep = (size_t)(BK * 2);
    const size_t hstep = (size_t)HALF * K * 2;
    const size_t tstep = 2 * hstep;
    const unsigned ldsw = (unsigned)wid * 1024u;
    const int aoff = lds_byte(wr * 64 + fr, fq * 8), boff = lds_byte(wc * 32 + fr, fq * 8);
#define PG8_SA(b, h) (((b) * 2 + (h)) * HTB)
#define PG8_SB(b, h) ((4 + (b) * 2 + (h)) * HTB)
#define PG8_STAGE(bufoff, gbase, voff) do { _Pragma("unroll") for (int _i = 0; _i < 2; ++_i) \
        __builtin_amdgcn_global_load_lds((const unsigned*)((const char*)(gbase) + (voff)[_i]), (PG8_LAS unsigned*)(lds + (bufoff) + ldsw + _i * 8192), 16, 0, 0); } while (0)
#define PG8_LDA(dst, b, h) do { _Pragma("unroll") for (int m = 0; m < 4; ++m) _Pragma("unroll") for (int k = 0; k < 2; ++k) dst[m][k] = *(const PG8_LAS bf16x8*)(lds + PG8_SA(b, h) + aoff + m * 2048 + k * 1024); } while (0)
#define PG8_LDB(dst, b, h) do { _Pragma("unroll") for (int n = 0; n < 2; ++n) _Pragma("unroll") for (int k = 0; k < 2; ++k) dst[n][k] = *(const PG8_LAS bf16x8*)(lds + PG8_SB(b, h) + boff + n * 2048 + k * 1024); } while (0)
#define PG8_MMA(ai, bj, At, Bt) do { __builtin_amdgcn_s_setprio(1); _Pragma("unroll") for (int m = 0; m < 4; ++m) _Pragma("unroll") for (int n = 0; n < 2; ++n) { \
        if constexpr (F8) mfma8(acc[ai][bj][m][n], cat8(Bt[n][0], Bt[n][1]), cat8(At[m][0], At[m][1]), one8); \
        else { _Pragma("unroll") for (int k = 0; k < 2; ++k) acc[ai][bj][m][n] = __builtin_amdgcn_mfma_f32_16x16x32_bf16(Bt[n][k], At[m][k], acc[ai][bj][m][n], 0, 0, 0); } } __builtin_amdgcn_s_setprio(0); } while (0)
#define PG8_WAIT_V(n) asm volatile("s_waitcnt vmcnt(" #n ")" ::: "memory")
#define PG8_WAIT_L(n) asm volatile("s_waitcnt lgkmcnt(" #n ")" ::: "memory")
#define PG8_BAR __builtin_amdgcn_s_barrier()
#define PG8_SCHED __builtin_amdgcn_sched_barrier(0)
    Unit cur, nxt; int ui = 0;
    if (!S.next(0, cur)) return;
    int one8 = 0x7F7F7F7F; asm volatile("" : "+v"(one8));
    f32x4 acc[2][2][4][2];
#pragma unroll
    for (int a = 0; a < 2; ++a)
#pragma unroll
        for (int b = 0; b < 2; ++b)
#pragma unroll
            for (int m = 0; m < 4; ++m)
#pragma unroll
                for (int n = 0; n < 2; ++n) acc[a][b][m][n] = (f32x4){0.f, 0.f, 0.f, 0.f};
    bf16x8 At[4][2], B0[2][2], B1[2][2];
    const char* cA = (const char*)g.A + (size_t)S.arow(cur.pm) * K * 2; const char* cB = (const char*)g.Bt + (size_t)cur.pn * tstep;
    S.a_ready(cur);
    if constexpr (SP2) {
        PG8_STAGE(PG8_SB(0, 0), cB, voffB); PG8_STAGE(PG8_SB(0, 1), cB + hstep, voffB); PG8_STAGE(PG8_SA(0, 0), cA, voffA); PG8_STAGE(PG8_SA(0, 1), cA + hstep, voffA);
        if (wr == 1) PG8_BAR;
        PG8_WAIT_V(2); PG8_BAR;
        PG8_STAGE(PG8_SB(1, 0), cB + kstep, voffB); PG8_STAGE(PG8_SA(1, 0), cA + kstep, voffA); PG8_STAGE(PG8_SB(1, 1), cB + hstep + kstep, voffB);
        PG8_WAIT_V(6); PG8_BAR;
    } else {
        PG8_STAGE(PG8_SB(0, 0), cB, voffB); PG8_STAGE(PG8_SA(0, 0), cA, voffA); PG8_STAGE(PG8_SB(0, 1), cB + hstep, voffB); PG8_STAGE(PG8_SA(0, 1), cA + hstep, voffA);
        if (wr == 1) PG8_BAR;
        PG8_WAIT_V(4); PG8_BAR;
        PG8_STAGE(PG8_SB(1, 0), cB + kstep, voffB); PG8_STAGE(PG8_SA(1, 0), cA + kstep, voffA); PG8_STAGE(PG8_SB(1, 1), cB + hstep + kstep, voffB);
        PG8_WAIT_V(6); PG8_BAR;
    }
    for (;;) {
        const bool has_next = S.next(ui + 1, nxt);
        const char* nA = has_next ? (const char*)g.A + (size_t)S.arow(nxt.pm) * K * 2 : cA; const char* nB = has_next ? (const char*)g.Bt + (size_t)nxt.pn * tstep : cB;
        for (int t = 0; t < nt; t += 2) {
            const bool last = (t == nt - 2);
            const char* a1 = cA + (size_t)(t + 1) * kstep;
            const char* a2 = last ? nA : cA + (size_t)(t + 2) * kstep; const char* b2 = last ? nB : cB + (size_t)(t + 2) * kstep;
            const char* a3 = a2 + kstep; const char* b3 = b2 + kstep;
            if (last && has_next) S.a_ready(nxt);
            if constexpr (SP2) {
            PG8_LDB(B0, 0, 0); PG8_LDB(B1, 0, 1); PG8_SCHED; PG8_LDA(At, 0, 0); PG8_STAGE(PG8_SA(1, 1), a1 + hstep, voffA);
            PG8_WAIT_V(8); PG8_WAIT_L(0); PG8_BAR; PG8_MMA(0, 0, At, B0); PG8_MMA(0, 1, At, B1); PG8_BAR; PG8_SCHED;
            PG8_LDA(At, 0, 1); PG8_STAGE(PG8_SB(0, 0), b2, voffB); PG8_STAGE(PG8_SB(0, 1), b2 + hstep, voffB); PG8_STAGE(PG8_SA(0, 0), a2, voffA);
            PG8_WAIT_V(8); PG8_WAIT_L(0); PG8_BAR; PG8_MMA(1, 0, At, B0); PG8_MMA(1, 1, At, B1); PG8_BAR; PG8_SCHED;
            PG8_LDB(B0, 1, 0); PG8_LDB(B1, 1, 1); PG8_SCHED; PG8_LDA(At, 1, 0); PG8_STAGE(PG8_SA(0, 1), a2 + hstep, voffA);
            PG8_WAIT_V(8); PG8_WAIT_L(0); PG8_BAR; PG8_MMA(0, 0, At, B0); PG8_MMA(0, 1, At, B1); PG8_BAR; PG8_SCHED;
            PG8_LDA(At, 1, 1); PG8_STAGE(PG8_SB(1, 0), b3, voffB); PG8_STAGE(PG8_SB(1, 1), b3 + hstep, voffB); PG8_STAGE(PG8_SA(1, 0), a3, voffA);
            PG8_WAIT_V(8); PG8_WAIT_L(0); PG8_BAR; PG8_MMA(1, 0, At, B0); PG8_MMA(1, 1, At, B1); PG8_BAR; PG8_SCHED;
            } else {
            PG8_LDB(B0, 0, 0); PG8_SCHED; PG8_LDA(At, 0, 0); PG8_STAGE(PG8_SA(1, 1), a1 + hstep, voffA);
            PG8_WAIT_L(8); PG8_BAR; PG8_WAIT_L(0); PG8_MMA(0, 0, At, B0); PG8_BAR; PG8_SCHED;
            PG8_LDB(B1, 0, 1); PG8_STAGE(PG8_SB(0, 0), b2, voffB);
            PG8_BAR; PG8_WAIT_L(0); PG8_MMA(0, 1, At, B1); PG8_BAR;
            PG8_LDA(At, 0, 1); PG8_STAGE(PG8_SA(0, 0), a2, voffA);
            PG8_BAR; PG8_WAIT_L(0); PG8_MMA(1, 0, At, B0); PG8_BAR; PG8_SCHED;
            PG8_STAGE(PG8_SB(0, 1), b2 + hstep, voffB);
            PG8_WAIT_V(6); PG8_BAR; PG8_MMA(1, 1, At, B1); PG8_BAR;
            PG8_LDB(B0, 1, 0); PG8_SCHED; PG8_LDA(At, 1, 0); PG8_STAGE(PG8_SA(0, 1), a2 + hstep, voffA);
            PG8_WAIT_L(8); PG8_BAR; PG8_WAIT_L(0); PG8_MMA(0, 0, At, B0); PG8_BAR; PG8_SCHED;
            PG8_LDB(B1, 1, 1); PG8_STAGE(PG8_SB(1, 0), b3, voffB);
            PG8_BAR; PG8_WAIT_L(0); PG8_MMA(0, 1, At, B1); PG8_BAR;
            PG8_LDA(At, 1, 1); PG8_STAGE(PG8_SA(1, 0), a3, voffA);
            PG8_BAR; PG8_WAIT_L(0); PG8_MMA(1, 0, At, B0); PG8_BAR; PG8_SCHED;
            PG8_STAGE(PG8_SB(1, 1), b3 + hstep, voffB);
            PG8_WAIT_V(6); PG8_BAR; PG8_MMA(1, 1, At, B1); PG8_BAR;
            }
        }
        if constexpr (ALIGN_EPI) { if (wr == 0) PG8_BAR; }
        if constexpr (F8) asm volatile("s_nop 15\n\ts_nop 15" ::: "memory");
        if constexpr (!Epi::AFTER_DRAIN) { E(acc, cur, wr, wc, fr, fq); S.done(cur); }
        if (!has_next) break;
#pragma unroll
        for (int a = 0; a < 2; ++a)
#pragma unroll
            for (int b = 0; b < 2; ++b)
#pragma unroll
                for (int m = 0; m < 4; ++m)
#pragma unroll
                    for (int n = 0; n < 2; ++n) acc[a][b][m][n] = (f32x4){0.f, 0.f, 0.f, 0.f};
        cur = nxt; cA = nA; cB = nB; ++ui;
        if constexpr (ALIGN_EPI) { if (wr == 1) PG8_BAR; }
    }
    PG8_WAIT_V(0);
    if constexpr (!ALIGN_EPI) { if (wr == 0) PG8_BAR; }
    PG8_BAR;
    if constexpr (Epi::AFTER_DRAIN) { E.fused(acc, cur, wr, wc, fr, fq, lds, wid, lane); S.done(cur); }
#undef PG8_SA
#undef PG8_SB
#undef PG8_STAGE
#undef PG8_LDA
#undef PG8_LDB
#undef PG8_MMA
#undef PG8_WAIT_V
#undef PG8_WAIT_L
#undef PG8_BAR
#undef PG8_SCHED
}
__device__ __forceinline__ float rstd_slots(const float* ss, int row, int fq) {
    const f32x4 v = *(const f32x4*)(ss + (size_t)row * 16 + 4 * fq);
    float s = (v[0] + v[1]) + (v[2] + v[3]);
    s += __shfl_xor(s, 16); s += __shfl_xor(s, 32);
    return 1.0f / sqrtf(s * (1.0f / 1024.0f) + 1e-6f);
}
__device__ __forceinline__ f32x4 slots_load(const float* ss, int row, int fq) { return *(const f32x4*)(ss + (size_t)row * 16 + 4 * fq); }
__device__ __forceinline__ float slots_rstd(const f32x4 v) { float s = (v[0] + v[1]) + (v[2] + v[3]); s += __shfl_xor(s, 16); s += __shfl_xor(s, 32); return 1.0f / sqrtf(s * (1.0f / 1024.0f) + 1e-6f); }
__device__ __forceinline__ float silu_mul(float g, float u) { return g * __builtin_amdgcn_rcpf(1.0f + __builtin_amdgcn_exp2f(-1.4426950408889634f * g)) * u; }
__device__ __forceinline__ unsigned pk8(float a, float b, float c, float d) {
    a = __builtin_amdgcn_fmed3f(a, -448.f, 448.f); b = __builtin_amdgcn_fmed3f(b, -448.f, 448.f); c = __builtin_amdgcn_fmed3f(c, -448.f, 448.f); d = __builtin_amdgcn_fmed3f(d, -448.f, 448.f);
    const int p = __builtin_amdgcn_cvt_pk_fp8_f32(a, b, 0, false); return (unsigned)__builtin_amdgcn_cvt_pk_fp8_f32(c, d, p, true); }
__device__ __forceinline__ unsigned pkbf(float lo, float hi) { typedef float v2f __attribute__((ext_vector_type(2))); typedef __bf16 v2b __attribute__((ext_vector_type(2))); v2f v = {lo, hi}; v2b b = __builtin_convertvector(v, v2b); return __builtin_bit_cast(unsigned, b); }

struct EpiGU {
    static constexpr bool PERM = true, AFTER_DRAIN = false;
    unsigned char* act; const float* ss; int abl;
    __device__ __forceinline__ void operator()(const f32x4 (&acc)[2][2][4][2], const Unit& u, int wr, int wc, int fr, int fq) const {
        if (abl & 1) return;
        const int row0 = u.pm * BM + wr * 64 + fr, col0 = u.pn * 128 + wc * 32 + 8 * fq;
        f32x4 sv[2][4];
#pragma unroll
        for (int ai = 0; ai < 2; ++ai)
#pragma unroll
            for (int m = 0; m < 4; ++m) sv[ai][m] = slots_load(ss, row0 + ai * HALF + m * 16, fq);
#pragma unroll
        for (int ai = 0; ai < 2; ++ai)
#pragma unroll
            for (int m = 0; m < 4; ++m) { const int row = row0 + ai * HALF + m * 16; const float rs = slots_rstd(sv[ai][m]);
                const f32x4 g0 = acc[ai][0][m][0] * rs, g1 = acc[ai][0][m][1] * rs, u0 = acc[ai][1][m][0] * (rs * ACT_SCALE), u1 = acc[ai][1][m][1] * (rs * ACT_SCALE);
                typedef unsigned u32x2v __attribute__((ext_vector_type(2))); u32x2v w;
                w.x = pk8(silu_mul(g0[0], u0[0]), silu_mul(g0[1], u0[1]), silu_mul(g0[2], u0[2]), silu_mul(g0[3], u0[3]));
                w.y = pk8(silu_mul(g1[0], u1[0]), silu_mul(g1[1], u1[1]), silu_mul(g1[2], u1[2]), silu_mul(g1[3], u1[3]));
                *(u32x2v*)(act + (size_t)row * 2816 + col0) = w; }
    }
};
template <bool HB, bool SS> struct EpiRes {
    static constexpr bool PERM = false, AFTER_DRAIN = false;
    const float* res; float* out; bf16_t* hb; float* ss; float alpha;
    __device__ __forceinline__ void operator()(const f32x4 (&acc)[2][2][4][2], const Unit& u, int wr, int wc, int fr, int fq) const {
        const int row0 = u.pm * BM + wr * 64 + fr, col0 = u.pn * BM + wc * 32 + 4 * fq;
#pragma unroll
        for (int ai = 0; ai < 2; ++ai)
#pragma unroll
            for (int m = 0; m < 4; ++m) { const int row = row0 + ai * HALF + m * 16; const size_t off = (size_t)row * 1024 + col0; float sq = 0.f;
#pragma unroll
                for (int bj = 0; bj < 2; ++bj)
#pragma unroll
                    for (int n = 0; n < 2; ++n) { const f32x4 r4 = *(const f32x4*)(res + off + bj * HALF + n * 16); const f32x4 v = r4 + acc[ai][bj][m][n] * alpha;
                        *(f32x4*)(out + off + bj * HALF + n * 16) = v;
                        if (HB) { typedef unsigned u32x2v __attribute__((ext_vector_type(2))); u32x2v w; w.x = pkbf(v[0], v[1]); w.y = pkbf(v[2], v[3]); *(u32x2v*)(hb + off + bj * HALF + n * 16) = w; }
                        if (SS) sq += (v[0] * v[0] + v[1] * v[1]) + (v[2] * v[2] + v[3] * v[3]); }
                if (SS) { sq += __shfl_xor(sq, 16); sq += __shfl_xor(sq, 32); if (fq == 0) ss[(size_t)row * 16 + u.pn * 4 + wc] = sq; }
                if (m == 3) asm volatile("" ::: "memory"); }
    }
};
template <bool OUTF32, bool SS> struct EpiResB {
    static constexpr bool PERM = true, AFTER_DRAIN = false;
    const bf16_t* res; bf16_t* outb; float* outf; float* ss; float alpha;
    __device__ __forceinline__ void operator()(const f32x4 (&acc)[2][2][4][2], const Unit& u, int wr, int wc, int fr, int fq) const {
        const int row0 = u.pm * BM + wr * 64 + fr, col0 = u.pn * BM + wc * 32 + 8 * fq;
        u32x4 rv[2][4][2];
#pragma unroll
        for (int ai = 0; ai < 2; ++ai)
#pragma unroll
            for (int m = 0; m < 4; ++m)
#pragma unroll
                for (int bj = 0; bj < 2; ++bj) rv[ai][m][bj] = *(const u32x4*)(res + (size_t)(row0 + ai * HALF + m * 16) * 1024 + col0 + bj * HALF);
#pragma unroll
        for (int ai = 0; ai < 2; ++ai)
#pragma unroll
            for (int m = 0; m < 4; ++m) { const int row = row0 + ai * HALF + m * 16; const size_t off = (size_t)row * 1024 + col0; float sq = 0.f;
#pragma unroll
                for (int bj = 0; bj < 2; ++bj) { const u32x4 r = rv[ai][m][bj];
                    f32x4 v0, v1;
                    v0[0] = __uint_as_float(r.x << 16); v0[1] = __uint_as_float(r.x & 0xffff0000u); v0[2] = __uint_as_float(r.y << 16); v0[3] = __uint_as_float(r.y & 0xffff0000u);
                    v1[0] = __uint_as_float(r.z << 16); v1[1] = __uint_as_float(r.z & 0xffff0000u); v1[2] = __uint_as_float(r.w << 16); v1[3] = __uint_as_float(r.w & 0xffff0000u);
                    v0 = v0 + acc[ai][bj][m][0] * alpha; v1 = v1 + acc[ai][bj][m][1] * alpha;
                    if (OUTF32) { *(f32x4*)(outf + off + bj * HALF) = v0; *(f32x4*)(outf + off + bj * HALF + 4) = v1; }
                    else { u32x4 w; w.x = pkbf(v0[0], v0[1]); w.y = pkbf(v0[2], v0[3]); w.z = pkbf(v1[0], v1[1]); w.w = pkbf(v1[2], v1[3]); *(u32x4*)(outb + off + bj * HALF) = w; }
                    if (SS) sq += ((v0[0] * v0[0] + v0[1] * v0[1]) + (v0[2] * v0[2] + v0[3] * v0[3])) + ((v1[0] * v1[0] + v1[1] * v1[1]) + (v1[2] * v1[2] + v1[3] * v1[3])); }
                if (SS) { sq += __shfl_xor(sq, 16); sq += __shfl_xor(sq, 32); if (fq == 0) ss[(size_t)row * 16 + u.pn * 4 + wc] = sq; } }
    }
};
struct EpiIn {
    static constexpr bool PERM = true, AFTER_DRAIN = false;
    bf16_t *qa, *ka, *va, *qb, *cc, *iq, *ik; float* iw; const float* ss; const float *g_aq, *g_ak, *g_kv; PG8_LAS float* xch;
    __device__ __forceinline__ void operator()(const f32x4 (&acc)[2][2][4][2], const Unit& u, int wr, int wc, int fr, int fq) const {
        const int row0 = u.pm * BM + wr * 64 + fr, pn = u.pn, lc0 = 64 * wc + 8 * fq;
        if (pn == 8) {
            float rsv[2][4]; f32x4 sv[2][4];
#pragma unroll
            for (int ai = 0; ai < 2; ++ai)
#pragma unroll
                for (int m = 0; m < 4; ++m) sv[ai][m] = slots_load(ss, row0 + ai * HALF + m * 16, fq);
#pragma unroll
            for (int ai = 0; ai < 2; ++ai)
#pragma unroll
                for (int m = 0; m < 4; ++m) { const float rs = slots_rstd(sv[ai][m]); rsv[ai][m] = rs; float sq = 0.f;
#pragma unroll
                    for (int bj = 0; bj < 2; ++bj)
#pragma unroll
                        for (int n = 0; n < 2; ++n) { const f32x4 v = acc[ai][bj][m][n] * rs; sq += (v[0] * v[0] + v[1] * v[1]) + (v[2] * v[2] + v[3] * v[3]); }
                    sq += __shfl_xor(sq, 16); sq += __shfl_xor(sq, 32);
                    if (fq == 0) xch[(ai * HALF + wr * 64 + m * 16 + fr) * 4 + wc] = sq; }
            asm volatile("s_waitcnt lgkmcnt(0)" ::: "memory"); __builtin_amdgcn_s_barrier(); asm volatile("" ::: "memory");
            f32x4 gv[2][2];
#pragma unroll
            for (int bj = 0; bj < 2; ++bj)
#pragma unroll
                for (int n = 0; n < 2; ++n) gv[bj][n] = *(const f32x4*)(g_kv + lc0 + 32 * bj + 4 * n);
#pragma unroll
            for (int ai = 0; ai < 2; ++ai)
#pragma unroll
                for (int m = 0; m < 4; ++m) { const int row = row0 + ai * HALF + m * 16, rl = ai * HALF + wr * 64 + m * 16 + fr; const f32x4 t = *(const PG8_LAS f32x4*)(xch + rl * 4);
                    const float r2 = rsv[ai][m] / sqrtf(((t[0] + t[1]) + (t[2] + t[3])) * (1.0f / 256.0f) + 1e-6f);
                    const size_t kr = (size_t)(row >> 11) * 2112 + 64 + (row & 2047);
#pragma unroll
                    for (int bj = 0; bj < 2; ++bj) { const f32x4 a = acc[ai][bj][m][0] * r2 * gv[bj][0], b = acc[ai][bj][m][1] * r2 * gv[bj][1];
                        u32x4 w; w.x = pkbf(a[0], a[1]); w.y = pkbf(a[2], a[3]); w.z = pkbf(b[0], b[1]); w.w = pkbf(b[2], b[3]);
                        *(u32x4*)(cc + kr * 256 + lc0 + 32 * bj) = w; } }
            asm volatile("s_waitcnt lgkmcnt(0)" ::: "memory"); __builtin_amdgcn_s_barrier(); asm volatile("" ::: "memory");
            return;
        }
        const bool headnorm = pn < 4;
        f32x4 gv[2][2];
        if (headnorm) { const float* gp = (pn < 2) ? g_aq : g_ak; const float sc = (pn < 2) ? (0.125f * 1.4426950408889634f) : 1.0f;
#pragma unroll
            for (int bj = 0; bj < 2; ++bj)
#pragma unroll
                for (int n = 0; n < 2; ++n) gv[bj][n] = *(const f32x4*)(gp + 32 * bj + 8 * fq + 4 * n) * sc; }
        f32x4 sv[2][4];
#pragma unroll
        for (int ai = 0; ai < 2; ++ai)
#pragma unroll
            for (int m = 0; m < 4; ++m) sv[ai][m] = slots_load(ss, row0 + ai * HALF + m * 16, fq);
#pragma unroll
        for (int ai = 0; ai < 2; ++ai)
#pragma unroll
            for (int m = 0; m < 4; ++m) { const int row = row0 + ai * HALF + m * 16; const float rs = slots_rstd(sv[ai][m]);
                const size_t kr = (size_t)(row >> 11) * 2112 + 64 + (row & 2047);
                f32x4 v[2][2];
#pragma unroll
                for (int bj = 0; bj < 2; ++bj)
#pragma unroll
                    for (int n = 0; n < 2; ++n) v[bj][n] = acc[ai][bj][m][n] * rs;
                if (headnorm) { float sq = 0.f;
#pragma unroll
                    for (int bj = 0; bj < 2; ++bj)
#pragma unroll
                        for (int n = 0; n < 2; ++n) sq += (v[bj][n][0] * v[bj][n][0] + v[bj][n][1] * v[bj][n][1]) + (v[bj][n][2] * v[bj][n][2] + v[bj][n][3] * v[bj][n][3]);
                    sq += __shfl_xor(sq, 16); sq += __shfl_xor(sq, 32);
                    const float r2 = 1.0f / sqrtf(sq * (1.0f / 64.0f) + 1e-6f);
#pragma unroll
                    for (int bj = 0; bj < 2; ++bj)
#pragma unroll
                        for (int n = 0; n < 2; ++n) v[bj][n] = v[bj][n] * r2 * gv[bj][n]; }
                bf16_t* dst; bool st = true;
                if (pn < 2) dst = qa + (size_t)row * 512 + pn * 256 + lc0;
                else if (pn < 4) dst = ka + kr * 512 + (pn - 2) * 256 + lc0;
                else if (pn < 6) dst = va + kr * 512 + (pn - 4) * 256 + lc0;
                else if (pn < 8) dst = qb + (size_t)row * 512 + (pn - 6) * 256 + lc0;
                else if (pn < 11) dst = iq + (size_t)row * 512 + (pn - 9) * 256 + lc0;
                else { dst = ik + kr * 64 + lc0; st = (wc == 0);
                    if (wc == 1 && fq == 0) { const float s = 0.35355339059327373f * 0.125f; *(f32x4*)(iw + (size_t)row * 8) = v[0][0] * s; *(f32x4*)(iw + (size_t)row * 8 + 4) = v[0][1] * s; } }
                if (st) {
#pragma unroll
                    for (int bj = 0; bj < 2; ++bj) { u32x4 w; w.x = pkbf(v[bj][0][0], v[bj][0][1]); w.y = pkbf(v[bj][0][2], v[bj][0][3]); w.z = pkbf(v[bj][1][0], v[bj][1][1]); w.w = pkbf(v[bj][1][2], v[bj][1][3]);
                        *(u32x4*)(dst + 32 * bj) = w; } } }
    }
};
struct EpiKV {
    static constexpr bool PERM = true, AFTER_DRAIN = false;
    bf16_t *kk, *vv;
    __device__ __forceinline__ void operator()(const f32x4 (&acc)[2][2][4][2], const Unit& u, int wr, int wc, int fr, int fq) const {
        const int row0 = (u.pm >> 3) * 2112 + 64 + (u.pm & 7) * BM + wr * 64 + fr; bf16_t* base = (u.pn < 2 ? kk : vv) + (u.pn & 1) * 256 + wc * 32 + 8 * fq;
#pragma unroll
        for (int ai = 0; ai < 2; ++ai)
#pragma unroll
            for (int m = 0; m < 4; ++m) { bf16_t* rowp = base + (size_t)(row0 + ai * HALF + m * 16) * 512;
#pragma unroll
                for (int bj = 0; bj < 2; ++bj) { const f32x4 a = acc[ai][bj][m][0], b = acc[ai][bj][m][1];
                    u32x4 w; w.x = pkbf(a[0], a[1]); w.y = pkbf(a[2], a[3]); w.z = pkbf(b[0], b[1]); w.w = pkbf(b[2], b[3]);
                    *(u32x4*)(rowp + bj * HALF) = w; } }
    }
};
}
struct Args {
    const float* in[25]; float* out; unsigned char* ws; int dup; int pad;
};
typedef const __attribute__((address_space(4))) Args* CArgsP;
__device__ __forceinline__ CArgsP get_args() { CArgsP p = (CArgsP)__builtin_amdgcn_kernarg_segment_ptr(); asm volatile("" : "+s"(p)); return p; }
struct Frame {
    LAS unsigned char* lds; int tid, lane, wave, G, vcu;
};

__device__ __forceinline__ Frame make_frame(LAS unsigned char* lds, int wave_s) {
    Frame F; int t = wave_s * 64 + pg8::lane_id(); asm volatile("" : "+v"(t));
    F.lds = lds; F.tid = t; F.lane = t & 63; F.wave = __builtin_amdgcn_readfirstlane(t >> 6);
    F.G = gridDim.x; { const int bx = blockIdx.x; F.vcu = (F.G % 8 == 0) ? (bx % 8) * (F.G / 8) + bx / 8 : bx; }
    return F;
}
__device__ __forceinline__ void tr_item(const float* __restrict__ W, int ld, int col, int nvalid, const float* __restrict__ gain, int k0, bf16* out, int Kpitch, LAS float* scr, int lane) {
    const int c = lane & 31; const bool okc = c < nvalid;
    const float* wp = W + (size_t)(k0 + (lane >> 5)) * ld + col + (okc ? c : 0);
    float v[32];
#pragma unroll
    for (int i = 0; i < 32; ++i) v[i] = okc ? wp[(size_t)(2 * i) * ld] : 0.f;
    if (gain) {
#pragma unroll
        for (int i = 0; i < 32; ++i) v[i] *= gain[k0 + 2 * i + (lane >> 5)]; }
#pragma unroll
    for (int i = 0; i < 32; ++i) scr[(2 * i + (lane >> 5)) * 33 + c] = v[i];
    LDS_WAIT(); asm volatile("" ::: "memory");
    const int c8 = lane & 7;
#pragma unroll
    for (int j = 0; j < 4; ++j) { const int n = (lane >> 3) + 8 * j; const LAS float* s = scr + (8 * c8) * 33 + n;
        u32x4 o; o.x = pk2(s[0 * 33], s[1 * 33]); o.y = pk2(s[2 * 33], s[3 * 33]); o.z = pk2(s[4 * 33], s[5 * 33]); o.w = pk2(s[6 * 33], s[7 * 33]);
        *(u32x4*)(out + (size_t)n * Kpitch + 8 * c8) = o; }
    LDS_WAIT(); asm volatile("" ::: "memory");
}
__device__ __forceinline__ void p0_gu_item(const float* Wg, const float* Wu, const float* gain, bf16* WT, int r, LAS float* scr, int lane) {
    const int kb = r / 176, nb = r % 176, n0 = 32 * nb, pn = n0 >> 8, j = n0 & 255, bj = j >> 7, jj = j & 127;
    tr_item(bj ? Wu : Wg, FF, 128 * pn + jj, 32, gain, 64 * kb, WT + (size_t)n0 * DM + 64 * kb, DM, scr, lane);
}
__device__ __forceinline__ void p0_plain_item(const float* W, int K, int N, const float* gain, bf16* WT, int r, LAS float* scr, int lane) {
    const int nblk = N / 32, kb = r / nblk, nb = r % nblk;
    tr_item(W, N, 32 * nb, 32, gain, 64 * kb, WT + (size_t)(32 * nb) * K + 64 * kb, K, scr, lane);
}
__device__ __forceinline__ void tr_item8(const float* __restrict__ W, int ld, int col, float scale, int k0, unsigned char* out8, int Kpitch, LAS float* scr, int lane) {
    const int c = lane & 31;
    const float* wp = W + (size_t)(k0 + (lane >> 5)) * ld + col + c;
    float v[32];
#pragma unroll
    for (int i = 0; i < 32; ++i) v[i] = wp[(size_t)(2 * i) * ld];
#pragma unroll
    for (int i = 0; i < 32; ++i) scr[(2 * i + (lane >> 5)) * 33 + c] = v[i] * scale;
    LDS_WAIT(); asm volatile("" ::: "memory");
    const int n = lane >> 1, kh = 32 * (lane & 1); const LAS float* s = scr + kh * 33 + n;
#pragma unroll
    for (int j = 0; j < 2; ++j) { u32x4 o;
        o.x = pg8::pk8(s[(16 * j + 0) * 33], s[(16 * j + 1) * 33], s[(16 * j + 2) * 33], s[(16 * j + 3) * 33]); o.y = pg8::pk8(s[(16 * j + 4) * 33], s[(16 * j + 5) * 33], s[(16 * j + 6) * 33], s[(16 * j + 7) * 33]);
        o.z = pg8::pk8(s[(16 * j + 8) * 33], s[(16 * j + 9) * 33], s[(16 * j + 10) * 33], s[(16 * j + 11) * 33]); o.w = pg8::pk8(s[(16 * j + 12) * 33], s[(16 * j + 13) * 33], s[(16 * j + 14) * 33], s[(16 * j + 15) * 33]);
        *(u32x4*)(out8 + (size_t)n * Kpitch + kh + 16 * j) = o; }
    LDS_WAIT(); asm volatile("" ::: "memory");
}
__device__ __forceinline__ void p0_plain_item8(const float* W, int K, int N, float scale, unsigned char* WT8, int r, LAS float* scr, int lane) {
    const int nblk = N / 32, kb = r / nblk, nb = r % nblk;
    tr_item8(W, N, 32 * nb, scale, 64 * kb, WT8 + (size_t)(32 * nb) * K + 64 * kb, K, scr, lane);
}
__device__ __forceinline__ void p0_in_item(const float* W, const float* gain, bf16* WT, int r, LAS float* scr, int lane) {
    const int kb = r / 96, nb = r % 96, n0 = 32 * nb, pn = n0 >> 8, j = n0 & 255, bj = j >> 7, wc = (j >> 5) & 3, L = 256 * pn + 64 * wc + 32 * bj;
    int nv = NIN - L; nv = nv < 0 ? 0 : (nv > 32 ? 32 : nv);
    tr_item(W, NIN, L, nv, gain, 64 * kb, WT + (size_t)n0 * DM + 64 * kb, DM, scr, lane);
}
__device__ __forceinline__ void row_to_bf16(const float* xrow, bf16* orow, float* ssrow, int lane) {
    const f32x4* xr = (const f32x4*)xrow + lane; f32x4 v[4]; float s = 0.f;
#pragma unroll
    for (int j = 0; j < 4; ++j) { v[j] = xr[64 * j]; s += (v[j][0] * v[j][0] + v[j][1] * v[j][1]) + (v[j][2] * v[j][2] + v[j][3] * v[j][3]); }
    u32x2* o8 = (u32x2*)orow + lane;
#pragma unroll
    for (int j = 0; j < 4; ++j) { u32x2 w; w.x = pk2(v[j][0], v[j][1]); w.y = pk2(v[j][2], v[j][3]); o8[64 * j] = w; }
    const float tot = wave_sum(s);
    if (lane < 16) ssrow[lane] = (lane == 0) ? tot : 0.f;
}
__device__ __forceinline__ void p0_prologue(const Frame& F, CArgsP a) {
    unsigned char* ws = a->ws;
    LAS float* scr = (LAS float*)(F.lds + F.wave * 16384);
    const int gw = F.vcu * 8 + F.wave, NGW = F.G * 8, lane = F.lane;
    constexpr int I0 = 2816, I1 = 1408, I2 = 1536, I3 = 512, I4 = 2816, I5 = 1408, I6 = 64, I7 = 64, NIT = I0 + I1 + I2 + I3 + I4 + I5 + I6 + I7;
    for (int it = gw; it < NIT; it += NGW) {
        int r = it;
        if (r < I0) { p0_gu_item(a->in[4], a->in[5], a->in[3], (bf16*)(ws + WS_WGU1), r, scr, lane); continue; } r -= I0;
        if (r < I1) { p0_plain_item8(a->in[6], FF, DM, WD_SCALE, ws + WS_WD1, r, scr, lane); continue; } r -= I1;
        if (r < I2) { p0_in_item(a->in[8], a->in[7], (bf16*)(ws + WS_WIN), r, scr, lane); continue; } r -= I2;
        if (r < I3) { p0_plain_item(a->in[20], DM, DM, nullptr, (bf16*)(ws + WS_WOUT), r, scr, lane); continue; } r -= I3;
        if (r < I4) { p0_gu_item(a->in[22], a->in[23], a->in[21], (bf16*)(ws + WS_WGU2), r, scr, lane); continue; } r -= I4;
        if (r < I5) { p0_plain_item8(a->in[24], FF, DM, WD_SCALE, ws + WS_WD2, r, scr, lane); continue; } r -= I5;
        if (r < I6) { const int h = r >> 4, q = r & 15, kb = q >> 2, nb = q & 3;
            tr_item(a->in[19] + (size_t)h * 256 * 128, 128, 32 * nb, 32, nullptr, 64 * kb, (bf16*)(ws + WS_WKV) + (size_t)(512 + 128 * h + 32 * nb) * 256 + 64 * kb, 256, scr, lane); continue; } r -= I6;
        { const int h = r >> 4, q = r & 15, kb = q >> 3, nb = q & 7;
            tr_item(a->in[17] + (size_t)h * 128 * 256, 256, 32 * nb, 32, nullptr, 64 * kb, (bf16*)(ws + WS_WUKT) + (size_t)h * 256 * 128 + (size_t)(32 * nb) * 128 + 64 * kb, 128, scr, lane); }
    }
    {
        const int gid = F.vcu * 512 + F.tid;
        for (int e = gid; e < 512 * 256 / 2; e += F.G * 512) { const int i = 2 * e, c = i & 255; const float* w = a->in[17] + i; const float* g = a->in[18] + c;
            ((unsigned*)(ws + WS_WKV))[e] = pk2(w[0] * g[0], w[1] * g[1]); }
    }
    for (int m0 = gw * 4; m0 < MX; m0 += NGW * 4) {
        f32x4 v[4][4]; float sq[4];
#pragma unroll
        for (int r = 0; r < 4; ++r) { const f32x4* xr = (const f32x4*)(a->in[0] + (size_t)(m0 + r) * DM) + lane;
#pragma unroll
            for (int j = 0; j < 4; ++j) v[r][j] = __builtin_nontemporal_load(xr + 64 * j); }
#pragma unroll
        for (int r = 0; r < 4; ++r) { float s = 0.f; u32x2* o8 = (u32x2*)((bf16*)(ws + WS_HB) + (size_t)(m0 + r) * DM) + lane;
#pragma unroll
            for (int j = 0; j < 4; ++j) { s += (v[r][j][0] * v[r][j][0] + v[r][j][1] * v[r][j][1]) + (v[r][j][2] * v[r][j][2] + v[r][j][3] * v[r][j][3]);
                u32x2 w; w.x = pk2(v[r][j][0], v[r][j][1]); w.y = pk2(v[r][j][2], v[r][j][3]); o8[64 * j] = w; }
            sq[r] = wave_sum(s); }
#pragma unroll
        for (int r = 0; r < 4; ++r) if (lane < 16) ((float*)(ws + WS_SS))[(size_t)(m0 + r) * 16 + lane] = (lane == 0) ? sq[r] : 0.f;
    }
    if (gw < 16) row_to_bf16(a->in[1] + (size_t)gw * DM, (bf16*)(ws + WS_META + MO_HBM) + (size_t)gw * DM, (float*)(ws + WS_META + MO_SSM0) + gw * 16, lane);
    {
        const int gid = F.vcu * 512 + F.tid, NT = F.G * 512; const u32x4 z = {0u, 0u, 0u, 0u};
        for (int e = gid; e < NB * 48 * 64; e += NT) { const int b = e / (48 * 64), q = e % (48 * 64); const size_t o = ((size_t)b * KROWS) * 1024 + (size_t)q * 16;
            *(u32x4*)(ws + WS_KA + o) = z; *(u32x4*)(ws + WS_VA + o) = z; *(u32x4*)(ws + WS_KK + o) = z; *(u32x4*)(ws + WS_VV + o) = z; }
        for (int e = gid; e < NB * 48 * 32; e += NT) { const int b = e / (48 * 32), q = e % (48 * 32); *(u32x4*)(ws + WS_C + ((size_t)b * KROWS) * 512 + (size_t)q * 16) = z; }
        for (int e = gid; e < NB * 48 * 8; e += NT) { const int b = e / (48 * 8), q = e % (48 * 8); *(u32x4*)(ws + WS_IK + ((size_t)b * KROWS) * 128 + (size_t)q * 16) = z; }
    }
}

template <int KS, int NT, int BS> __device__ __forceinline__ void meta_block_mm(const Frame& F, const bf16* __restrict__ A16, const bf16* __restrict__ Bt, const int (&prow)[NT], int K, float (&v)[4][NT]) {
    const int lane = F.lane, col = lane & 15, kq = lane >> 4, k0 = F.wave * KS * 32;
    const bf16* ap = A16 + (size_t)col * K + k0 + 8 * kq;
    const bf16* bp[NT]; f32x4 acc[NT];
#pragma unroll
    for (int j = 0; j < NT; ++j) { bp[j] = Bt + (size_t)(prow[j] + col) * K + k0 + 8 * kq; acc[j] = (f32x4){0.f, 0.f, 0.f, 0.f}; }
#pragma unroll
    for (int s0 = 0; s0 < KS; s0 += BS) {
        bf16x8 av[BS], bv[NT][BS];
#pragma unroll
        for (int s = 0; s < BS; ++s) if (s0 + s < KS) { av[s] = *(const bf16x8*)(ap + 32 * (s0 + s));
#pragma unroll
            for (int j = 0; j < NT; ++j) bv[j][s] = *(const bf16x8*)(bp[j] + 32 * (s0 + s)); }
#pragma unroll
        for (int s = 0; s < BS; ++s) if (s0 + s < KS) {
#pragma unroll
            for (int j = 0; j < NT; ++j) acc[j] = MFMA16(av[s], bv[j][s], acc[j]); }
    }
    LAS float* red = (LAS float*)F.lds;
#pragma unroll
    for (int j = 0; j < NT; ++j)
#pragma unroll
        for (int r = 0; r < 4; ++r) red[(F.wave * 16 + 4 * kq + r) * (16 * NT) + 16 * j + col] = acc[j][r];
    __syncthreads();
    if (F.wave == 0) {
#pragma unroll
        for (int r = 0; r < 4; ++r)
#pragma unroll
            for (int j = 0; j < NT; ++j) { float t = 0.f;
#pragma unroll
                for (int w = 0; w < 8; ++w) t += red[(w * 16 + 4 * kq + r) * (16 * NT) + 16 * j + col];
                v[r][j] = t; } }
    __syncthreads();
}
template <int N> __device__ __forceinline__ float meta_rstd(const float* ssm, int row) { float s = 0.f;
#pragma unroll
    for (int i = 0; i < N; ++i) s += ssm[row * N + i];
    return 1.0f / sqrtf(s * (1.0f / 1024.0f) + EPS); }
__device__ __forceinline__ void meta_store_rows(const Frame& F, const float (&v)[4][4], bf16* dst, int pitch, int cb, int nb) {
    const int lane = F.lane; LAS unsigned char* st = F.lds + 96 * 1024;
#pragma unroll
    for (int r = 0; r < 4; ++r)
#pragma unroll
        for (int j = 0; j < 4; ++j) *(LAS bf16*)(st + (4 * (lane >> 4) + r) * 144 + 2 * (16 * j + (lane & 15))) = (bf16)(pk2(v[r][j], 0.f) & 0xffffu);
    LDS_WAIT();
#pragma unroll
    for (int i = 0; i < 2; ++i) { const int c = lane + 64 * i, row = c >> 3, ch = c & 7; const u32x4 x = *(const LAS u32x4*)(st + row * 144 + 16 * ch);
        for (int b = 0; b < nb; ++b) *(u32x4*)(dst + ((size_t)b * KROWS + 48 + row) * pitch + cb + 8 * ch) = x; }
    LDS_WAIT();
}
__device__ __forceinline__ void meta_p1(const Frame& F, CArgsP a) {
    unsigned char* ws = a->ws;
    const int t = F.vcu; if (t >= 88) return;
    const int lane = F.lane, f0 = 32 * t, pn = f0 >> 7, jj = f0 & 127; const int prow[4] = {256 * pn + jj, 256 * pn + jj + 16, 256 * pn + 128 + jj, 256 * pn + 128 + jj + 16};
    float v[4][4]; meta_block_mm<4, 4, 4>(F, (const bf16*)(ws + WS_META + MO_HBM), (const bf16*)(ws + WS_WGU1), prow, DM, v);
    if (F.wave != 0) return;
    unsigned char* actm = ws + WS_META + MO_ACTM; const float* ssm = (const float*)(ws + WS_META + MO_SSM0);
#pragma unroll
    for (int r = 0; r < 4; ++r) { const int row = 4 * (lane >> 4) + r; const float rs = meta_rstd<16>(ssm, row);
        const float a0 = pg8::silu_mul(v[r][0] * rs, v[r][2] * (rs * ACT_SCALE)), a1 = pg8::silu_mul(v[r][1] * rs, v[r][3] * (rs * ACT_SCALE));
        const unsigned p = pg8::pk8(a0, a0, a1, a1);
        actm[row * FF + f0 + (lane & 15)] = (unsigned char)(p & 0xffu); actm[row * FF + f0 + 16 + (lane & 15)] = (unsigned char)((p >> 16) & 0xffu); }
}
__device__ __forceinline__ void meta_p2(const Frame& F, CArgsP a) {
    unsigned char* ws = a->ws;
    if (F.vcu >= 64) return;
    const int t = F.vcu, lane = F.lane, col = lane & 15, kq = lane >> 4;
    const unsigned char* ap = ws + WS_META + MO_ACTM + (size_t)col * FF + 32 * kq; const unsigned char* bp = ws + WS_WD1 + (size_t)(16 * t + col) * FF + 32 * kq;
    u32x4 av[3][2], bv[3][2];
#pragma unroll
    for (int i = 0; i < 3; ++i) { const int s = F.wave + 8 * i; if (s < 22) { av[i][0] = *(const u32x4*)(ap + 128 * s); av[i][1] = *(const u32x4*)(ap + 128 * s + 16); bv[i][0] = *(const u32x4*)(bp + 128 * s); bv[i][1] = *(const u32x4*)(bp + 128 * s + 16); } }
    f32x4 acc = {0.f, 0.f, 0.f, 0.f};
#pragma unroll
    for (int i = 0; i < 3; ++i) if (F.wave + 8 * i < 22) { typedef int i32x8 __attribute__((ext_vector_type(8)));
        const i32x8 A = {(int)av[i][0].x, (int)av[i][0].y, (int)av[i][0].z, (int)av[i][0].w, (int)av[i][1].x, (int)av[i][1].y, (int)av[i][1].z, (int)av[i][1].w};
        const i32x8 B = {(int)bv[i][0].x, (int)bv[i][0].y, (int)bv[i][0].z, (int)bv[i][0].w, (int)bv[i][1].x, (int)bv[i][1].y, (int)bv[i][1].z, (int)bv[i][1].w};
        acc = __builtin_amdgcn_mfma_scale_f32_16x16x128_f8f6f4(A, B, acc, 0, 0, 0, 0x7F7F7F7F, 0, 0x7F7F7F7F); }
    LAS float* red = (LAS float*)F.lds;
#pragma unroll
    for (int r = 0; r < 4; ++r) red[(F.wave * 16 + 4 * kq + r) * 16 + col] = acc[r];
    __syncthreads();
    if (F.wave == 0) {
        bf16* h1mb = (bf16*)(ws + WS_META + MO_H1MB); float* ssm1 = (float*)(ws + WS_META + MO_SSM1);
#pragma unroll
        for (int r = 0; r < 4; ++r) { const int row = 4 * kq + r; const int c = 16 * t + col; float d = 0.f;
#pragma unroll
            for (int w = 0; w < 8; ++w) d += red[(w * 16 + row) * 16 + col];
            const float h = a->in[1][row * DM + c] + d * (0.5f / (ACT_SCALE * WD_SCALE)); float sq = h * h; h1mb[row * DM + c] = (bf16)(pk2(h, 0.f) & 0xffffu);
            sq += __shfl_xor(sq, 1); sq += __shfl_xor(sq, 2); sq += __shfl_xor(sq, 4); sq += __shfl_xor(sq, 8);
            if (col == 0) ssm1[row * 64 + t] = sq; } }
    __syncthreads();
}
__device__ __forceinline__ void meta_p3(const Frame& F, CArgsP a) {
    unsigned char* ws = a->ws; const int lane = F.lane;
    if (F.vcu > 17) return;
    const bf16* A16 = (const bf16*)(ws + WS_META + MO_H1MB); const bf16* Wt = (const bf16*)(ws + WS_WIN); const float* ssm1 = (const float*)(ws + WS_META + MO_SSM1);
    if (F.vcu < 17) { const int t = F.vcu; int L, kind; if (t < 8) { L = 512 + 64 * t; kind = 1; } else if (t < 16) { L = 1024 + 64 * (t - 8); kind = 2; } else { L = 2816; kind = 3; }
        const int pn = L >> 8, wc = (L & 255) >> 6, base = 256 * pn + 32 * wc; const int prow[4] = {base, base + 16, base + 128, base + 144};
        float v[4][4]; meta_block_mm<4, 4, 4>(F, A16, Wt, prow, DM, v);
        if (F.wave != 0) return;
#pragma unroll
        for (int r = 0; r < 4; ++r) { const float rs = meta_rstd<64>(ssm1, 4 * (lane >> 4) + r);
#pragma unroll
            for (int j = 0; j < 4; ++j) v[r][j] *= rs;
            if (kind == 1) { float sq = (v[r][0] * v[r][0] + v[r][1] * v[r][1]) + (v[r][2] * v[r][2] + v[r][3] * v[r][3]);
                sq += __shfl_xor(sq, 1); sq += __shfl_xor(sq, 2); sq += __shfl_xor(sq, 4); sq += __shfl_xor(sq, 8);
                const float r2 = 1.0f / sqrtf(sq * (1.0f / 64.0f) + EPS);
#pragma unroll
                for (int j = 0; j < 4; ++j) v[r][j] *= r2 * a->in[10][16 * j + (lane & 15)]; } }
        if (kind == 1) meta_store_rows(F, v, (bf16*)(ws + WS_KA), 512, L - 512, NB);
        else if (kind == 2) meta_store_rows(F, v, (bf16*)(ws + WS_VA), 512, L - 1024, NB);
        else meta_store_rows(F, v, (bf16*)(ws + WS_IK), 64, 0, NB);
    } else {
        float v8[2][4][8]; float sq[4] = {0.f, 0.f, 0.f, 0.f};
#pragma unroll
        for (int c = 0; c < 2; ++c) { const int b0 = 2048 + 32 * (2 * c), b1 = 2048 + 32 * (2 * c + 1); const int prow[8] = {b0, b0 + 16, b0 + 128, b0 + 144, b1, b1 + 16, b1 + 128, b1 + 144};
            meta_block_mm<4, 8, 4>(F, A16, Wt, prow, DM, v8[c]); }
        if (F.wave != 0) return;
        float v[4][4][4];
#pragma unroll
        for (int r = 0; r < 4; ++r) { const float rs = meta_rstd<64>(ssm1, 4 * (lane >> 4) + r);
#pragma unroll
            for (int g = 0; g < 4; ++g)
#pragma unroll
                for (int j = 0; j < 4; ++j) { v[g][r][j] = v8[g >> 1][r][4 * (g & 1) + j] * rs; sq[r] += v[g][r][j] * v[g][r][j]; }
            sq[r] += __shfl_xor(sq[r], 1); sq[r] += __shfl_xor(sq[r], 2); sq[r] += __shfl_xor(sq[r], 4); sq[r] += __shfl_xor(sq[r], 8);
            const float r2 = 1.0f / sqrtf(sq[r] * (1.0f / 256.0f) + EPS);
#pragma unroll
            for (int g = 0; g < 4; ++g)
#pragma unroll
                for (int j = 0; j < 4; ++j) v[g][r][j] *= r2 * a->in[16][64 * g + 16 * j + (lane & 15)]; }
#pragma unroll
        for (int g = 0; g < 4; ++g) meta_store_rows(F, v[g], (bf16*)(ws + WS_C), 256, 64 * g, 1);
    }
}

__device__ __forceinline__ void meta_p4(const Frame& F, CArgsP a) {
    unsigned char* ws = a->ws; const int lane = F.lane;
    if (F.vcu >= 16) return;
    const int t = F.vcu; const int prow[4] = {64 * t, 64 * t + 16, 64 * t + 32, 64 * t + 48};
    float v[4][4]; meta_block_mm<1, 4, 1>(F, (const bf16*)(ws + WS_C) + (size_t)48 * 256, (const bf16*)(ws + WS_WKV), prow, 256, v);
    if (F.wave != 0) return;
    meta_store_rows(F, v, (bf16*)(ws + (t < 8 ? WS_KK : WS_VV)), 512, 64 * (t & 7), NB);
}

#define XB_TMO      128
#define XB_XCNT(j)  (256  + 64 * (j))
#define XB_XSUB(j)  (1280 + 64 * (j))
#define XB_XGEN(j)  (2304 + 64 * (j))
#define XB_TOP      3328
#define XB_TOPGEN   3392
#define XCD_BAR_WORDS 3456
#define XB_SPIN_CAP (1u << 18)

__device__ __forceinline__ unsigned xb_ld(unsigned* p)              { return __hip_atomic_load(p, __ATOMIC_RELAXED, __HIP_MEMORY_SCOPE_AGENT); }
__device__ __forceinline__ unsigned xb_add(unsigned* p, unsigned v) { return __hip_atomic_fetch_add(p, v, __ATOMIC_RELAXED, __HIP_MEMORY_SCOPE_AGENT); }
__device__ __forceinline__ unsigned xb_xcc_id() { return (unsigned)__builtin_amdgcn_s_getreg((3 << 11) | 20) & 0xFu; }
#define XB_SPIN(cond, bar) do { unsigned _sp = 0; while (cond) { __builtin_amdgcn_s_sleep(1); \
    if ((++_sp & 255u) == 0u) { if (xb_ld(&(bar)[XB_TMO])) break; if (_sp > XB_SPIN_CAP) { atomicAdd(&(bar)[XB_TMO], 1u); break; } } } } while (0)

struct XcdBarrier {
    unsigned* bar; unsigned x; int w;
    volatile LAS unsigned* st;
};

__device__ __forceinline__ XcdBarrier xcd_barrier_post(unsigned* bar, volatile LAS unsigned* st) {
    XcdBarrier b; b.bar = bar; b.x = xb_xcc_id(); b.st = st;
    if (threadIdx.x == 0) (void)xb_add(&bar[XB_XCNT(b.x)], 1u);
    return b;
}
__device__ __forceinline__ void xcd_barrier_complete(unsigned* bar, unsigned x, unsigned& nloc, unsigned& nx) {
    const unsigned G = gridDim.x * gridDim.y * gridDim.z;
    unsigned sum, cnt, mine, sp = 0u;
    for (;;) {
        sum = 0u; cnt = 0u; mine = 0u;
#pragma unroll
        for (unsigned j = 0; j < 16; ++j) { const unsigned c = xb_ld(&bar[XB_XCNT(j)]); sum += c; cnt += (c > 0u) ? 1u : 0u; mine = (j == x) ? c : mine; }
        if (sum == G) break;
        __builtin_amdgcn_s_sleep(1);
        if ((++sp & 255u) == 0u) { if (xb_ld(&bar[XB_TMO])) break; if (sp > XB_SPIN_CAP) { atomicAdd(&bar[XB_TMO], 1u); break; } }
    }
    nloc = mine > 0u ? mine : 1u; nx = cnt > 0u ? cnt : 1u;
}

__device__ __forceinline__ void xcd_barrier(const XcdBarrier& b) {
    asm volatile("s_waitcnt vmcnt(0)" ::: "memory");
    __syncthreads();
    if (b.w == 0 && pg8::lane_id() == 0) {
        unsigned* bar = b.bar;
        __builtin_amdgcn_s_waitcnt(0);
        unsigned nloc = b.st[0], nx = b.st[1];
        if (nloc == 0u) { xcd_barrier_complete(bar, b.x, nloc, nx); b.st[0] = nloc; b.st[1] = nx; }
        const unsigned old = xb_add(&bar[XB_XSUB(b.x)], 1u);
        const unsigned gen = old / nloc;
        if (old + 1u == (gen + 1u) * nloc) {
            __builtin_amdgcn_fence(__ATOMIC_RELEASE, "agent");
            asm volatile("s_waitcnt vmcnt(0)" ::: "memory");
            const unsigned og = xb_add(&bar[XB_TOP], 1u);
            const unsigned tg = og / nx;
            if (og + 1u == (tg + 1u) * nx) xb_add(&bar[XB_TOPGEN], 1u);
            else XB_SPIN(xb_ld(&bar[XB_TOPGEN]) == tg, bar);
            __builtin_amdgcn_fence(__ATOMIC_ACQUIRE, "agent");
            xb_add(&bar[XB_XGEN(b.x)], 1u);
            asm volatile("s_waitcnt vmcnt(0)" ::: "memory");
        } else {
            XB_SPIN(xb_ld(&bar[XB_XGEN(b.x)]) == gen, bar);
            __builtin_amdgcn_fence(__ATOMIC_ACQUIRE, "agent");
            asm volatile("s_waitcnt vmcnt(0)" ::: "memory");
        }
    }
    __syncthreads();
}
constexpr int G4 = 1040, TROW = 272, TILEB = 16 * G4  , BUFB = 2 * TILEB  ;
__device__ __forceinline__ unsigned offg(unsigned row, unsigned ch) { return (row >> 2) * (unsigned)G4 + (row & 3u) * 256u + 16u * (ch ^ (4u * (row & 3u))); }
__device__ __constant__ unsigned char kBucket[128] = {
    0, 1, 2, 3, 4, 5, 6, 7, 8, 9, 10, 11, 12, 13, 14, 15, 16, 16, 16, 17, 17, 18, 18, 18, 19, 19, 19, 20, 20, 20, 20, 21, 21, 21, 21, 22, 22, 22, 22, 22, 23, 23, 23, 23, 23, 23, 24, 24, 24, 24, 24, 24,
    25, 25, 25, 25, 25, 25, 25, 26, 26, 26, 26, 26, 26, 26, 26, 27, 27, 27, 27, 27, 27, 27, 27, 27, 27, 28, 28, 28, 28, 28, 28, 28, 28, 28, 28, 29, 29, 29, 29, 29, 29, 29, 29, 29, 29, 29, 29,
    30, 30, 30, 30, 30, 30, 30, 30, 30, 30, 30, 30, 30, 30, 31, 31, 31, 31, 31, 31, 31, 31, 31, 31, 31, 31, 31, 31, 31};
__device__ __forceinline__ unsigned piece_src(int lane, unsigned RP) { const unsigned j = (unsigned)lane >> 4; return j * RP + 16u * (((unsigned)lane & 15u) ^ (4u * j)); }
__device__ __forceinline__ void dma_piece(const void* gbase  , unsigned voff, unsigned m0v  ) {
    unsigned keep;
    asm volatile("s_mov_b32 %0, m0\n\ts_mov_b32 m0, %3\n\ts_nop 0\n\tglobal_load_lds_dwordx4 %1, %2\n\ts_mov_b32 m0, %0" : "=&s"(keep) : "v"(voff), "s"(gbase), "s"(m0v) : "memory");
}
__device__ __forceinline__ void tile_dma(const bf16* Kg, const bf16* Vg, LAS unsigned char* buf, int wid, int lane) {
    const bf16* k0 = Kg + (size_t)(8 * wid) * 512; const bf16* k1 = k0 + 4 * 512; const bf16* v0 = Vg + (size_t)(8 * wid) * 512; const bf16* v1 = v0 + 4 * 512;
    const unsigned mk = (unsigned)__builtin_amdgcn_readfirstlane((int)(unsigned)(uintptr_t)(buf + 2 * wid * G4)), mv = mk + TILEB;
    const unsigned vo = piece_src(lane, 1024u); unsigned keep;
    asm volatile("s_mov_b32 %0, m0\n\t"
                 "s_mov_b32 m0, %6\n\ts_nop 0\n\tglobal_load_lds_dwordx4 %1, %2\n\t"
                 "s_add_u32 m0, m0, 0x410\n\ts_nop 0\n\tglobal_load_lds_dwordx4 %1, %3\n\t"
                 "s_mov_b32 m0, %7\n\ts_nop 0\n\tglobal_load_lds_dwordx4 %1, %4\n\t"
                 "s_add_u32 m0, m0, 0x410\n\ts_nop 0\n\tglobal_load_lds_dwordx4 %1, %5\n\t"
                 "s_mov_b32 m0, %0"
                 : "=&s"(keep) : "v"(vo), "s"(k0), "s"(k1), "s"(v0), "s"(v1), "s"(mk), "s"(mv) : "memory", "scc");
}
#define DMA_WAIT() asm volatile("s_waitcnt vmcnt(0)" ::: "memory")
__device__ __forceinline__ void store_rows_via_lds(const f32x16 (&o)[4], float sc, const float* gain, LAS unsigned char* stage, bf16* grow0  , int lane) {
    const int r32 = lane & 31, hi = lane >> 5;
#pragma unroll
    for (int dt = 0; dt < 4; ++dt)
#pragma unroll
        for (int g = 0; g < 4; ++g) { const int d0 = 32 * dt + 8 * g + 4 * hi; f32x4 gn = {1.f, 1.f, 1.f, 1.f}; if (gain) gn = *(const f32x4*)(gain + d0);
            u32x2 w; w.x = pk2(o[dt][4 * g] * sc * gn[0], o[dt][4 * g + 1] * sc * gn[1]); w.y = pk2(o[dt][4 * g + 2] * sc * gn[2], o[dt][4 * g + 3] * sc * gn[3]);
            *(LAS u32x2*)(stage + r32 * TROW + d0 * 2) = w; }
    LDS_WAIT();
#pragma unroll
    for (int i = 0; i < 8; ++i) { const int row = 4 * i + (lane >> 4), ch = lane & 15; const u32x4 v = *(const LAS u32x4*)(stage + row * TROW + ch * 16);
        *(u32x4*)(grow0 + (size_t)row * 1024 + ch * 8) = v; }
}
__device__ __forceinline__ unsigned xch(int c, int j) { return 16u * (unsigned)(c ^ (4 * j)); }
typedef short v4i16_t __attribute__((ext_vector_type(4)));
__device__ __forceinline__ s16x4 vtr(const LAS unsigned char* p) { return __builtin_bit_cast(s16x4, __builtin_amdgcn_ds_read_tr16_b64_v4i16((LAS v4i16_t*)p)); }
__device__ __forceinline__ bf16x8 vfrag(const LAS unsigned char* Vb, int lane, int kb, int sp, int dt) {
    const int hi = lane >> 5, blk = (lane >> 4) & 1, qq = (lane & 15) >> 2, p = lane & 3;
    const unsigned ch = 4 * dt + 2 * blk + (p >> 1);
    const unsigned r0 = 32 * kb + 16 * sp + 4 * hi + qq;
    const s16x4 lo = vtr(Vb + offg(r0, ch) + 8 * (p & 1)), hh = vtr(Vb + offg(r0 + 8, ch) + 8 * (p & 1));
    return (bf16x8){lo[0], lo[1], lo[2], lo[3], hh[0], hh[1], hh[2], hh[3]};
}
__device__ __forceinline__ bf16x8 pack8(const f32x16& x, int s) {
    u32x4 p; p.x = pk2(x[8 * s], x[8 * s + 1]); p.y = pk2(x[8 * s + 2], x[8 * s + 3]); p.z = pk2(x[8 * s + 4], x[8 * s + 5]); p.w = pk2(x[8 * s + 6], x[8 * s + 7]);
    return __builtin_bit_cast(bf16x8, p);
}
__device__ __forceinline__ void build_lut(LAS float* lut, const float* rel_bias, int col, int tid) {
    if (tid < 128) lut[tid] = rel_bias[kBucket[tid] * 8 + col] * LOG2E;
}

constexpr int LDS_AQ = 67072;
__device__ __forceinline__ void exp_block(f32x16& s, const LAS float* lut, bool interior, int kr0, int qrow, int hi, float& l) {
    if (interior) {
#pragma unroll
        for (int r = 0; r < 16; ++r) { s[r] = __builtin_amdgcn_exp2f(s[r]); l += s[r]; } }
    else {
#pragma unroll
        for (int r = 0; r < 16; ++r) { const int kr = kr0 + crow(r, hi), n = qrow - kr; const bool ok = (n >= 0) && (kr >= 48);
            const int idx = n < 0 ? 0 : (n > 127 ? 127 : n); const float e = __builtin_amdgcn_exp2f(s[r] + lut[idx]);
            s[r] = ok ? e : 0.f; l += s[r];
            if ((r & 3) == 3) asm volatile("" ::: "memory"); } }
}
__device__ __forceinline__ void attnA_unit(const Frame& F, CArgsP a, int b, int head, int qb8, float lam, int abl) {
    unsigned char* ws = a->ws; const int tid = F.tid, lane = F.lane, wid = F.wave, r32 = lane & 31, hi = lane >> 5;
    LAS unsigned char* lds = F.lds; LAS float* lut = (LAS float*)(lds + LDS_LUT);
    const int qrow0 = 64 + 256 * qb8 + 32 * wid, qrow = qrow0 + r32;
    const size_t gq = (size_t)b * SEQ + 256 * qb8 + 32 * wid + r32;
    const bf16* Kg = (const bf16*)(ws + WS_KA) + (size_t)b * KROWS * 512 + head * 128;
    const bf16* Vg = (const bf16*)(ws + WS_VA) + (size_t)b * KROWS * 512 + head * 128;
    const int nt = 4 * qb8 + 5, wlast = (qrow0 + 31) >> 6;
    tile_dma(Kg, Vg, lds, wid, lane);
    build_lut(lut, a->in[2], head, tid);
    { const bf16* qg = (const bf16*)(ws + WS_QA) + ((size_t)b * SEQ + 256 * qb8 + 32 * wid) * 512 + head * 128;
      const unsigned mq = (unsigned)__builtin_amdgcn_readfirstlane((int)(unsigned)(uintptr_t)(lds + LDS_AQ + 8 * wid * G4)); const unsigned vo = piece_src(lane, 1024u);
#pragma unroll
      for (int i = 0; i < 8; ++i) dma_piece(qg + (size_t)(4 * i) * 512, vo, mq + i * G4); }
    const int j4 = r32 & 3;
    const LAS unsigned char* qb_ = lds + LDS_AQ + (8 * wid + (r32 >> 2)) * G4 + j4 * 256;
    float l1 = 0.f, l2 = 0.f;
    f32x16 o1[4], o2[4];
#pragma unroll
    for (int dt = 0; dt < 4; ++dt) { o1[dt] = (f32x16){}; o2[dt] = (f32x16){}; }
    DMA_WAIT(); __syncthreads();
#pragma unroll 1
    for (int jt = 0; jt < nt; ++jt) {
        LAS unsigned char* cur = lds + (jt & 1) * BUFB; LAS unsigned char* nxt = lds + ((jt + 1) & 1) * BUFB;
        if (jt + 1 < nt && !(abl & 1)) tile_dma(Kg + (size_t)(jt + 1) * 64 * 512, Vg + (size_t)(jt + 1) * 64 * 512, nxt, wid, lane);
        if (jt <= wlast && !(abl & 2)) {
#pragma unroll 1
            for (int kb = 0; kb < 2; ++kb) { const int kr0 = 64 * jt + 32 * kb;
                if (kr0 <= qrow0 + 31) {
                    const LAS unsigned char* kbase = cur + (8 * kb + (r32 >> 2)) * G4 + j4 * 256;
                    const bool interior = (kr0 >= 64) && (kr0 + 31 + 113 <= qrow0);
                    bf16x8 p1a, p1b, p2a, p2b;
                    const float c0 = interior ? lut[127] : 0.f;
                    f32x16 s1, s2;
#pragma unroll
                    for (int r = 0; r < 16; ++r) { s1[r] = c0; s2[r] = c0; }
#pragma unroll
                    for (int s = 0; s < 4; ++s) { const unsigned x = xch(2 * s + hi, j4); const bf16x8 kf = *(const LAS bf16x8*)(kbase + x); const bf16x8 qf = *(const LAS bf16x8*)(qb_ + x); s1 = MFMA32(kf, qf, s1); }
#pragma unroll
                    for (int s = 0; s < 4; ++s) { const unsigned x = xch(8 + 2 * s + hi, j4); const bf16x8 kf = *(const LAS bf16x8*)(kbase + x); const bf16x8 qf = *(const LAS bf16x8*)(qb_ + x); s2 = MFMA32(kf, qf, s2); }
                    exp_block(s1, lut, interior, kr0, qrow, hi, l1); p1a = pack8(s1, 0); p1b = pack8(s1, 1);
                    exp_block(s2, lut, interior, kr0, qrow, hi, l2); p2a = pack8(s2, 0); p2b = pack8(s2, 1);
                    const LAS unsigned char* vb = cur + TILEB + kb * (8 * G4);
#pragma unroll
                    for (int dt = 0; dt < 4; ++dt) { const bf16x8 v0 = vfrag(vb, lane, 0, 0, dt), v1 = vfrag(vb, lane, 0, 1, dt);
                        o1[dt] = MFMA32(v0, p1a, o1[dt]); o2[dt] = MFMA32(v0, p2a, o2[dt]); o1[dt] = MFMA32(v1, p1b, o1[dt]); o2[dt] = MFMA32(v1, p2b, o2[dt]); }
                } }
        }
        DMA_WAIT(); __syncthreads();
    }
    l1 += __shfl_xor(l1, 32); l2 += __shfl_xor(l2, 32);
    const float c1 = 1.0f / l1, c2 = lam / l2;
    float sq = 0.f;
#pragma unroll
    for (int dt = 0; dt < 4; ++dt)
#pragma unroll
        for (int r = 0; r < 16; ++r) { o1[dt][r] = o1[dt][r] * c1 - o2[dt][r] * c2; sq += o1[dt][r] * o1[dt][r]; }
    sq += __shfl_xor(sq, 32);
    const float rs = SUBLN_SCALE / sqrtf(sq * (1.0f / 128.0f) + EPS);
    store_rows_via_lds(o1, rs, a->in[15], lds + wid * (32 * TROW), (bf16*)a->out + (gq - r32) * 1024 + head * 128, lane);
    __syncthreads();
}

__device__ __forceinline__ void attnB_unit(const Frame& F, CArgsP a, int b, int head, int qb8, int abl) {
    unsigned char* ws = a->ws; const int tid = F.tid, lane = F.lane, wid = F.wave, r32 = lane & 31, hi = lane >> 5;
    LAS unsigned char* lds = F.lds; LAS float* lut = (LAS float*)(lds + LDS_LUT);
    const int qrow0 = 64 + 256 * qb8 + 32 * wid, qrow = qrow0 + r32;
    const size_t gq = (size_t)b * SEQ + 256 * qb8 + 32 * wid + r32;
    const bf16* Kg = (const bf16*)(ws + WS_KK) + (size_t)b * KROWS * 512 + head * 128;
    const bf16* Vg = (const bf16*)(ws + WS_VV) + (size_t)b * KROWS * 512 + head * 128;
    const unsigned* selp = (const unsigned*)(ws + WS_SEL) + gq * SELW;
    const int nt = 4 * qb8 + 5, wlast = (qrow0 + 31) >> 6;
    tile_dma(Kg, Vg, lds, wid, lane);
    build_lut(lut, a->in[2], 4 + head, tid);
    const int j4 = r32 & 3;
    bf16x8 qf[8];
    { const bf16* qp = (const bf16*)(ws + WS_QB) + gq * 512 + head * 128 + 8 * hi;
#pragma unroll
      for (int s = 0; s < 8; ++s) qf[s] = *(const bf16x8*)(qp + 16 * s); }
    float ysq = 0.f;
    if (!(abl & 128)) {
        { const unsigned char* wg = ws + WS_WUKT + (size_t)head * 256 * 256 + (size_t)(32 * wid) * 256;
          const unsigned mb = (unsigned)__builtin_amdgcn_readfirstlane((int)(unsigned)(uintptr_t)(lds + LDS_AQ + 8 * wid * G4)); const unsigned vo = piece_src(lane, 256u);
#pragma unroll
          for (int i = 0; i < 8; ++i) dma_piece(wg + i * 4 * 256, vo, mb + i * G4); }
        DMA_WAIT(); __syncthreads();
        const LAS unsigned char* wb = lds + LDS_AQ + (r32 >> 2) * G4 + j4 * 256;
#pragma unroll 2
        for (int ct = 0; ct < 8; ++ct) { f32x16 y = (f32x16){};
#pragma unroll
            for (int s = 0; s < 8; ++s) { const bf16x8 wf = *(const LAS bf16x8*)(wb + ct * (8 * G4) + xch(2 * s + hi, j4)); y = MFMA32(wf, qf[s], y); }
#pragma unroll
            for (int r = 0; r < 16; ++r) ysq += y[r] * y[r]; }
    }
    ysq += __shfl_xor(ysq, 32);
    const float scq = B_QSCALE / sqrtf(ysq * (1.0f / 256.0f) + EPS);
    float l = 0.f;
    f32x16 o[4];
#pragma unroll
    for (int dt = 0; dt < 4; ++dt) o[dt] = (f32x16){};
    u32x2 mw = *(const u32x2*)(selp), mwn = mw;
    DMA_WAIT(); __syncthreads();
#pragma unroll 1
    for (int jt = 0; jt < nt; ++jt) {
        LAS unsigned char* cur = lds + (jt & 1) * BUFB; LAS unsigned char* nxt = lds + ((jt + 1) & 1) * BUFB;
        if (jt + 1 < nt) { if (!(abl & 1)) tile_dma(Kg + (size_t)(jt + 1) * 64 * 512, Vg + (size_t)(jt + 1) * 64 * 512, nxt, wid, lane); mwn = *(const u32x2*)(selp + 2 * (jt + 1)); }
        if (wid >= 4 && 64 * jt + 63 + 113 <= qrow0 && !(abl & 2)) {
            const LAS unsigned char* kb0 = cur + (r32 >> 2) * G4 + j4 * 256; const float bf = lut[127];
            f32x16 sa = (f32x16){}, sb = (f32x16){};
#pragma unroll
            for (int s = 0; s < 8; ++s) { const bf16x8 kf = *(const LAS bf16x8*)(kb0 + xch(2 * s + hi, j4)); sa = MFMA32(kf, qf[s], sa); }
#pragma unroll
            for (int s = 0; s < 8; ++s) { const bf16x8 kf = *(const LAS bf16x8*)(kb0 + 8 * G4 + xch(2 * s + hi, j4)); sb = MFMA32(kf, qf[s], sb); }
            const int mha = (int)(mw.x >> (4 * hi)), mhb = (int)(mw.y >> (4 * hi));
#pragma unroll
            for (int r = 0; r < 16; ++r) { const float e = __builtin_amdgcn_exp2f(sa[r] * scq + bf); sa[r] = __uint_as_float(__float_as_uint(e) & (unsigned)__builtin_amdgcn_sbfe(mha, (r & 3) + 8 * (r >> 2), 1)); l += sa[r]; }
            { const bf16x8 pa0 = pack8(sa, 0), pa1 = pack8(sa, 1); const LAS unsigned char* vb = cur + TILEB;
#pragma unroll
              for (int dt = 0; dt < 4; ++dt) { const bf16x8 v0 = vfrag(vb, lane, 0, 0, dt), v1 = vfrag(vb, lane, 0, 1, dt); o[dt] = MFMA32(v0, pa0, o[dt]); o[dt] = MFMA32(v1, pa1, o[dt]); } }
#pragma unroll
            for (int r = 0; r < 16; ++r) { const float e = __builtin_amdgcn_exp2f(sb[r] * scq + bf); sb[r] = __uint_as_float(__float_as_uint(e) & (unsigned)__builtin_amdgcn_sbfe(mhb, (r & 3) + 8 * (r >> 2), 1)); l += sb[r]; }
            { const bf16x8 pa0 = pack8(sb, 0), pa1 = pack8(sb, 1); const LAS unsigned char* vb = cur + TILEB + 8 * G4;
#pragma unroll
              for (int dt = 0; dt < 4; ++dt) { const bf16x8 v0 = vfrag(vb, lane, 0, 0, dt), v1 = vfrag(vb, lane, 0, 1, dt); o[dt] = MFMA32(v0, pa0, o[dt]); o[dt] = MFMA32(v1, pa1, o[dt]); } }
        } else
        if (jt <= wlast && !(abl & 2)) {
#pragma unroll
            for (int kb = 0; kb < 2; ++kb) { const int kr0 = 64 * jt + 32 * kb;
                if (kr0 <= qrow0 + 31) {
                    const LAS unsigned char* kbase = cur + (8 * kb + (r32 >> 2)) * G4 + j4 * 256;
                    f32x16 s1 = (f32x16){};
#pragma unroll
                    for (int s = 0; s < 8; ++s) { const bf16x8 kf = *(const LAS bf16x8*)(kbase + xch(2 * s + hi, j4)); s1 = MFMA32(kf, qf[s], s1); }
                    const int mh = (int)((kb ? mw.y : mw.x) >> (4 * hi));
                    const bool interior = (kr0 + 31 + 113 <= qrow0);
                    if (interior) { const float bf = lut[127];
#pragma unroll
                        for (int r = 0; r < 16; ++r) { const float e = __builtin_amdgcn_exp2f(s1[r] * scq + bf); s1[r] = __uint_as_float(__float_as_uint(e) & (unsigned)__builtin_amdgcn_sbfe(mh, (r & 3) + 8 * (r >> 2), 1)); } }
                    else {
#pragma unroll
                        for (int r = 0; r < 16; ++r) { const int kr = kr0 + crow(r, hi), n = qrow - kr; const int idx = n < 0 ? 0 : (n > 127 ? 127 : n);
                            const float e = __builtin_amdgcn_exp2f(s1[r] * scq + lut[idx]); s1[r] = __uint_as_float(__float_as_uint(e) & (unsigned)__builtin_amdgcn_sbfe(mh, (r & 3) + 8 * (r >> 2), 1)); } }
#pragma unroll
                    for (int r = 0; r < 16; ++r) l += s1[r];
                    const bf16x8 pa0 = pack8(s1, 0), pa1 = pack8(s1, 1);
                    const LAS unsigned char* vb = cur + TILEB + kb * (8 * G4);
#pragma unroll
                    for (int dt = 0; dt < 4; ++dt) { const bf16x8 v0 = vfrag(vb, lane, 0, 0, dt), v1 = vfrag(vb, lane, 0, 1, dt);
                        o[dt] = MFMA32(v0, pa0, o[dt]); o[dt] = MFMA32(v1, pa1, o[dt]); }
                } }
        }
        mw = mwn;
        DMA_WAIT(); __syncthreads();
    }
    l += __shfl_xor(l, 32);
    const float il = 1.0f / l;
    if (!(abl & 256)) store_rows_via_lds(o, il, nullptr, lds + wid * (32 * TROW), (bf16*)a->out + (gq - r32) * 1024 + 512 + head * 128, lane);
    __syncthreads();
}
__device__ __forceinline__ unsigned lanes_below(unsigned long long m) { return __builtin_amdgcn_mbcnt_hi((unsigned)(m >> 32), __builtin_amdgcn_mbcnt_lo((unsigned)m, 0u)); }
#define DPP_STEP(OP, v, ctrl, rmask, ident) { const int t_ = __builtin_amdgcn_update_dpp((int)(ident), (int)(v), (ctrl), (rmask), 0xf, false); v = OP(v, (decltype(v))t_); }
__device__ __forceinline__ unsigned umax2(unsigned a, unsigned b) { return a > b ? a : b; }
__device__ __forceinline__ unsigned umin2(unsigned a, unsigned b) { return a < b ? a : b; }
__device__ __forceinline__ int iadd2(int a, int b) { return a + b; }
__device__ __forceinline__ unsigned wave_umax(unsigned v) { DPP_STEP(umax2, v, 0x111, 0xf, 0u) DPP_STEP(umax2, v, 0x112, 0xf, 0u) DPP_STEP(umax2, v, 0x114, 0xf, 0u) DPP_STEP(umax2, v, 0x118, 0xf, 0u) DPP_STEP(umax2, v, 0x142, 0xa, 0u) DPP_STEP(umax2, v, 0x143, 0xc, 0u)
    return (unsigned)__builtin_amdgcn_readlane((int)v, 63); }
__device__ __forceinline__ unsigned wave_umin(unsigned v) { DPP_STEP(umin2, v, 0x111, 0xf, 0xffffffffu) DPP_STEP(umin2, v, 0x112, 0xf, 0xffffffffu) DPP_STEP(umin2, v, 0x114, 0xf, 0xffffffffu) DPP_STEP(umin2, v, 0x118, 0xf, 0xffffffffu) DPP_STEP(umin2, v, 0x142, 0xa, 0xffffffffu) DPP_STEP(umin2, v, 0x143, 0xc, 0xffffffffu)
    return (unsigned)__builtin_amdgcn_readlane((int)v, 63); }
__device__ __forceinline__ int wave_isum(int v) { DPP_STEP(iadd2, v, 0x111, 0xf, 0) DPP_STEP(iadd2, v, 0x112, 0xf, 0) DPP_STEP(iadd2, v, 0x114, 0xf, 0) DPP_STEP(iadd2, v, 0x118, 0xf, 0) DPP_STEP(iadd2, v, 0x142, 0xa, 0) DPP_STEP(iadd2, v, 0x143, 0xc, 0)
    return __builtin_amdgcn_readlane(v, 63); }
#define WRITELANE(src, l, old) do { const int s__ = __builtin_amdgcn_readfirstlane(src); asm volatile("s_nop 3\n\tv_writelane_b32 %0, %1, %2" : "+v"(old) : "s"(s__), "n"(l)); } while (0)
template <int NI> __device__ __forceinline__ void select8(unsigned char* ws, const float* sc, int b, int q0, int wid, int lane, int abl) {
    unsigned raw[NI];
    { const unsigned* srow = (const unsigned*)(sc + (size_t)(8 * wid) * SCP);
#pragma unroll
      for (int i = 0; i < NI; ++i) raw[i] = __hip_atomic_load(srow + 64 * i + lane, __ATOMIC_RELAXED, __HIP_MEMORY_SCOPE_AGENT); }
#pragma unroll 1
    for (int qq = 0; qq < 8; ++qq) { const int ql = 8 * wid + qq, t = q0 + ql, qrow = 64 + t, nvalid = t + 17;
        unsigned w[NI];
#pragma unroll
        for (int i = 0; i < NI; ++i) { const int kr = 64 * i + lane; w[i] = ((kr >= 48) && (kr <= qrow)) ? raw[i] : 0u; }
        if (qq < 7 && !(abl & 64)) { const unsigned* srow = (const unsigned*)(sc + (size_t)(ql + 1) * SCP);
#pragma unroll
            for (int i = 0; i < NI; ++i) raw[i] = __hip_atomic_load(srow + 64 * i + lane, __ATOMIC_RELAXED, __HIP_MEMORY_SCOPE_AGENT); }
        unsigned thr = 0u; int quota = 0;
        if (nvalid > 256 && !(abl & 16)) {
            unsigned mn = 0x7fffffffu, mx = 0u;
#pragma unroll
            for (int i = 0; i < NI; ++i) { mx = w[i] > mx ? w[i] : mx; const unsigned v = w[i] ? w[i] : 0x7fffffffu; mn = v < mn ? v : mn; }
            mx = wave_umax(mx); mn = wave_umin(mn);
            unsigned lo = mn, hi = mx + 1u; int chi = 0; bool exact = false;
#pragma unroll 1
            while (hi - lo > 1u) { const unsigned cand = lo + ((hi - lo) >> 1);
                unsigned acc0 = 0u, acc1 = 0u;
#pragma unroll
                for (int i = 0; i < NI; ++i) { const unsigned d = w[i] - cand; if (i & 1) acc1 = __builtin_amdgcn_alignbit(acc1, d, 31); else acc0 = __builtin_amdgcn_alignbit(acc0, d, 31); }
                const int lt = wave_isum(__popc(acc0) + __popc(acc1));
                const int cnt = 64 * NI - lt;
                if (cnt == 256) { lo = cand; exact = true; break; }
                if (cnt > 256) lo = cand; else { hi = cand; chi = cnt; } }
            if (exact) { thr = lo - 1u; quota = 0; } else { thr = lo; quota = 256 - chi; }
        }
        int wlo = 0, whi = 0;
        if (!(abl & 32)) {
            if (quota == 0) {
#pragma unroll
                for (int i = 0; i < NI; ++i) { const unsigned long long bs = __ballot(w[i] > thr);
                    WRITELANE((int)(unsigned)bs, i, wlo); WRITELANE((int)(unsigned)(bs >> 32), i, whi); } }
            else { int tiebase = 0;
#pragma unroll
                for (int i = 0; i < NI; ++i) { const bool gt = w[i] > thr, eq = (w[i] == thr);
                    const unsigned long long be = __ballot(eq); const int rank = tiebase + (int)lanes_below(be);
                    const unsigned long long bs = __ballot(gt || (eq && rank < quota));
                    WRITELANE((int)(unsigned)bs, i, wlo); WRITELANE((int)(unsigned)(bs >> 32), i, whi);
                    tiebase += __popcll(be); } } }
        if (lane < 33) { u32x2 w2; w2.x = (unsigned)wlo; w2.y = (unsigned)whi; *(u32x2*)((unsigned*)(ws + WS_SEL) + ((size_t)b * SEQ + t) * SELW + 2 * lane) = w2; }
    }
}
__device__ __forceinline__ void index_unit(const Frame& F, CArgsP a, int b, int j64, int abl) {
    unsigned char* ws = a->ws; const int lane = F.lane, wid = F.wave, r32 = lane & 31, hi = lane >> 5;
    float* sc = (float*)(ws + WS_SCR) + (size_t)blockIdx.x * 64 * SCP;
    const int q0 = 64 * j64;
    {
        const bf16* ip = (const bf16*)(ws + WS_IQ) + ((size_t)b * SEQ + q0) * 512;
#pragma unroll
        for (int i = 0; i < 8; ++i) { const int c = F.tid + 512 * i, row = c >> 6, ch = c & 63; *(LAS u32x4*)(F.lds + 1040 * row + 16 * ch) = *(const u32x4*)(ip + (size_t)row * 512 + ch * 8); }
    }
    __syncthreads();
    if (!(abl & 4)) {
        const int qi = wid & 1, kbq = wid >> 1, qrow0 = 64 + q0 + 32 * qi; const size_t gq = (size_t)b * SEQ + q0 + 32 * qi + r32;
        float wv[8];
        { const f32x4 w0 = *(const f32x4*)((const float*)(ws + WS_IW) + gq * 8), w1 = *(const f32x4*)((const float*)(ws + WS_IW) + gq * 8 + 4);
          wv[0] = w0[0]; wv[1] = w0[1]; wv[2] = w0[2]; wv[3] = w0[3]; wv[4] = w1[0]; wv[5] = w1[1]; wv[6] = w1[2]; wv[7] = w1[3]; }
        const LAS unsigned char* iql = F.lds + 1040 * (32 * qi + r32) + 16 * hi;
        const int ng = (q0 + 128 + 127) >> 7;
        const bf16* ikb = (const bf16*)(ws + WS_IK) + (size_t)b * KROWS * 64 + (size_t)r32 * 64 + 8 * hi;
        LAS unsigned char* stg = F.lds + 66560 + wid * 4608;
        bf16x8 ikn[4];
#pragma unroll
        for (int s = 0; s < 4; ++s) ikn[s] = *(const bf16x8*)(ikb + (size_t)(32 * kbq) * 64 + 16 * s);
#pragma unroll 1
        for (int g = 0; g < ng; ++g) { const int kr0 = 128 * g + 32 * kbq;
            if (kr0 > qrow0 + 31) break;
            asm volatile("" ::: "memory");
            bf16x8 ikf[4];
#pragma unroll
            for (int s = 0; s < 4; ++s) ikf[s] = ikn[s];
            { const int krn = kr0 + 128 <= KROWS - 32 ? kr0 + 128 : kr0;
#pragma unroll
              for (int s = 0; s < 4; ++s) ikn[s] = *(const bf16x8*)(ikb + (size_t)krn * 64 + 16 * s); }
            f32x16 score = (f32x16){};
#pragma unroll
            for (int h = 0; h < 8; ++h) { f32x16 acc = (f32x16){};
#pragma unroll
                for (int s = 0; s < 4; ++s) { const bf16x8 qf = *(const LAS bf16x8*)(iql + 128 * h + 32 * s); acc = MFMA32(ikf[s], qf, acc); }
#pragma unroll
                for (int r = 0; r < 16; ++r) score[r] += wv[h] * fmaxf(acc[r], 0.f);
                if (h & 1) __builtin_amdgcn_sched_barrier(0); }
#pragma unroll
            for (int g4 = 0; g4 < 4; ++g4) { u32x4 kv;
#pragma unroll
                for (int e = 0; e < 4; ++e) { unsigned bits = __float_as_uint(score[4 * g4 + e]); if (bits == 0x80000000u) bits = 0u; kv[e] = ((bits & 0x80000000u) ? ~bits : (bits | 0x80000000u)) >> 1; }
                *(LAS u32x4*)(stg + r32 * 144 + 32 * g4 + 16 * hi) = kv; }
            LDS_WAIT();
#pragma unroll
            for (int i = 0; i < 4; ++i) { const int row = 8 * i + (lane >> 3), ch = lane & 7; const u32x4 v = *(const LAS u32x4*)(stg + row * 144 + 16 * ch);
                *(u32x4*)(sc + (size_t)(32 * qi + row) * SCP + kr0 + 4 * ch) = v; }
            LDS_WAIT();
        }
    }
    VM_WAIT(); __syncthreads();
    if (!(abl & 8)) { const int ni = ((64 + q0 + 8 * wid + 7) >> 6) + 1;
      switch ((ni - 2) >> 2) {
        case 0: select8<5>(ws, sc, b, q0, wid, lane, abl); break;
        case 1: select8<9>(ws, sc, b, q0, wid, lane, abl); break;
        case 2: select8<13>(ws, sc, b, q0, wid, lane, abl); break;
        case 3: select8<17>(ws, sc, b, q0, wid, lane, abl); break;
        case 4: select8<21>(ws, sc, b, q0, wid, lane, abl); break;
        case 5: select8<25>(ws, sc, b, q0, wid, lane, abl); break;
        case 6: select8<29>(ws, sc, b, q0, wid, lane, abl); break;
        default: select8<33>(ws, sc, b, q0, wid, lane, abl); break;
      } }
    __syncthreads();
}

struct KvOrder : pg8::StaticOrder { __host__ __device__ int arow(int pm) const { return (pm >> 3) * KROWS + 64 + (pm & 7) * 256; } };
struct AblOrder : pg8::StaticOrder { int abl;
    __device__ bool next(int i, pg8::Unit& u) const { const bool r = pg8::StaticOrder::next(i, u); if (abl & 2) u.pm = 0; if (abl & 4) u.pn = 0; return r; } };
#ifndef PH
#define PH 0xFFFF
#endif
#ifndef DUP
#define DUP 0
#endif
#ifndef TIMING_KNOBS
#define TIMING_KNOBS 0
#endif
#if TIMING_KNOBS
#define PHASE(bit) _Pragma("unroll 1") for (int rep_ = 0, nrep_ = ((PH & (bit)) ? 1 + ((get_args()->dup & (bit)) ? 1 : 0) : 0); rep_ < nrep_; ++rep_)
#define ABL() ((nrep_ == 2 && rep_ == 0) ? (get_args()->dup >> 16) : 0)
#else
#define PHASE(bit) if (PH & (bit))
#define ABL() 0
#endif
#ifndef USE_XCD
#define USE_XCD 1
#endif
#if USE_XCD
#define GRID_SYNC() xcd_barrier(xbar)
#else
#define GRID_SYNC() grid.sync()
#endif
__global__ void __launch_bounds__(512, 2) fwd_megakernel(Args args_by_value) {
    extern __shared__ __attribute__((aligned(16))) unsigned char lds_raw[];
#if !USE_XCD
    cg::grid_group grid = cg::this_grid();
#endif
    LAS unsigned char* const lds0 = (LAS unsigned char*)lds_raw;
    const int wave_s = __builtin_amdgcn_readfirstlane((int)(threadIdx.x >> 6));
#if USE_XCD
    if (threadIdx.x < 4) ((LAS unsigned*)(lds0 + LDS_MISC))[threadIdx.x] = 0u;
    __syncthreads();
    XcdBarrier xbar = xcd_barrier_post((unsigned*)(get_args()->ws + WS_CTL), (volatile LAS unsigned*)(lds0 + LDS_MISC)); xbar.w = wave_s;
#endif
#define PHASE_VARS const Frame F = make_frame(lds0, wave_s); CArgsP a = get_args(); unsigned char* ws = a->ws; float* out = a->out; pg8::bf16_t* HB = (pg8::bf16_t*)(ws + WS_HB); pg8::bf16_t* ACT = (pg8::bf16_t*)(ws + WS_ACT); float* SSB = (float*)(ws + WS_SS); \
    PG8_LAS unsigned char* ring = (PG8_LAS unsigned char*)F.lds; (void)out; (void)HB; (void)ACT; (void)SSB; (void)ring
    PHASE(1) { PHASE_VARS; p0_prologue(F, a); }
    GRID_SYNC();
    PHASE(2) { PHASE_VARS; meta_p1(F, a);
      pg8::Gemm g{HB, (const pg8::bf16_t*)(ws + WS_WGU1), MX, NGU, DM}; AblOrder S; S.init(MX, NGU, F.G, (int)blockIdx.x); S.abl = ABL(); pg8::EpiGU E{(unsigned char*)ACT, SSB, ABL()};
      pg8::gemm_phase<pg8::EpiGU, AblOrder, true, true>(ring, g, S, E, wave_s); }
    GRID_SYNC();
    PHASE(4) { PHASE_VARS; meta_p2(F, a);
      pg8::Gemm g{ACT, (const pg8::bf16_t*)(ws + WS_WD1), MX, DM, FF / 2}; pg8::StaticOrder S; S.init(MX, DM, F.G, (int)blockIdx.x); pg8::EpiResB<false, true> E{HB, HB, nullptr, SSB, 0.5f / (ACT_SCALE * WD_SCALE)};
      pg8::gemm_phase<pg8::EpiResB<false, true>, pg8::StaticOrder, true, true, true>(ring, g, S, E, wave_s); }
    GRID_SYNC();
    PHASE(8) { PHASE_VARS; meta_p3(F, a);
      pg8::Gemm g{HB, (const pg8::bf16_t*)(ws + WS_WIN), MX, NINP, DM}; pg8::StaticOrder S; S.init(MX, NINP, F.G, (int)blockIdx.x);
      pg8::EpiIn E{(pg8::bf16_t*)(ws + WS_QA), (pg8::bf16_t*)(ws + WS_KA), (pg8::bf16_t*)(ws + WS_VA), (pg8::bf16_t*)(ws + WS_QB), (pg8::bf16_t*)(ws + WS_C), (pg8::bf16_t*)(ws + WS_IQ), (pg8::bf16_t*)(ws + WS_IK),
                   (float*)(ws + WS_IW), SSB, a->in[9], a->in[10], a->in[16], (PG8_LAS float*)(F.lds + LDS_XCH)};
      pg8::gemm_phase<pg8::EpiIn, pg8::StaticOrder, true, true>(ring, g, S, E, wave_s); }
    GRID_SYNC();
    PHASE(16) { PHASE_VARS; meta_p4(F, a);
      int kkv = 256; asm volatile("" : "+s"(kkv)); pg8::Gemm g{(const pg8::bf16_t*)(ws + WS_C), (const pg8::bf16_t*)(ws + WS_WKV), MX, 1024, kkv}; KvOrder S; S.init(MX, 1024, F.G, (int)blockIdx.x);
      pg8::EpiKV E{(pg8::bf16_t*)(ws + WS_KK), (pg8::bf16_t*)(ws + WS_VV)};
      pg8::gemm_phase<pg8::EpiKV, KvOrder, true, true>(ring, g, S, E, wave_s); }
    __syncthreads();
    PHASE(32) { _Pragma("unroll 1") for (int k = 0; k < 2; ++k) { const Frame F = make_frame(lds0, wave_s); CArgsP a = get_args(); const int b = F.vcu >> 4, s = F.vcu & 15; index_unit(F, a, b, k ? 31 - s : s, ABL()); } }
    PHASE(64) { float lam; { const int ln = pg8::lane_id(); CArgsP a = get_args(); const float d1 = wave_sum(a->in[11][ln] * a->in[12][ln]), d2 = wave_sum(a->in[13][ln] * a->in[14][ln]);
        lam = __uint_as_float((unsigned)__builtin_amdgcn_readfirstlane((int)__float_as_uint(__expf(d1) - __expf(d2) + LAM_INIT))); }
      _Pragma("unroll 1") for (int k = 0; k < 2; ++k) { const Frame F = make_frame(lds0, wave_s); CArgsP a = get_args(); const int bh = F.vcu >> 2, s = F.vcu & 3; attnA_unit(F, a, bh >> 2, bh & 3, k ? 7 - s : s, lam, ABL()); } }
    GRID_SYNC();
    PHASE(128) { _Pragma("unroll 1") for (int k = 0; k < 2; ++k) { const Frame F = make_frame(lds0, wave_s); CArgsP a = get_args(); const int bh = F.vcu >> 2, s = F.vcu & 3; attnB_unit(F, a, bh >> 2, bh & 3, k ? 7 - s : s, ABL()); } }
    GRID_SYNC();
    PHASE(256) { PHASE_VARS; pg8::Gemm g{(const pg8::bf16_t*)out, (const pg8::bf16_t*)(ws + WS_WOUT), MX, DM, DM}; pg8::StaticOrder S; S.init(MX, DM, F.G, (int)blockIdx.x); pg8::EpiResB<false, true> E{HB, (pg8::bf16_t*)(ws + WS_H2B), nullptr, SSB, 1.0f};
      pg8::gemm_phase<pg8::EpiResB<false, true>, pg8::StaticOrder, true, true>(ring, g, S, E, wave_s); }
    GRID_SYNC();
    PHASE(512) { PHASE_VARS; pg8::Gemm g{(const pg8::bf16_t*)(ws + WS_H2B), (const pg8::bf16_t*)(ws + WS_WGU2), MX, NGU, DM}; pg8::StaticOrder S; S.init(MX, NGU, F.G, (int)blockIdx.x); pg8::EpiGU E{(unsigned char*)ACT, SSB, ABL()};
      pg8::gemm_phase<pg8::EpiGU, pg8::StaticOrder, true, true>(ring, g, S, E, wave_s); }
    GRID_SYNC();
    PHASE(1024) { PHASE_VARS; pg8::Gemm g{ACT, (const pg8::bf16_t*)(ws + WS_WD2), MX, DM, FF / 2}; pg8::StaticOrder S; S.init(MX, DM, F.G, (int)blockIdx.x); pg8::EpiResB<true, false> E{(const pg8::bf16_t*)(ws + WS_H2B), nullptr, out, nullptr, 0.5f / (ACT_SCALE * WD_SCALE)};
      pg8::gemm_phase<pg8::EpiResB<true, false>, pg8::StaticOrder, true, true, true>(ring, g, S, E, wave_s); }
}

extern "C" void kernel_launch(void* const* d_in, const int* in_sizes, int n_in, void* d_out, int out_size, void* d_ws, size_t ws_size, hipStream_t stream) {
    static int grid = 0;
    if (grid == 0) {
        if (n_in != 25 || out_size != MX * DM || ws_size < WS_END) { fprintf(stderr, "kernel_launch: unexpected shapes (n_in %d out %d ws %zu)\n", n_in, out_size, ws_size); grid = -1; return; }
        int dev = 0, cus = 0, per_cu = 0;
        if (hipGetDevice(&dev) != hipSuccess || hipDeviceGetAttribute(&cus, hipDeviceAttributeMultiprocessorCount, dev) != hipSuccess) { grid = -1; return; }
        if (hipFuncSetAttribute((const void*)fwd_megakernel, hipFuncAttributeMaxDynamicSharedMemorySize, LDS_BYTES) != hipSuccess) { fprintf(stderr, "kernel_launch: hipFuncSetAttribute failed\n"); grid = -1; return; }
        if (hipOccupancyMaxActiveBlocksPerMultiprocessor(&per_cu, (const void*)fwd_megakernel, 512, LDS_BYTES) != hipSuccess || per_cu < 1) { fprintf(stderr, "kernel_launch: occupancy query says %d blocks per CU\n", per_cu); (void)hipGetLastError(); grid = -1; return; }
        grid = cus;
        if (grid != 256) fprintf(stderr, "kernel_launch: note: %d CUs\n", grid);
    }
    if (grid < 0) return;
    (void)hipMemsetAsync((char*)d_ws + WS_CTL, 0, 16384, stream);
    Args a{};
    for (int i = 0; i < 25; ++i) a.in[i] = (const float*)d_in[i];
    a.out = (float*)d_out; a.ws = (unsigned char*)d_ws; a.dup = DUP; a.pad = 0;
    void* args[] = {&a};
#ifndef PLAIN_LAUNCH
#define PLAIN_LAUNCH 0
#endif
#if PLAIN_LAUNCH
    (void)args; hipLaunchKernelGGL(fwd_megakernel, dim3(grid), dim3(512), LDS_BYTES, stream, a); hipError_t e = hipPeekAtLastError();
#else
    hipError_t e = hipLaunchCooperativeKernel((const void*)fwd_megakernel, dim3(grid), dim3(512), args, LDS_BYTES, stream);
#endif
    if (e != hipSuccess) fprintf(stderr, "kernel_launch: cooperative launch failed: %s\n", hipGetErrorString(e));
}
```

```cpp
#include <hip/hip_runtime.h>
#include <hip/hip_cooperative_groups.h>
#include <cstdio>
#include <cstdint>
namespace cg = cooperative_groups;

#define LAS __attribute__((address_space(3)))
typedef unsigned short bf16;
typedef short bf16x8 __attribute__((ext_vector_type(8)));
typedef short s16x4 __attribute__((ext_vector_type(4)));
typedef float f32x4 __attribute__((ext_vector_type(4)));
typedef float f32x16 __attribute__((ext_vector_type(16)));
typedef unsigned u32x4 __attribute__((ext_vector_type(4)));
typedef unsigned u32x2 __attribute__((ext_vector_type(2)));
typedef float f32x2_t __attribute__((ext_vector_type(2)));
typedef __bf16 bf16x2_t __attribute__((ext_vector_type(2)));

constexpr int DM = 1024, NB = 16, SEQ = 2048, MX = NB * SEQ, FF = 2816, NGU = 2 * FF, NINP = 3072, NIN = 2888;
#ifndef F8_D1
#define F8_D1 0
#endif
#ifndef F8_D2
#define F8_D2 1
#endif
#ifndef F8_G2
#define F8_G2 1
#endif
constexpr float H_SCALE = 16.0f, GU_SCALE = 1024.0f;
constexpr float ACT_SCALE = 8.0f, WD_SCALE = 2048.0f;
constexpr int KROWS = 2112, MK = NB * KROWS;
constexpr int SELW = 68;
constexpr int SCP = 2112;
constexpr float EPS = 1e-6f, LOG2E = 1.4426950408889634f;
constexpr float A_QSCALE = 0.125f * LOG2E;
constexpr float B_QSCALE = 0.0625f * LOG2E;
constexpr float IW_SCALE = 0.35355339059327373f * 0.125f;
constexpr float SUBLN_SCALE = 0.8f;
constexpr float LAM_INIT = 0.2f;

constexpr size_t MiB = 1u << 20;
constexpr size_t WS_CTL = 0, CTL_BYTES = 1 * MiB;
constexpr size_t WS_WGU1 = 1 * MiB, WS_WD1 = 12 * MiB, WS_WIN = WS_WD1 + (size_t)DM * FF * 2, WS_WKV = WS_WIN + (size_t)NINP * DM * 2, WS_WUKT = WS_WKV + 512 * 1024,
                 WS_WOUT = WS_WUKT + 256 * 1024, WS_WGU2 = WS_WOUT + 2 * MiB, WS_WD2 = WS_WGU2 + 11 * MiB;
constexpr size_t WS_SS = 43 * MiB, WS_IW = 45 * MiB, WS_META = 46 * MiB, WS_SCR = 48 * MiB, WS_HB = 180 * MiB, WS_ACT = 244 * MiB;
constexpr size_t WS_QA = WS_ACT, WS_QB = WS_QA + 32 * MiB, WS_IQ = WS_QB + 32 * MiB, WS_KA = WS_IQ + 32 * MiB, WS_VA = WS_KA + 33 * MiB, WS_SEL = WS_VA + 33 * MiB;
constexpr size_t WS_C = 420 * MiB, WS_IK = WS_C + (size_t)MK * 256 * 2, WS_KK = 441 * MiB, WS_VV = 474 * MiB, WS_H2B = 420 * MiB, WS_H2Q = WS_SCR  , WS_END = 512 * MiB;
static_assert(WS_WD2 + (size_t)DM * FF * 2 <= WS_SS, "weights");
static_assert(WS_SCR + (size_t)256 * 64 * SCP * 4 <= WS_HB, "scratch");
static_assert(WS_SEL + (size_t)MX * SELW * 4 <= WS_C && WS_IK + (size_t)MK * 64 * 2 <= WS_KK && WS_VV + (size_t)MK * 512 * 2 <= WS_END, "map");
constexpr size_t MO_HBM = 0, MO_SSM0 = 32 * 1024, MO_ACTM = 36 * 1024, MO_H1MB = 128 * 1024, MO_SSM1 = 160 * 1024;

constexpr int LDS_BYTES = 155648;
constexpr int LDS_XCH = 131072;
constexpr int LDS_LUT = 66560;
constexpr int LDS_MISC = 150 * 1024;

static_assert(LDS_LUT + 512 <= 67072 && 67072 + 64 * 1040 <= LDS_MISC && 8 * 32 * 272 <= LDS_MISC && LDS_XCH + 4096 <= LDS_MISC && LDS_MISC + 64 <= LDS_BYTES && LDS_BYTES <= 160 * 1024, "LDS map");
#define LDS_WAIT() asm volatile("s_waitcnt lgkmcnt(0)" ::: "memory")
#define VM_WAIT() asm volatile("s_waitcnt vmcnt(0)" ::: "memory")
__device__ __forceinline__ unsigned pk2(float lo, float hi) { f32x2_t v = {lo, hi}; bf16x2_t b = __builtin_convertvector(v, bf16x2_t); return __builtin_bit_cast(unsigned, b); }
__device__ __forceinline__ float wave_sum(float v) {
#pragma unroll
    for (int o = 1; o < 64; o <<= 1) v += __shfl_xor(v, o);
    return v;
}
__device__ __forceinline__ float rsqrt_acc(float x) { return 1.0f / sqrtf(x); }
__device__ __forceinline__ int crow(int r, int hi) { return (r & 3) + 8 * (r >> 2) + 4 * hi; }
#define MFMA32(a, b, c) __builtin_amdgcn_mfma_f32_32x32x16_bf16((a), (b), (c), 0, 0, 0)
#define MFMA16(a, b, c) __builtin_amdgcn_mfma_f32_16x16x32_bf16((a), (b), (c), 0, 0, 0)
namespace pg8 {
#define PG8_LAS __attribute__((address_space(3)))
typedef unsigned short bf16_t;
typedef short bf16x8 __attribute__((ext_vector_type(8)));
typedef float f32x4 __attribute__((ext_vector_type(4)));
typedef unsigned u32x4 __attribute__((ext_vector_type(4)));
typedef int i32x8 __attribute__((ext_vector_type(8)));
__device__ __forceinline__ i32x8 cat8(bf16x8 a, bf16x8 b) { typedef short s16 __attribute__((ext_vector_type(16))); return __builtin_bit_cast(i32x8, __builtin_shufflevector(a, b, 0, 1, 2, 3, 4, 5, 6, 7, 8, 9, 10, 11, 12, 13, 14, 15)); }
constexpr int BM = 256, BK = 64, HALF = 128, HTB = HALF * BK * 2  , STAGE_BYTES = 8 * HTB, NXCD = 8, WGM = 8;

__host__ __device__ __forceinline__ int lds_byte(int r, int c) { const int st = (r >> 4) * 2 + (c >> 5), rr = r & 15, cc = c & 31, ob = rr * 64 + cc * 2; return st * 1024 + (ob ^ (((ob >> 9) & 1) << 5)); }
__host__ __device__ __forceinline__ void stage_rc(int b, int& R, int& C) { const int st = b / 1024, sb = b % 1024, swz = sb ^ (((sb >> 9) & 1) << 5); R = (st >> 1) * 16 + swz / 64; C = (st & 1) * 32 + (swz % 64) / 2; }
__host__ __device__ __forceinline__ int perm32(int rho) { const int n = rho >> 4, i = rho & 15; return 8 * (i >> 2) + 4 * n + (i & 3); }

__device__ __forceinline__ void mfma8(f32x4& c, const i32x8 a, const i32x8 b, int sc) {
    asm volatile("v_mfma_scale_f32_16x16x128_f8f6f4 %0, %1, %2, %0, %3, %3 op_sel_hi:[0,0,0]" : "+v"(c) : "v"(a), "v"(b), "v"(sc)); }
__device__ __forceinline__ int lane_id() { int l; asm volatile("v_mbcnt_lo_u32_b32 %0, -1, 0\n\tv_mbcnt_hi_u32_b32 %0, -1, %0" : "=v"(l)); return l; }
struct Unit { int pm, pn; };
struct Gemm { const bf16_t* A; const bf16_t* Bt; int M, N, K; };

struct StaticOrder {
    int nM, nN, nwg, G, c;
    __host__ __device__ void init(int M, int N, int G_, int c_) { nM = M / BM; nN = N / BM; nwg = nM * nN; G = G_; c = c_; }
    __host__ __device__ bool next(int i, Unit& u) const {
        const long L = (long)i * G + c; if (L >= nwg) return false;
        int wgid = (int)L; { const int q = nwg / NXCD, r = nwg % NXCD, xcd = wgid % NXCD, off = wgid / NXCD; wgid = (xcd < r ? xcd * (q + 1) : r * (q + 1) + (xcd - r) * q) + off; }
        const int nig = WGM * nN, gid = wgid / nig, fm = gid * WGM, gsz = (nM - fm) < WGM ? (nM - fm) : WGM;
        u.pm = fm + ((wgid % nig) % gsz); u.pn = (wgid % nig) / gsz; return true;
    }
    __host__ __device__ int arow(int pm) const { return pm * BM; }
    __device__ __forceinline__ void a_ready(const Unit&) const {}
    __device__ __forceinline__ void done(const Unit&) const {}
};
__device__ __forceinline__ unsigned cvt_pk_bf16(float lo, float hi) { unsigned r; asm volatile("v_cvt_pk_bf16_f32 %0, %1, %2" : "=v"(r) : "v"(lo), "v"(hi)); return r; }
template <class Epi, class Sched, bool ALIGN_EPI = false, bool SP2 = false, bool F8 = false>
__device__ __forceinline__ void gemm_phase(PG8_LAS unsigned char* lds, const Gemm g, const Sched& S, const Epi& E, int wave_s) {
    int tid_ = wave_s * 64 + lane_id(); asm volatile("" : "+v"(tid_));
    const int tid = tid_, wid = __builtin_amdgcn_readfirstlane(tid >> 6), lane = tid & 63, wr = wid >> 2, wc = wid & 3, fr = lane & 15, fq = lane >> 4;
    const int K = g.K, nt = K / BK;
    unsigned voffA[2], voffB[2];
#pragma unroll
    for (int i = 0; i < 2; ++i) { int R, C; stage_rc(tid * 16 + i * 8192, R, C); const int Rb = Epi::PERM ? ((R & ~31) + perm32(R & 31)) : R;
        voffA[i] = (unsigned)(R * K + C) * 2u; voffB[i] = (unsigned)(Rb * K + C) * 2u; }
    const size_t kstep = (size_t)(BK * 2);
    const size_t hstep = (size_t)HALF * K * 2;
    const size_t tstep = 2 * hstep;
    const unsigned ldsw = (unsigned)wid * 1024u;
    const int aoff = lds_byte(wr * 64 + fr, fq * 8), boff = lds_byte(wc * 32 + fr, fq * 8);
#define PG8_SA(b, h) (((b) * 2 + (h)) * HTB)
#define PG8_SB(b, h) ((4 + (b) * 2 + (h)) * HTB)
#define PG8_STAGE(bufoff, gbase, voff) do { _Pragma("unroll") for (int _i = 0; _i < 2; ++_i) \
        __builtin_amdgcn_global_load_lds((const unsigned*)((const char*)(gbase) + (voff)[_i]), (PG8_LAS unsigned*)(lds + (bufoff) + ldsw + _i * 8192), 16, 0, 0); } while (0)
#define PG8_LDA(dst, b, h) do { _Pragma("unroll") for (int m = 0; m < 4; ++m) _Pragma("unroll") for (int k = 0; k < 2; ++k) dst[m][k] = *(const PG8_LAS bf16x8*)(lds + PG8_SA(b, h) + aoff + m * 2048 + k * 1024); } while (0)
#define PG8_LDB(dst, b, h) do { _Pragma("unroll") for (int n = 0; n < 2; ++n) _Pragma("unroll") for (int k = 0; k < 2; ++k) dst[n][k] = *(const PG8_LAS bf16x8*)(lds + PG8_SB(b, h) + boff + n * 2048 + k * 1024); } while (0)
#define PG8_MMA(ai, bj, At, Bt) do { __builtin_amdgcn_s_setprio(1); _Pragma("unroll") for (int m = 0; m < 4; ++m) _Pragma("unroll") for (int n = 0; n < 2; ++n) { \
        if constexpr (F8) mfma8(acc[ai][bj][m][n], cat8(Bt[n][0], Bt[n][1]), cat8(At[m][0], At[m][1]), one8); \
        else { _Pragma("unroll") for (int k = 0; k < 2; ++k) acc[ai][bj][m][n] = __builtin_amdgcn_mfma_f32_16x16x32_bf16(Bt[n][k], At[m][k], acc[ai][bj][m][n], 0, 0, 0); } } __builtin_amdgcn_s_setprio(0); } while (0)
#define PG8_WAIT_V(n) asm volatile("s_waitcnt vmcnt(" #n ")" ::: "memory")
#define PG8_WAIT_L(n) asm volatile("s_waitcnt lgkmcnt(" #n ")" ::: "memory")
#define PG8_BAR __builtin_amdgcn_s_barrier()
#define PG8_SCHED __builtin_amdgcn_sched_barrier(0)
    Unit cur, nxt; int ui = 0;
    if (!S.next(0, cur)) return;
    int one8 = 0x7F7F7F7F; asm volatile("" : "+v"(one8));
    f32x4 acc[2][2][4][2];
#pragma unroll
    for (int a = 0; a < 2; ++a)
#pragma unroll
        for (int b = 0; b < 2; ++b)
#pragma unroll
            for (int m = 0; m < 4; ++m)
#pragma unroll
                for (int n = 0; n < 2; ++n) acc[a][b][m][n] = (f32x4){0.f, 0.f, 0.f, 0.f};
    bf16x8 At[4][2], B0[2][2], B1[2][2];
    const char* cA = (const char*)g.A + (size_t)S.arow(cur.pm) * K * 2; const char* cB = (const char*)g.Bt + (size_t)cur.pn * tstep;
    S.a_ready(cur);
    if constexpr (SP2) {
        PG8_STAGE(PG8_SB(0, 0), cB, voffB); PG8_STAGE(PG8_SB(0, 1), cB + hstep, voffB); PG8_STAGE(PG8_SA(0, 0), cA, voffA); PG8_STAGE(PG8_SA(0, 1), cA + hstep, voffA);
        if (wr == 1) PG8_BAR;
        PG8_WAIT_V(2); PG8_BAR;
        PG8_STAGE(PG8_SB(1, 0), cB + kstep, voffB); PG8_STAGE(PG8_SA(1, 0), cA + kstep, voffA); PG8_STAGE(PG8_SB(1, 1), cB + hstep + kstep, voffB);
        PG8_WAIT_V(6); PG8_BAR;
    } else {
        PG8_STAGE(PG8_SB(0, 0), cB, voffB); PG8_STAGE(PG8_SA(0, 0), cA, voffA); PG8_STAGE(PG8_SB(0, 1), cB + hstep, voffB); PG8_STAGE(PG8_SA(0, 1), cA + hstep, voffA);
        if (wr == 1) PG8_BAR;
        PG8_WAIT_V(4); PG8_BAR;
        PG8_STAGE(PG8_SB(1, 0), cB + kstep, voffB); PG8_STAGE(PG8_SA(1, 0), cA + kstep, voffA); PG8_STAGE(PG8_SB(1, 1), cB + hstep + kstep, voffB);
        PG8_WAIT_V(6); PG8_BAR;
    }
    for (;;) {
        const bool has_next = S.next(ui + 1, nxt);
        const char* nA = has_next ? (const char*)g.A + (size_t)S.arow(nxt.pm) * K * 2 : cA; const char* nB = has_next ? (const char*)g.Bt + (size_t)nxt.pn * tstep : cB;
        for (int t = 0; t < nt; t += 2) {
            const bool last = (t == nt - 2);
            const char* a1 = cA + (size_t)(t + 1) * kstep;
            const char* a2 = last ? nA : cA + (size_t)(t + 2) * kstep; const char* b2 = last ? nB : cB + (size_t)(t + 2) * kstep;
            const char* a3 = a2 + kstep; const char* b3 = b2 + kstep;
            if (last && has_next) S.a_ready(nxt);
            if constexpr (SP2) {
            PG8_LDB(B0, 0, 0); PG8_LDB(B1, 0, 1); PG8_SCHED; PG8_LDA(At, 0, 0); PG8_STAGE(PG8_SA(1, 1), a1 + hstep, voffA);
            PG8_WAIT_V(8); PG8_WAIT_L(0); PG8_BAR; PG8_MMA(0, 0, At, B0); PG8_MMA(0, 1, At, B1); PG8_BAR; PG8_SCHED;
            PG8_LDA(At, 0, 1); PG8_STAGE(PG8_SB(0, 0), b2, voffB); PG8_STAGE(PG8_SB(0, 1), b2 + hstep, voffB); PG8_STAGE(PG8_SA(0, 0), a2, voffA);
            PG8_WAIT_V(8); PG8_WAIT_L(0); PG8_BAR; PG8_MMA(1, 0, At, B0); PG8_MMA(1, 1, At, B1); PG8_BAR; PG8_SCHED;
            PG8_LDB(B0, 1, 0); PG8_LDB(B1, 1, 1); PG8_SCHED; PG8_LDA(At, 1, 0); PG8_STAGE(PG8_SA(0, 1), a2 + hstep, voffA);
            PG8_WAIT_V(8); PG8_WAIT_L(0); PG8_BAR; PG8_MMA(0, 0, At, B0); PG8_MMA(0, 1, At, B1); PG8_BAR; PG8_SCHED;
            PG8_LDA(At, 1, 1); PG8_STAGE(PG8_SB(1, 0), b3, voffB); PG8_STAGE(PG8_SB(1, 1), b3 + hstep, voffB); PG8_STAGE(PG8_SA(1, 0), a3, voffA);
            PG8_WAIT_V(8); PG8_WAIT_L(0); PG8_BAR; PG8_MMA(1, 0, At, B0); PG8_MMA(1, 1, At, B1); PG8_BAR; PG8_SCHED;
            } else {
            PG8_LDB(B0, 0, 0); PG8_SCHED; PG8_LDA(At, 0, 0); PG8_STAGE(PG8_SA(1, 1), a1 + hstep, voffA);
            PG8_WAIT_L(8); PG8_BAR; PG8_WAIT_L(0); PG8_MMA(0, 0, At, B0); PG8_BAR; PG8_SCHED;
            PG8_LDB(B1, 0, 1); PG8_STAGE(PG8_SB(0, 0), b2, voffB);
            PG8_BAR; PG8_WAIT_L(0); PG8_MMA(0, 1, At, B1); PG8_BAR;
            PG8_LDA(At, 0, 1); PG8_STAGE(PG8_SA(0, 0), a2, voffA);
            PG8_BAR; PG8_WAIT_L(0); PG8_MMA(1, 0, At, B0); PG8_BAR; PG8_SCHED;
            PG8_STAGE(PG8_SB(0, 1), b2 + hstep, voffB);
            PG8_WAIT_V(6); PG8_BAR; PG8_MMA(1, 1, At, B1); PG8_BAR;
            PG8_LDB(B0, 1, 0); PG8_SCHED; PG8_LDA(At, 1, 0); PG8_STAGE(PG8_SA(0, 1), a2 + hstep, voffA);
            PG8_WAIT_L(8); PG8_BAR; PG8_WAIT_L(0); PG8_MMA(0, 0, At, B0); PG8_BAR; PG8_SCHED;
            PG8_LDB(B1, 1, 1); PG8_STAGE(PG8_SB(1, 0), b3, voffB);
            PG8_BAR; PG8_WAIT_L(0); PG8_MMA(0, 1, At, B1); PG8_BAR;
            PG8_LDA(At, 1, 1); PG8_STAGE(PG8_SA(1, 0), a3, voffA);
            PG8_BAR; PG8_WAIT_L(0); PG8_MMA(1, 0, At, B0); PG8_BAR; PG8_SCHED;
            PG8_STAGE(PG8_SB(1, 1), b3 + hstep, voffB);
            PG8_WAIT_V(6); PG8_BAR; PG8_MMA(1, 1, At, B1); PG8_BAR;
            }
        }
        if constexpr (ALIGN_EPI) { if (wr == 0) PG8_BAR; }
        if constexpr (F8) asm volatile("s_nop 15\n\ts_nop 15" ::: "memory");
        if constexpr (!Epi::AFTER_DRAIN) { E(acc, cur, wr, wc, fr, fq); S.done(cur); }
        if (!has_next) break;
#pragma unroll
        for (int a = 0; a < 2; ++a)
#pragma unroll
            for (int b = 0; b < 2; ++b)
#pragma unroll
                for (int m = 0; m < 4; ++m)
#pragma unroll
                    for (int n = 0; n < 2; ++n) acc[a][b][m][n] = (f32x4){0.f, 0.f, 0.f, 0.f};
        cur = nxt; cA = nA; cB = nB; ++ui;
        if constexpr (ALIGN_EPI) { if (wr == 1) PG8_BAR; }
    }
    PG8_WAIT_V(0);
    if constexpr (!ALIGN_EPI) { if (wr == 0) PG8_BAR; }
    PG8_BAR;
    if constexpr (Epi::AFTER_DRAIN) { E.fused(acc, cur, wr, wc, fr, fq, lds, wid, lane); S.done(cur); }
#undef PG8_SA
#undef PG8_SB
#undef PG8_STAGE
#undef PG8_LDA
#undef PG8_LDB
#undef PG8_MMA
#undef PG8_WAIT_V
#undef PG8_WAIT_L
#undef PG8_BAR
#undef PG8_SCHED
}
__device__ __forceinline__ float rstd_slots(const float* ss, int row, int fq) {
    const f32x4 v = *(const f32x4*)(ss + (size_t)row * 16 + 4 * fq);
    float s = (v[0] + v[1]) + (v[2] + v[3]);
    s += __shfl_xor(s, 16); s += __shfl_xor(s, 32);
    return 1.0f / sqrtf(s * (1.0f / 1024.0f) + 1e-6f);
}
__device__ __forceinline__ f32x4 slots_load(const float* ss, int row, int fq) { return *(const f32x4*)(ss + (size_t)row * 16 + 4 * fq); }
__device__ __forceinline__ float slots_rstd(const f32x4 v) { float s = (v[0] + v[1]) + (v[2] + v[3]); s += __shfl_xor(s, 16); s += __shfl_xor(s, 32); return 1.0f / sqrtf(s * (1.0f / 1024.0f) + 1e-6f); }
__device__ __forceinline__ float silu_mul(float g, float u) { return g * __builtin_amdgcn_rcpf(1.0f + __builtin_amdgcn_exp2f(-1.4426950408889634f * g)) * u; }
__device__ __forceinline__ unsigned pk8(float a, float b, float c, float d) {
    a = __builtin_amdgcn_fmed3f(a, -448.f, 448.f); b = __builtin_amdgcn_fmed3f(b, -448.f, 448.f); c = __builtin_amdgcn_fmed3f(c, -448.f, 448.f); d = __builtin_amdgcn_fmed3f(d, -448.f, 448.f);
    const int p = __builtin_amdgcn_cvt_pk_fp8_f32(a, b, 0, false); return (unsigned)__builtin_amdgcn_cvt_pk_fp8_f32(c, d, p, true); }
__device__ __forceinline__ unsigned pkbf(float lo, float hi) { typedef float v2f __attribute__((ext_vector_type(2))); typedef __bf16 v2b __attribute__((ext_vector_type(2))); v2f v = {lo, hi}; v2b b = __builtin_convertvector(v, v2b); return __builtin_bit_cast(unsigned, b); }

template <bool F8> struct EpiGU {
    static constexpr bool PERM = true, AFTER_DRAIN = false;
    unsigned char* act; const float* ss; int abl; float pre;
    __device__ __forceinline__ void operator()(const f32x4 (&acc)[2][2][4][2], const Unit& u, int wr, int wc, int fr, int fq) const {
        if (abl & 1) return;
        const int row0 = u.pm * BM + wr * 64 + fr, col0 = u.pn * 128 + wc * 32 + 8 * fq;
        f32x4 sv[2][4];
#pragma unroll
        for (int ai = 0; ai < 2; ++ai)
#pragma unroll
            for (int m = 0; m < 4; ++m) sv[ai][m] = slots_load(ss, row0 + ai * HALF + m * 16, fq);
#pragma unroll
        for (int ai = 0; ai < 2; ++ai)
#pragma unroll
            for (int m = 0; m < 4; ++m) { const int row = row0 + ai * HALF + m * 16; const float rs = slots_rstd(sv[ai][m]) * pre, ru = F8 ? rs * ACT_SCALE : rs;
                const f32x4 g0 = acc[ai][0][m][0] * rs, g1 = acc[ai][0][m][1] * rs, u0 = acc[ai][1][m][0] * ru, u1 = acc[ai][1][m][1] * ru;
                if constexpr (F8) { typedef unsigned u32x2v __attribute__((ext_vector_type(2))); u32x2v w;
                    w.x = pk8(silu_mul(g0[0], u0[0]), silu_mul(g0[1], u0[1]), silu_mul(g0[2], u0[2]), silu_mul(g0[3], u0[3]));
                    w.y = pk8(silu_mul(g1[0], u1[0]), silu_mul(g1[1], u1[1]), silu_mul(g1[2], u1[2]), silu_mul(g1[3], u1[3]));
                    *(u32x2v*)(act + (size_t)row * 2816 + col0) = w; }
                else { u32x4 w; w.x = pkbf(silu_mul(g0[0], u0[0]), silu_mul(g0[1], u0[1])); w.y = pkbf(silu_mul(g0[2], u0[2]), silu_mul(g0[3], u0[3]));
                    w.z = pkbf(silu_mul(g1[0], u1[0]), silu_mul(g1[1], u1[1])); w.w = pkbf(silu_mul(g1[2], u1[2]), silu_mul(g1[3], u1[3]));
                    *(u32x4*)((bf16_t*)act + (size_t)row * 2816 + col0) = w; } }
    }
};
template <bool HB, bool SS> struct EpiRes {
    static constexpr bool PERM = false, AFTER_DRAIN = false;
    const float* res; float* out; bf16_t* hb; float* ss; float alpha;
    __device__ __forceinline__ void operator()(const f32x4 (&acc)[2][2][4][2], const Unit& u, int wr, int wc, int fr, int fq) const {
        const int row0 = u.pm * BM + wr * 64 + fr, col0 = u.pn * BM + wc * 32 + 4 * fq;
#pragma unroll
        for (int ai = 0; ai < 2; ++ai)
#pragma unroll
            for (int m = 0; m < 4; ++m) { const int row = row0 + ai * HALF + m * 16; const size_t off = (size_t)row * 1024 + col0; float sq = 0.f;
#pragma unroll
                for (int bj = 0; bj < 2; ++bj)
#pragma unroll
                    for (int n = 0; n < 2; ++n) { const f32x4 r4 = *(const f32x4*)(res + off + bj * HALF + n * 16); const f32x4 v = r4 + acc[ai][bj][m][n] * alpha;
                        *(f32x4*)(out + off + bj * HALF + n * 16) = v;
                        if (HB) { typedef unsigned u32x2v __attribute__((ext_vector_type(2))); u32x2v w; w.x = pkbf(v[0], v[1]); w.y = pkbf(v[2], v[3]); *(u32x2v*)(hb + off + bj * HALF + n * 16) = w; }
                        if (SS) sq += (v[0] * v[0] + v[1] * v[1]) + (v[2] * v[2] + v[3] * v[3]); }
                if (SS) { sq += __shfl_xor(sq, 16); sq += __shfl_xor(sq, 32); if (fq == 0) ss[(size_t)row * 16 + u.pn * 4 + wc] = sq; }
                if (m == 3) asm volatile("" ::: "memory"); }
    }
};
template <bool OUTF32, bool SS, bool Q8 = false> struct EpiResB {
    static constexpr bool PERM = true, AFTER_DRAIN = false;
    const bf16_t* res; bf16_t* outb; float* outf; float* ss; float alpha;
    __device__ __forceinline__ void operator()(const f32x4 (&acc)[2][2][4][2], const Unit& u, int wr, int wc, int fr, int fq) const {
        const int row0 = u.pm * BM + wr * 64 + fr, col0 = u.pn * BM + wc * 32 + 8 * fq;
        u32x4 rv[2][4][2];
#pragma unroll
        for (int ai = 0; ai < 2; ++ai)
#pragma unroll
            for (int m = 0; m < 4; ++m)
#pragma unroll
                for (int bj = 0; bj < 2; ++bj) rv[ai][m][bj] = *(const u32x4*)(res + (size_t)(row0 + ai * HALF + m * 16) * 1024 + col0 + bj * HALF);
#pragma unroll
        for (int ai = 0; ai < 2; ++ai)
#pragma unroll
            for (int m = 0; m < 4; ++m) { const int row = row0 + ai * HALF + m * 16; const size_t off = (size_t)row * 1024 + col0; float sq = 0.f;
#pragma unroll
                for (int bj = 0; bj < 2; ++bj) { const u32x4 r = rv[ai][m][bj];
                    f32x4 v0, v1;
                    v0[0] = __uint_as_float(r.x << 16); v0[1] = __uint_as_float(r.x & 0xffff0000u); v0[2] = __uint_as_float(r.y << 16); v0[3] = __uint_as_float(r.y & 0xffff0000u);
                    v1[0] = __uint_as_float(r.z << 16); v1[1] = __uint_as_float(r.z & 0xffff0000u); v1[2] = __uint_as_float(r.w << 16); v1[3] = __uint_as_float(r.w & 0xffff0000u);
                    v0 = v0 + acc[ai][bj][m][0] * alpha; v1 = v1 + acc[ai][bj][m][1] * alpha;
                    if (OUTF32) { *(f32x4*)(outf + off + bj * HALF) = v0; *(f32x4*)(outf + off + bj * HALF + 4) = v1; }
                    else { u32x4 w; w.x = pkbf(v0[0], v0[1]); w.y = pkbf(v0[2], v0[3]); w.z = pkbf(v1[0], v1[1]); w.w = pkbf(v1[2], v1[3]); *(u32x4*)(outb + off + bj * HALF) = w; }
                    if constexpr (Q8) { typedef unsigned u32x2v __attribute__((ext_vector_type(2))); u32x2v w8; w8.x = pk8(v0[0] * H_SCALE, v0[1] * H_SCALE, v0[2] * H_SCALE, v0[3] * H_SCALE); w8.y = pk8(v1[0] * H_SCALE, v1[1] * H_SCALE, v1[2] * H_SCALE, v1[3] * H_SCALE);
                        *(u32x2v*)((unsigned char*)outb - (WS_H2B - WS_H2Q) + off + bj * HALF) = w8; }
                    if (SS) sq += ((v0[0] * v0[0] + v0[1] * v0[1]) + (v0[2] * v0[2] + v0[3] * v0[3])) + ((v1[0] * v1[0] + v1[1] * v1[1]) + (v1[2] * v1[2] + v1[3] * v1[3])); }
                if (SS) { sq += __shfl_xor(sq, 16); sq += __shfl_xor(sq, 32); if (fq == 0) ss[(size_t)row * 16 + u.pn * 4 + wc] = sq; } }
    }
};
struct EpiIn {
    static constexpr bool PERM = true, AFTER_DRAIN = false;
    bf16_t *qa, *ka, *va, *qb, *cc, *iq, *ik; float* iw; const float* ss; const float *g_aq, *g_ak, *g_kv; PG8_LAS float* xch;
    __device__ __forceinline__ void operator()(const f32x4 (&acc)[2][2][4][2], const Unit& u, int wr, int wc, int fr, int fq) const {
        const int row0 = u.pm * BM + wr * 64 + fr, pn = u.pn, lc0 = 64 * wc + 8 * fq;
        if (pn == 8) {
            float rsv[2][4]; f32x4 sv[2][4];
#pragma unroll
            for (int ai = 0; ai < 2; ++ai)
#pragma unroll
                for (int m = 0; m < 4; ++m) sv[ai][m] = slots_load(ss, row0 + ai * HALF + m * 16, fq);
#pragma unroll
            for (int ai = 0; ai < 2; ++ai)
#pragma unroll
                for (int m = 0; m < 4; ++m) { const float rs = slots_rstd(sv[ai][m]); rsv[ai][m] = rs; float sq = 0.f;
#pragma unroll
                    for (int bj = 0; bj < 2; ++bj)
#pragma unroll
                        for (int n = 0; n < 2; ++n) { const f32x4 v = acc[ai][bj][m][n] * rs; sq += (v[0] * v[0] + v[1] * v[1]) + (v[2] * v[2] + v[3] * v[3]); }
                    sq += __shfl_xor(sq, 16); sq += __shfl_xor(sq, 32);
                    if (fq == 0) xch[(ai * HALF + wr * 64 + m * 16 + fr) * 4 + wc] = sq; }
            asm volatile("s_waitcnt lgkmcnt(0)" ::: "memory"); __builtin_amdgcn_s_barrier(); asm volatile("" ::: "memory");
            f32x4 gv[2][2];
#pragma unroll
            for (int bj = 0; bj < 2; ++bj)
#pragma unroll
                for (int n = 0; n < 2; ++n) gv[bj][n] = *(const f32x4*)(g_kv + lc0 + 32 * bj + 4 * n);
#pragma unroll
            for (int ai = 0; ai < 2; ++ai)
#pragma unroll
                for (int m = 0; m < 4; ++m) { const int row = row0 + ai * HALF + m * 16, rl = ai * HALF + wr * 64 + m * 16 + fr; const f32x4 t = *(const PG8_LAS f32x4*)(xch + rl * 4);
                    const float r2 = rsv[ai][m] / sqrtf(((t[0] + t[1]) + (t[2] + t[3])) * (1.0f / 256.0f) + 1e-6f);
                    const size_t kr = (size_t)(row >> 11) * 2112 + 64 + (row & 2047);
#pragma unroll
                    for (int bj = 0; bj < 2; ++bj) { const f32x4 a = acc[ai][bj][m][0] * r2 * gv[bj][0], b = acc[ai][bj][m][1] * r2 * gv[bj][1];
                        u32x4 w; w.x = pkbf(a[0], a[1]); w.y = pkbf(a[2], a[3]); w.z = pkbf(b[0], b[1]); w.w = pkbf(b[2], b[3]);
                        *(u32x4*)(cc + kr * 256 + lc0 + 32 * bj) = w; } }
            asm volatile("s_waitcnt lgkmcnt(0)" ::: "memory"); __builtin_amdgcn_s_barrier(); asm volatile("" ::: "memory");
            return;
        }
        const bool headnorm = pn < 4;
        f32x4 gv[2][2];
        if (headnorm) { const float* gp = (pn < 2) ? g_aq : g_ak; const float sc = (pn < 2) ? (0.125f * 1.4426950408889634f) : 1.0f;
#pragma unroll
            for (int bj = 0; bj < 2; ++bj)
#pragma unroll
                for (int n = 0; n < 2; ++n) gv[bj][n] = *(const f32x4*)(gp + 32 * bj + 8 * fq + 4 * n) * sc; }
        f32x4 sv[2][4];
#pragma unroll
        for (int ai = 0; ai < 2; ++ai)
#pragma unroll
            for (int m = 0; m < 4; ++m) sv[ai][m] = slots_load(ss, row0 + ai * HALF + m * 16, fq);
#pragma unroll
        for (int ai = 0; ai < 2; ++ai)
#pragma unroll
            for (int m = 0; m < 4; ++m) { const int row = row0 + ai * HALF + m * 16; const float rs = slots_rstd(sv[ai][m]);
                const size_t kr = (size_t)(row >> 11) * 2112 + 64 + (row & 2047);
                f32x4 v[2][2];
#pragma unroll
                for (int bj = 0; bj < 2; ++bj)
#pragma unroll
                    for (int n = 0; n < 2; ++n) v[bj][n] = acc[ai][bj][m][n] * rs;
                if (headnorm) { float sq = 0.f;
#pragma unroll
                    for (int bj = 0; bj < 2; ++bj)
#pragma unroll
                        for (int n = 0; n < 2; ++n) sq += (v[bj][n][0] * v[bj][n][0] + v[bj][n][1] * v[bj][n][1]) + (v[bj][n][2] * v[bj][n][2] + v[bj][n][3] * v[bj][n][3]);
                    sq += __shfl_xor(sq, 16); sq += __shfl_xor(sq, 32);
                    const float r2 = 1.0f / sqrtf(sq * (1.0f / 64.0f) + 1e-6f);
#pragma unroll
                    for (int bj = 0; bj < 2; ++bj)
#pragma unroll
                        for (int n = 0; n < 2; ++n) v[bj][n] = v[bj][n] * r2 * gv[bj][n]; }
                bf16_t* dst; bool st = true;
                if (pn < 2) dst = qa + (size_t)row * 512 + pn * 256 + lc0;
                else if (pn < 4) dst = ka + kr * 512 + (pn - 2) * 256 + lc0;
                else if (pn < 6) dst = va + kr * 512 + (pn - 4) * 256 + lc0;
                else if (pn < 8) dst = qb + (size_t)row * 512 + (pn - 6) * 256 + lc0;
                else if (pn < 11) dst = iq + (size_t)row * 512 + (pn - 9) * 256 + lc0;
                else { dst = ik + kr * 64 + lc0; st = (wc == 0);
                    if (wc == 1 && fq == 0) { const float s = 0.35355339059327373f * 0.125f; *(f32x4*)(iw + (size_t)row * 8) = v[0][0] * s; *(f32x4*)(iw + (size_t)row * 8 + 4) = v[0][1] * s; } }
                if (st) {
#pragma unroll
                    for (int bj = 0; bj < 2; ++bj) { u32x4 w; w.x = pkbf(v[bj][0][0], v[bj][0][1]); w.y = pkbf(v[bj][0][2], v[bj][0][3]); w.z = pkbf(v[bj][1][0], v[bj][1][1]); w.w = pkbf(v[bj][1][2], v[bj][1][3]);
                        *(u32x4*)(dst + 32 * bj) = w; } } }
    }
};
struct EpiKV {
    static constexpr bool PERM = true, AFTER_DRAIN = false;
    bf16_t *kk, *vv;
    __device__ __forceinline__ void operator()(const f32x4 (&acc)[2][2][4][2], const Unit& u, int wr, int wc, int fr, int fq) const {
        const int row0 = (u.pm >> 3) * 2112 + 64 + (u.pm & 7) * BM + wr * 64 + fr; bf16_t* base = (u.pn < 2 ? kk : vv) + (u.pn & 1) * 256 + wc * 32 + 8 * fq;
#pragma unroll
        for (int ai = 0; ai < 2; ++ai)
#pragma unroll
            for (int m = 0; m < 4; ++m) { bf16_t* rowp = base + (size_t)(row0 + ai * HALF + m * 16) * 512;
#pragma unroll
                for (int bj = 0; bj < 2; ++bj) { const f32x4 a = acc[ai][bj][m][0], b = acc[ai][bj][m][1];
                    u32x4 w; w.x = pkbf(a[0], a[1]); w.y = pkbf(a[2], a[3]); w.z = pkbf(b[0], b[1]); w.w = pkbf(b[2], b[3]);
                    *(u32x4*)(rowp + bj * HALF) = w; } }
    }
};
}
struct Args {
    const float* in[25]; float* out; unsigned char* ws; int dup; int pad;
};
typedef const __attribute__((address_space(4))) Args* CArgsP;
__device__ __forceinline__ CArgsP get_args() { CArgsP p = (CArgsP)__builtin_amdgcn_kernarg_segment_ptr(); asm volatile("" : "+s"(p)); return p; }
struct Frame {
    LAS unsigned char* lds; int tid, lane, wave, G, vcu;
};

__device__ __forceinline__ Frame make_frame(LAS unsigned char* lds, int wave_s) {
    Frame F; int t = wave_s * 64 + pg8::lane_id(); asm volatile("" : "+v"(t));
    F.lds = lds; F.tid = t; F.lane = t & 63; F.wave = __builtin_amdgcn_readfirstlane(t >> 6);
    F.G = gridDim.x; { const int bx = blockIdx.x; F.vcu = (F.G % 8 == 0) ? (bx % 8) * (F.G / 8) + bx / 8 : bx; }
    return F;
}
__device__ __forceinline__ void tr_item(const float* __restrict__ W, int ld, int col, int nvalid, const float* __restrict__ gain, int k0, bf16* out, int Kpitch, LAS float* scr, int lane) {
    const int c = lane & 31; const bool okc = c < nvalid;
    const float* wp = W + (size_t)(k0 + (lane >> 5)) * ld + col + (okc ? c : 0);
    float v[32];
#pragma unroll
    for (int i = 0; i < 32; ++i) v[i] = okc ? wp[(size_t)(2 * i) * ld] : 0.f;
    if (gain) {
#pragma unroll
        for (int i = 0; i < 32; ++i) v[i] *= gain[k0 + 2 * i + (lane >> 5)]; }
#pragma unroll
    for (int i = 0; i < 32; ++i) scr[(2 * i + (lane >> 5)) * 33 + c] = v[i];
    LDS_WAIT(); asm volatile("" ::: "memory");
    const int c8 = lane & 7;
#pragma unroll
    for (int j = 0; j < 4; ++j) { const int n = (lane >> 3) + 8 * j; const LAS float* s = scr + (8 * c8) * 33 + n;
        u32x4 o; o.x = pk2(s[0 * 33], s[1 * 33]); o.y = pk2(s[2 * 33], s[3 * 33]); o.z = pk2(s[4 * 33], s[5 * 33]); o.w = pk2(s[6 * 33], s[7 * 33]);
        *(u32x4*)(out + (size_t)n * Kpitch + 8 * c8) = o; }
    LDS_WAIT(); asm volatile("" ::: "memory");
}
__device__ __forceinline__ void p0_gu_item(const float* Wg, const float* Wu, const float* gain, bf16* WT, int r, LAS float* scr, int lane) {
    const int kb = r / 176, nb = r % 176, n0 = 32 * nb, pn = n0 >> 8, j = n0 & 255, bj = j >> 7, jj = j & 127;
    tr_item(bj ? Wu : Wg, FF, 128 * pn + jj, 32, gain, 64 * kb, WT + (size_t)n0 * DM + 64 * kb, DM, scr, lane);
}
__device__ __forceinline__ void p0_plain_item(const float* W, int K, int N, const float* gain, bf16* WT, int r, LAS float* scr, int lane) {
    const int nblk = N / 32, kb = r / nblk, nb = r % nblk;
    tr_item(W, N, 32 * nb, 32, gain, 64 * kb, WT + (size_t)(32 * nb) * K + 64 * kb, K, scr, lane);
}
__device__ __forceinline__ void tr_item8(const float* __restrict__ W, int ld, int col, float scale, int k0, unsigned char* out8, int Kpitch, LAS float* scr, int lane, const float* __restrict__ gain = nullptr) {
    const int c = lane & 31;
    const float* wp = W + (size_t)(k0 + (lane >> 5)) * ld + col + c;
    float v[32];
#pragma unroll
    for (int i = 0; i < 32; ++i) v[i] = wp[(size_t)(2 * i) * ld];
#pragma unroll
    for (int i = 0; i < 32; ++i) scr[(2 * i + (lane >> 5)) * 33 + c] = v[i] * (gain ? scale * gain[k0 + 2 * i + (lane >> 5)] : scale);
    LDS_WAIT(); asm volatile("" ::: "memory");
    const int n = lane >> 1, kh = 32 * (lane & 1); const LAS float* s = scr + kh * 33 + n;
#pragma unroll
    for (int j = 0; j < 2; ++j) { u32x4 o;
        o.x = pg8::pk8(s[(16 * j + 0) * 33], s[(16 * j + 1) * 33], s[(16 * j + 2) * 33], s[(16 * j + 3) * 33]); o.y = pg8::pk8(s[(16 * j + 4) * 33], s[(16 * j + 5) * 33], s[(16 * j + 6) * 33], s[(16 * j + 7) * 33]);
        o.z = pg8::pk8(s[(16 * j + 8) * 33], s[(16 * j + 9) * 33], s[(16 * j + 10) * 33], s[(16 * j + 11) * 33]); o.w = pg8::pk8(s[(16 * j + 12) * 33], s[(16 * j + 13) * 33], s[(16 * j + 14) * 33], s[(16 * j + 15) * 33]);
        *(u32x4*)(out8 + (size_t)n * Kpitch + kh + 16 * j) = o; }
    LDS_WAIT(); asm volatile("" ::: "memory");
}
__device__ __forceinline__ void p0_plain_item8(const float* W, int K, int N, float scale, unsigned char* WT8, int r, LAS float* scr, int lane) {
    const int nblk = N / 32, kb = r / nblk, nb = r % nblk;
    tr_item8(W, N, 32 * nb, scale, 64 * kb, WT8 + (size_t)(32 * nb) * K + 64 * kb, K, scr, lane);
}
__device__ __forceinline__ void p0_gu_item8(const float* Wg, const float* Wu, const float* gain, unsigned char* WT8, int r, LAS float* scr, int lane) {
    const int kb = r / 176, nb = r % 176, n0 = 32 * nb, pn = n0 >> 8, j = n0 & 255, bj = j >> 7, jj = j & 127;
    tr_item8(bj ? Wu : Wg, FF, 128 * pn + jj, GU_SCALE, 64 * kb, WT8 + (size_t)n0 * DM + 64 * kb, DM, scr, lane, gain);
}
__device__ __forceinline__ void p0_in_item(const float* W, const float* gain, bf16* WT, int r, LAS float* scr, int lane) {
    const int kb = r / 96, nb = r % 96, n0 = 32 * nb, pn = n0 >> 8, j = n0 & 255, bj = j >> 7, wc = (j >> 5) & 3, L = 256 * pn + 64 * wc + 32 * bj;
    int nv = NIN - L; nv = nv < 0 ? 0 : (nv > 32 ? 32 : nv);
    tr_item(W, NIN, L, nv, gain, 64 * kb, WT + (size_t)n0 * DM + 64 * kb, DM, scr, lane);
}
__device__ __forceinline__ void row_to_bf16(const float* xrow, bf16* orow, float* ssrow, int lane) {
    const f32x4* xr = (const f32x4*)xrow + lane; f32x4 v[4]; float s = 0.f;
#pragma unroll
    for (int j = 0; j < 4; ++j) { v[j] = xr[64 * j]; s += (v[j][0] * v[j][0] + v[j][1] * v[j][1]) + (v[j][2] * v[j][2] + v[j][3] * v[j][3]); }
    u32x2* o8 = (u32x2*)orow + lane;
#pragma unroll
    for (int j = 0; j < 4; ++j) { u32x2 w; w.x = pk2(v[j][0], v[j][1]); w.y = pk2(v[j][2], v[j][3]); o8[64 * j] = w; }
    const float tot = wave_sum(s);
    if (lane < 16) ssrow[lane] = (lane == 0) ? tot : 0.f;
}
__device__ __forceinline__ void p0_prologue(const Frame& F, CArgsP a) {
    unsigned char* ws = a->ws;
    LAS float* scr = (LAS float*)(F.lds + F.wave * 16384);
    const int gw = F.vcu * 8 + F.wave, NGW = F.G * 8, lane = F.lane;
    constexpr int I0 = 2816, I1 = 1408, I2 = 1536, I3 = 512, I4 = 2816, I5 = 1408, I6 = 64, I7 = 64, NIT = I0 + I1 + I2 + I3 + I4 + I5 + I6 + I7;
    for (int it = gw; it < NIT; it += NGW) {
        int r = it;
        if (r < I0) { p0_gu_item(a->in[4], a->in[5], a->in[3], (bf16*)(ws + WS_WGU1), r, scr, lane); continue; } r -= I0;
        if (r < I1) { if (F8_D1) p0_plain_item8(a->in[6], FF, DM, WD_SCALE, ws + WS_WD1, r, scr, lane); else p0_plain_item(a->in[6], FF, DM, nullptr, (bf16*)(ws + WS_WD1), r, scr, lane); continue; } r -= I1;
        if (r < I2) { p0_in_item(a->in[8], a->in[7], (bf16*)(ws + WS_WIN), r, scr, lane); continue; } r -= I2;
        if (r < I3) { p0_plain_item(a->in[20], DM, DM, nullptr, (bf16*)(ws + WS_WOUT), r, scr, lane); continue; } r -= I3;
        if (r < I4) { if (F8_G2) p0_gu_item8(a->in[22], a->in[23], a->in[21], ws + WS_WGU2, r, scr, lane); else p0_gu_item(a->in[22], a->in[23], a->in[21], (bf16*)(ws + WS_WGU2), r, scr, lane); continue; } r -= I4;
        if (r < I5) { if (F8_D2) p0_plain_item8(a->in[24], FF, DM, WD_SCALE, ws + WS_WD2, r, scr, lane); else p0_plain_item(a->in[24], FF, DM, nullptr, (bf16*)(ws + WS_WD2), r, scr, lane); continue; } r -= I5;
        if (r < I6) { const int h = r >> 4, q = r & 15, kb = q >> 2, nb = q & 3;
            tr_item(a->in[19] + (size_t)h * 256 * 128, 128, 32 * nb, 32, nullptr, 64 * kb, (bf16*)(ws + WS_WKV) + (size_t)(512 + 128 * h + 32 * nb) * 256 + 64 * kb, 256, scr, lane); continue; } r -= I6;
        { const int h = r >> 4, q = r & 15, kb = q >> 3, nb = q & 7;
            tr_item(a->in[17] + (size_t)h * 128 * 256, 256, 32 * nb, 32, nullptr, 64 * kb, (bf16*)(ws + WS_WUKT) + (size_t)h * 256 * 128 + (size_t)(32 * nb) * 128 + 64 * kb, 128, scr, lane); }
    }
    {
        const int gid = F.vcu * 512 + F.tid;
        for (int e = gid; e < 512 * 256 / 2; e += F.G * 512) { const int i = 2 * e, c = i & 255; const float* w = a->in[17] + i; const float* g = a->in[18] + c;
            ((unsigned*)(ws + WS_WKV))[e] = pk2(w[0] * g[0], w[1] * g[1]); }
    }
    for (int m0 = gw * 4; m0 < MX; m0 += NGW * 4) {
        f32x4 v[4][4]; float sq[4];
#pragma unroll
        for (int r = 0; r < 4; ++r) { const f32x4* xr = (const f32x4*)(a->in[0] + (size_t)(m0 + r) * DM) + lane;
#pragma unroll
            for (int j = 0; j < 4; ++j) v[r][j] = __builtin_nontemporal_load(xr + 64 * j); }
#pragma unroll
        for (int r = 0; r < 4; ++r) { float s = 0.f; u32x2* o8 = (u32x2*)((bf16*)(ws + WS_HB) + (size_t)(m0 + r) * DM) + lane;
#pragma unroll
            for (int j = 0; j < 4; ++j) { s += (v[r][j][0] * v[r][j][0] + v[r][j][1] * v[r][j][1]) + (v[r][j][2] * v[r][j][2] + v[r][j][3] * v[r][j][3]);
                u32x2 w; w.x = pk2(v[r][j][0], v[r][j][1]); w.y = pk2(v[r][j][2], v[r][j][3]); o8[64 * j] = w; }
            sq[r] = wave_sum(s); }
#pragma unroll
        for (int r = 0; r < 4; ++r) if (lane < 16) ((float*)(ws + WS_SS))[(size_t)(m0 + r) * 16 + lane] = (lane == 0) ? sq[r] : 0.f;
    }
    if (gw < 16) row_to_bf16(a->in[1] + (size_t)gw * DM, (bf16*)(ws + WS_META + MO_HBM) + (size_t)gw * DM, (float*)(ws + WS_META + MO_SSM0) + gw * 16, lane);
    {
        const int gid = F.vcu * 512 + F.tid, NT = F.G * 512; const u32x4 z = {0u, 0u, 0u, 0u};
        for (int e = gid; e < NB * 48 * 64; e += NT) { const int b = e / (48 * 64), q = e % (48 * 64); const size_t o = ((size_t)b * KROWS) * 1024 + (size_t)q * 16;
            *(u32x4*)(ws + WS_KA + o) = z; *(u32x4*)(ws + WS_VA + o) = z; *(u32x4*)(ws + WS_KK + o) = z; *(u32x4*)(ws + WS_VV + o) = z; }
        for (int e = gid; e < NB * 48 * 32; e += NT) { const int b = e / (48 * 32), q = e % (48 * 32); *(u32x4*)(ws + WS_C + ((size_t)b * KROWS) * 512 + (size_t)q * 16) = z; }
        for (int e = gid; e < NB * 48 * 8; e += NT) { const int b = e / (48 * 8), q = e % (48 * 8); *(u32x4*)(ws + WS_IK + ((size_t)b * KROWS) * 128 + (size_t)q * 16) = z; }
    }
}

template <int KS, int NT, int BS> __device__ __forceinline__ void meta_block_mm(const Frame& F, const bf16* __restrict__ A16, const bf16* __restrict__ Bt, const int (&prow)[NT], int K, float (&v)[4][NT]) {
    const int lane = F.lane, col = lane & 15, kq = lane >> 4, k0 = F.wave * KS * 32;
    const bf16* ap = A16 + (size_t)col * K + k0 + 8 * kq;
    const bf16* bp[NT]; f32x4 acc[NT];
#pragma unroll
    for (int j = 0; j < NT; ++j) { bp[j] = Bt + (size_t)(prow[j] + col) * K + k0 + 8 * kq; acc[j] = (f32x4){0.f, 0.f, 0.f, 0.f}; }
#pragma unroll
    for (int s0 = 0; s0 < KS; s0 += BS) {
        bf16x8 av[BS], bv[NT][BS];
#pragma unroll
        for (int s = 0; s < BS; ++s) if (s0 + s < KS) { av[s] = *(const bf16x8*)(ap + 32 * (s0 + s));
#pragma unroll
            for (int j = 0; j < NT; ++j) bv[j][s] = *(const bf16x8*)(bp[j] + 32 * (s0 + s)); }
#pragma unroll
        for (int s = 0; s < BS; ++s) if (s0 + s < KS) {
#pragma unroll
            for (int j = 0; j < NT; ++j) acc[j] = MFMA16(av[s], bv[j][s], acc[j]); }
    }
    LAS float* red = (LAS float*)F.lds;
#pragma unroll
    for (int j = 0; j < NT; ++j)
#pragma unroll
        for (int r = 0; r < 4; ++r) red[(F.wave * 16 + 4 * kq + r) * (16 * NT) + 16 * j + col] = acc[j][r];
    __syncthreads();
    if (F.wave == 0) {
#pragma unroll
        for (int r = 0; r < 4; ++r)
#pragma unroll
            for (int j = 0; j < NT; ++j) { float t = 0.f;
#pragma unroll
                for (int w = 0; w < 8; ++w) t += red[(w * 16 + 4 * kq + r) * (16 * NT) + 16 * j + col];
                v[r][j] = t; } }
    __syncthreads();
}
template <int N> __device__ __forceinline__ float meta_rstd(const float* ssm, int row) { float s = 0.f;
#pragma unroll
    for (int i = 0; i < N; ++i) s += ssm[row * N + i];
    return 1.0f / sqrtf(s * (1.0f / 1024.0f) + EPS); }
__device__ __forceinline__ void meta_store_rows(const Frame& F, const float (&v)[4][4], bf16* dst, int pitch, int cb, int nb) {
    const int lane = F.lane; LAS unsigned char* st = F.lds + 96 * 1024;
#pragma unroll
    for (int r = 0; r < 4; ++r)
#pragma unroll
        for (int j = 0; j < 4; ++j) *(LAS bf16*)(st + (4 * (lane >> 4) + r) * 144 + 2 * (16 * j + (lane & 15))) = (bf16)(pk2(v[r][j], 0.f) & 0xffffu);
    LDS_WAIT();
#pragma unroll
    for (int i = 0; i < 2; ++i) { const int c = lane + 64 * i, row = c >> 3, ch = c & 7; const u32x4 x = *(const LAS u32x4*)(st + row * 144 + 16 * ch);
        for (int b = 0; b < nb; ++b) *(u32x4*)(dst + ((size_t)b * KROWS + 48 + row) * pitch + cb + 8 * ch) = x; }
    LDS_WAIT();
}
__device__ __forceinline__ void meta_p1(const Frame& F, CArgsP a) {
    unsigned char* ws = a->ws;
    const int t = F.vcu; if (t >= 88) return;
    const int lane = F.lane, f0 = 32 * t, pn = f0 >> 7, jj = f0 & 127; const int prow[4] = {256 * pn + jj, 256 * pn + jj + 16, 256 * pn + 128 + jj, 256 * pn + 128 + jj + 16};
    float v[4][4]; meta_block_mm<4, 4, 4>(F, (const bf16*)(ws + WS_META + MO_HBM), (const bf16*)(ws + WS_WGU1), prow, DM, v);
    if (F.wave != 0) return;
    unsigned char* actm = ws + WS_META + MO_ACTM; const float* ssm = (const float*)(ws + WS_META + MO_SSM0);
#pragma unroll
    for (int r = 0; r < 4; ++r) { const int row = 4 * (lane >> 4) + r; const float rs = meta_rstd<16>(ssm, row);
        const float ru = F8_D1 ? rs * ACT_SCALE : rs; const float a0 = pg8::silu_mul(v[r][0] * rs, v[r][2] * ru), a1 = pg8::silu_mul(v[r][1] * rs, v[r][3] * ru);
        if (F8_D1) { const unsigned p = pg8::pk8(a0, a0, a1, a1);
            actm[row * FF + f0 + (lane & 15)] = (unsigned char)(p & 0xffu); actm[row * FF + f0 + 16 + (lane & 15)] = (unsigned char)((p >> 16) & 0xffu); }
        else { ((bf16*)actm)[row * FF + f0 + (lane & 15)] = (bf16)(pk2(a0, 0.f) & 0xffffu); ((bf16*)actm)[row * FF + f0 + 16 + (lane & 15)] = (bf16)(pk2(a1, 0.f) & 0xffffu); } }
}
#if F8_D1
__device__ __forceinline__ void meta_p2(const Frame& F, CArgsP a) {
    unsigned char* ws = a->ws;
    if (F.vcu >= 64) return;
    const int t = F.vcu, lane = F.lane, col = lane & 15, kq = lane >> 4;
    const unsigned char* ap = ws + WS_META + MO_ACTM + (size_t)col * FF + 32 * kq; const unsigned char* bp = ws + WS_WD1 + (size_t)(16 * t + col) * FF + 32 * kq;
    u32x4 av[3][2], bv[3][2];
#pragma unroll
    for (int i = 0; i < 3; ++i) { const int s = F.wave + 8 * i; if (s < 22) { av[i][0] = *(const u32x4*)(ap + 128 * s); av[i][1] = *(const u32x4*)(ap + 128 * s + 16); bv[i][0] = *(const u32x4*)(bp + 128 * s); bv[i][1] = *(const u32x4*)(bp + 128 * s + 16); } }
    f32x4 acc = {0.f, 0.f, 0.f, 0.f};
#pragma unroll
    for (int i = 0; i < 3; ++i) if (F.wave + 8 * i < 22) { typedef int i32x8 __attribute__((ext_vector_type(8)));
        const i32x8 A = {(int)av[i][0].x, (int)av[i][0].y, (int)av[i][0].z, (int)av[i][0].w, (int)av[i][1].x, (int)av[i][1].y, (int)av[i][1].z, (int)av[i][1].w};
        const i32x8 B = {(int)bv[i][0].x, (int)bv[i][0].y, (int)bv[i][0].z, (int)bv[i][0].w, (int)bv[i][1].x, (int)bv[i][1].y, (int)bv[i][1].z, (int)bv[i][1].w};
        acc = __builtin_amdgcn_mfma_scale_f32_16x16x128_f8f6f4(A, B, acc, 0, 0, 0, 0x7F7F7F7F, 0, 0x7F7F7F7F); }
    LAS float* red = (LAS float*)F.lds;
#pragma unroll
    for (int r = 0; r < 4; ++r) red[(F.wave * 16 + 4 * kq + r) * 16 + col] = acc[r];
    __syncthreads();
    if (F.wave == 0) {
        bf16* h1mb = (bf16*)(ws + WS_META + MO_H1MB); float* ssm1 = (float*)(ws + WS_META + MO_SSM1);
#pragma unroll
        for (int r = 0; r < 4; ++r) { const int row = 4 * kq + r; const int c = 16 * t + col; float d = 0.f;
#pragma unroll
            for (int w = 0; w < 8; ++w) d += red[(w * 16 + row) * 16 + col];
            const float h = a->in[1][row * DM + c] + d * (0.5f / (ACT_SCALE * WD_SCALE)); float sq = h * h; h1mb[row * DM + c] = (bf16)(pk2(h, 0.f) & 0xffffu);
            sq += __shfl_xor(sq, 1); sq += __shfl_xor(sq, 2); sq += __shfl_xor(sq, 4); sq += __shfl_xor(sq, 8);
            if (col == 0) ssm1[row * 64 + t] = sq; } }
    __syncthreads();
}
#else
__device__ __forceinline__ void meta_p2(const Frame& F, CArgsP a) {
    unsigned char* ws = a->ws;
    if (F.vcu >= 64) return;
    const int t = F.vcu, lane = F.lane; const int prow[1] = {16 * t};
    float v[4][1]; meta_block_mm<11, 1, 11>(F, (const bf16*)(ws + WS_META + MO_ACTM), (const bf16*)(ws + WS_WD1), prow, FF, v);
    if (F.wave != 0) return;
    bf16* h1mb = (bf16*)(ws + WS_META + MO_H1MB); float* ssm1 = (float*)(ws + WS_META + MO_SSM1);
#pragma unroll
    for (int r = 0; r < 4; ++r) { const int row = 4 * (lane >> 4) + r; const int c = 16 * t + (lane & 15);
        const float h = a->in[1][row * DM + c] + 0.5f * v[r][0]; float sq = h * h; h1mb[row * DM + c] = (bf16)(pk2(h, 0.f) & 0xffffu);
        sq += __shfl_xor(sq, 1); sq += __shfl_xor(sq, 2); sq += __shfl_xor(sq, 4); sq += __shfl_xor(sq, 8);
        if ((lane & 15) == 0) ssm1[row * 64 + t] = sq; }
}
#endif
__device__ __forceinline__ void meta_p3(const Frame& F, CArgsP a) {
    unsigned char* ws = a->ws; const int lane = F.lane;
    if (F.vcu > 17) return;
    const bf16* A16 = (const bf16*)(ws + WS_META + MO_H1MB); const bf16* Wt = (const bf16*)(ws + WS_WIN); const float* ssm1 = (const float*)(ws + WS_META + MO_SSM1);
    if (F.vcu < 17) { const int t = F.vcu; int L, kind; if (t < 8) { L = 512 + 64 * t; kind = 1; } else if (t < 16) { L = 1024 + 64 * (t - 8); kind = 2; } else { L = 2816; kind = 3; }
        const int pn = L >> 8, wc = (L & 255) >> 6, base = 256 * pn + 32 * wc; const int prow[4] = {base, base + 16, base + 128, base + 144};
        float v[4][4]; meta_block_mm<4, 4, 4>(F, A16, Wt, prow, DM, v);
        if (F.wave != 0) return;
#pragma unroll
        for (int r = 0; r < 4; ++r) { const float rs = meta_rstd<64>(ssm1, 4 * (lane >> 4) + r);
#pragma unroll
            for (int j = 0; j < 4; ++j) v[r][j] *= rs;
            if (kind == 1) { float sq = (v[r][0] * v[r][0] + v[r][1] * v[r][1]) + (v[r][2] * v[r][2] + v[r][3] * v[r][3]);
                sq += __shfl_xor(sq, 1); sq += __shfl_xor(sq, 2); sq += __shfl_xor(sq, 4); sq += __shfl_xor(sq, 8);
                const float r2 = 1.0f / sqrtf(sq * (1.0f / 64.0f) + EPS);
#pragma unroll
                for (int j = 0; j < 4; ++j) v[r][j] *= r2 * a->in[10][16 * j + (lane & 15)]; } }
        if (kind == 1) meta_store_rows(F, v, (bf16*)(ws + WS_KA), 512, L - 512, NB);
        else if (kind == 2) meta_store_rows(F, v, (bf16*)(ws + WS_VA), 512, L - 1024, NB);
        else meta_store_rows(F, v, (bf16*)(ws + WS_IK), 64, 0, NB);
    } else {
        float v8[2][4][8]; float sq[4] = {0.f, 0.f, 0.f, 0.f};
#pragma unroll
        for (int c = 0; c < 2; ++c) { const int b0 = 2048 + 32 * (2 * c), b1 = 2048 + 32 * (2 * c + 1); const int prow[8] = {b0, b0 + 16, b0 + 128, b0 + 144, b1, b1 + 16, b1 + 128, b1 + 144};
            meta_block_mm<4, 8, 4>(F, A16, Wt, prow, DM, v8[c]); }
        if (F.wave != 0) return;
        float v[4][4][4];
#pragma unroll
        for (int r = 0; r < 4; ++r) { const float rs = meta_rstd<64>(ssm1, 4 * (lane >> 4) + r);
#pragma unroll
            for (int g = 0; g < 4; ++g)
#pragma unroll
                for (int j = 0; j < 4; ++j) { v[g][r][j] = v8[g >> 1][r][4 * (g & 1) + j] * rs; sq[r] += v[g][r][j] * v[g][r][j]; }
            sq[r] += __shfl_xor(sq[r], 1); sq[r] += __shfl_xor(sq[r], 2); sq[r] += __shfl_xor(sq[r], 4); sq[r] += __shfl_xor(sq[r], 8);
            const float r2 = 1.0f / sqrtf(sq[r] * (1.0f / 256.0f) + EPS);
#pragma unroll
            for (int g = 0; g < 4; ++g)
#pragma unroll
                for (int j = 0; j < 4; ++j) v[g][r][j] *= r2 * a->in[16][64 * g + 16 * j + (lane & 15)]; }
#pragma unroll
        for (int g = 0; g < 4; ++g) meta_store_rows(F, v[g], (bf16*)(ws + WS_C), 256, 64 * g, 1);
    }
}

__device__ __forceinline__ void meta_p4(const Frame& F, CArgsP a) {
    unsigned char* ws = a->ws; const int lane = F.lane;
    if (F.vcu >= 16) return;
    const int t = F.vcu; const int prow[4] = {64 * t, 64 * t + 16, 64 * t + 32, 64 * t + 48};
    float v[4][4]; meta_block_mm<1, 4, 1>(F, (const bf16*)(ws + WS_C) + (size_t)48 * 256, (const bf16*)(ws + WS_WKV), prow, 256, v);
    if (F.wave != 0) return;
    meta_store_rows(F, v, (bf16*)(ws + (t < 8 ? WS_KK : WS_VV)), 512, 64 * (t & 7), NB);
}

#define XB_TMO      128
#define XB_XCNT(j)  (256  + 64 * (j))
#define XB_XSUB(j)  (1280 + 64 * (j))
#define XB_XGEN(j)  (2304 + 64 * (j))
#define XB_TOP      3328
#define XB_TOPGEN   3392
#define XCD_BAR_WORDS 3456
#define XB_SPIN_CAP (1u << 18)

__device__ __forceinline__ unsigned xb_ld(unsigned* p)              { return __hip_atomic_load(p, __ATOMIC_RELAXED, __HIP_MEMORY_SCOPE_AGENT); }
__device__ __forceinline__ unsigned xb_add(unsigned* p, unsigned v) { return __hip_atomic_fetch_add(p, v, __ATOMIC_RELAXED, __HIP_MEMORY_SCOPE_AGENT); }
__device__ __forceinline__ unsigned xb_xcc_id() { return (unsigned)__builtin_amdgcn_s_getreg((3 << 11) | 20) & 0xFu; }
#define XB_SPIN(cond, bar) do { unsigned _sp = 0; while (cond) { __builtin_amdgcn_s_sleep(1); \
    if ((++_sp & 255u) == 0u) { if (xb_ld(&(bar)[XB_TMO])) break; if (_sp > XB_SPIN_CAP) { atomicAdd(&(bar)[XB_TMO], 1u); break; } } } } while (0)

struct XcdBarrier {
    unsigned* bar; unsigned x; int w;
    volatile LAS unsigned* st;
};

__device__ __forceinline__ XcdBarrier xcd_barrier_post(unsigned* bar, volatile LAS unsigned* st) {
    XcdBarrier b; b.bar = bar; b.x = xb_xcc_id(); b.st = st;
    if (threadIdx.x == 0) (void)xb_add(&bar[XB_XCNT(b.x)], 1u);
    return b;
}
__device__ __forceinline__ void xcd_barrier_complete(unsigned* bar, unsigned x, unsigned& nloc, unsigned& nx) {
    const unsigned G = gridDim.x * gridDim.y * gridDim.z;
    unsigned sum, cnt, mine, sp = 0u;
    for (;;) {
        sum = 0u; cnt = 0u; mine = 0u;
#pragma unroll
        for (unsigned j = 0; j < 16; ++j) { const unsigned c = xb_ld(&bar[XB_XCNT(j)]); sum += c; cnt += (c > 0u) ? 1u : 0u; mine = (j == x) ? c : mine; }
        if (sum == G) break;
        __builtin_amdgcn_s_sleep(1);
        if ((++sp & 255u) == 0u) { if (xb_ld(&bar[XB_TMO])) break; if (sp > XB_SPIN_CAP) { atomicAdd(&bar[XB_TMO], 1u); break; } }
    }
    nloc = mine > 0u ? mine : 1u; nx = cnt > 0u ? cnt : 1u;
}

__device__ __forceinline__ void xcd_barrier(const XcdBarrier& b) {
    asm volatile("s_waitcnt vmcnt(0)" ::: "memory");
    __syncthreads();
    if (b.w == 0 && pg8::lane_id() == 0) {
        unsigned* bar = b.bar;
        __builtin_amdgcn_s_waitcnt(0);
        unsigned nloc = b.st[0], nx = b.st[1];
        if (nloc == 0u) { xcd_barrier_complete(bar, b.x, nloc, nx); b.st[0] = nloc; b.st[1] = nx; }
        const unsigned old = xb_add(&bar[XB_XSUB(b.x)], 1u);
        const unsigned gen = old / nloc;
        if (old + 1u == (gen + 1u) * nloc) {
            __builtin_amdgcn_fence(__ATOMIC_RELEASE, "agent");
            asm volatile("s_waitcnt vmcnt(0)" ::: "memory");
            const unsigned og = xb_add(&bar[XB_TOP], 1u);
            const unsigned tg = og / nx;
            if (og + 1u == (tg + 1u) * nx) xb_add(&bar[XB_TOPGEN], 1u);
            else XB_SPIN(xb_ld(&bar[XB_TOPGEN]) == tg, bar);
            __builtin_amdgcn_fence(__ATOMIC_ACQUIRE, "agent");
            xb_add(&bar[XB_XGEN(b.x)], 1u);
            asm volatile("s_waitcnt vmcnt(0)" ::: "memory");
        } else {
            XB_SPIN(xb_ld(&bar[XB_XGEN(b.x)]) == gen, bar);
            __builtin_amdgcn_fence(__ATOMIC_ACQUIRE, "agent");
            asm volatile("s_waitcnt vmcnt(0)" ::: "memory");
        }
    }
    __syncthreads();
}
constexpr int G4 = 1040, TROW = 272, TILEB = 16 * G4  , BUFB = 2 * TILEB  ;
__device__ __forceinline__ unsigned offg(unsigned row, unsigned ch) { return (row >> 2) * (unsigned)G4 + (row & 3u) * 256u + 16u * (ch ^ (4u * (row & 3u))); }
__device__ __constant__ unsigned char kBucket[128] = {
    0, 1, 2, 3, 4, 5, 6, 7, 8, 9, 10, 11, 12, 13, 14, 15, 16, 16, 16, 17, 17, 18, 18, 18, 19, 19, 19, 20, 20, 20, 20, 21, 21, 21, 21, 22, 22, 22, 22, 22, 23, 23, 23, 23, 23, 23, 24, 24, 24, 24, 24, 24,
    25, 25, 25, 25, 25, 25, 25, 26, 26, 26, 26, 26, 26, 26, 26, 27, 27, 27, 27, 27, 27, 27, 27, 27, 27, 28, 28, 28, 28, 28, 28, 28, 28, 28, 28, 29, 29, 29, 29, 29, 29, 29, 29, 29, 29, 29, 29,
    30, 30, 30, 30, 30, 30, 30, 30, 30, 30, 30, 30, 30, 30, 31, 31, 31, 31, 31, 31, 31, 31, 31, 31, 31, 31, 31, 31, 31};
__device__ __forceinline__ unsigned piece_src(int lane, unsigned RP) { const unsigned j = (unsigned)lane >> 4; return j * RP + 16u * (((unsigned)lane & 15u) ^ (4u * j)); }
__device__ __forceinline__ void dma_piece(const void* gbase  , unsigned voff, unsigned m0v  ) {
    unsigned keep;
    asm volatile("s_mov_b32 %0, m0\n\ts_mov_b32 m0, %3\n\ts_nop 0\n\tglobal_load_lds_dwordx4 %1, %2\n\ts_mov_b32 m0, %0" : "=&s"(keep) : "v"(voff), "s"(gbase), "s"(m0v) : "memory");
}
__device__ __forceinline__ void tile_dma(const bf16* Kg, const bf16* Vg, LAS unsigned char* buf, int wid, int lane) {
    const bf16* k0 = Kg + (size_t)(8 * wid) * 512; const bf16* k1 = k0 + 4 * 512; const bf16* v0 = Vg + (size_t)(8 * wid) * 512; const bf16* v1 = v0 + 4 * 512;
    const unsigned mk = (unsigned)__builtin_amdgcn_readfirstlane((int)(unsigned)(uintptr_t)(buf + 2 * wid * G4)), mv = mk + TILEB;
    const unsigned vo = piece_src(lane, 1024u); unsigned keep;
    asm volatile("s_mov_b32 %0, m0\n\t"
                 "s_mov_b32 m0, %6\n\ts_nop 0\n\tglobal_load_lds_dwordx4 %1, %2\n\t"
                 "s_add_u32 m0, m0, 0x410\n\ts_nop 0\n\tglobal_load_lds_dwordx4 %1, %3\n\t"
                 "s_mov_b32 m0, %7\n\ts_nop 0\n\tglobal_load_lds_dwordx4 %1, %4\n\t"
                 "s_add_u32 m0, m0, 0x410\n\ts_nop 0\n\tglobal_load_lds_dwordx4 %1, %5\n\t"
                 "s_mov_b32 m0, %0"
                 : "=&s"(keep) : "v"(vo), "s"(k0), "s"(k1), "s"(v0), "s"(v1), "s"(mk), "s"(mv) : "memory", "scc");
}
#define DMA_WAIT() asm volatile("s_waitcnt vmcnt(0)" ::: "memory")
__device__ __forceinline__ void store_rows_via_lds(const f32x16 (&o)[4], float sc, const float* gain, LAS unsigned char* stage, bf16* grow0  , int lane) {
    const int r32 = lane & 31, hi = lane >> 5;
#pragma unroll
    for (int dt = 0; dt < 4; ++dt)
#pragma unroll
        for (int g = 0; g < 4; ++g) { const int d0 = 32 * dt + 8 * g + 4 * hi; f32x4 gn = {1.f, 1.f, 1.f, 1.f}; if (gain) gn = *(const f32x4*)(gain + d0);
            u32x2 w; w.x = pk2(o[dt][4 * g] * sc * gn[0], o[dt][4 * g + 1] * sc * gn[1]); w.y = pk2(o[dt][4 * g + 2] * sc * gn[2], o[dt][4 * g + 3] * sc * gn[3]);
            *(LAS u32x2*)(stage + r32 * TROW + d0 * 2) = w; }
    LDS_WAIT();
#pragma unroll
    for (int i = 0; i < 8; ++i) { const int row = 4 * i + (lane >> 4), ch = lane & 15; const u32x4 v = *(const LAS u32x4*)(stage + row * TROW + ch * 16);
        *(u32x4*)(grow0 + (size_t)row * 1024 + ch * 8) = v; }
}
__device__ __forceinline__ unsigned xch(int c, int j) { return 16u * (unsigned)(c ^ (4 * j)); }
typedef short v4i16_t __attribute__((ext_vector_type(4)));
__device__ __forceinline__ s16x4 vtr(const LAS unsigned char* p) { return __builtin_bit_cast(s16x4, __builtin_amdgcn_ds_read_tr16_b64_v4i16((LAS v4i16_t*)p)); }
__device__ __forceinline__ bf16x8 vfrag(const LAS unsigned char* Vb, int lane, int kb, int sp, int dt) {
    const int hi = lane >> 5, blk = (lane >> 4) & 1, qq = (lane & 15) >> 2, p = lane & 3;
    const unsigned ch = 4 * dt + 2 * blk + (p >> 1);
    const unsigned r0 = 32 * kb + 16 * sp + 4 * hi + qq;
    const s16x4 lo = vtr(Vb + offg(r0, ch) + 8 * (p & 1)), hh = vtr(Vb + offg(r0 + 8, ch) + 8 * (p & 1));
    return (bf16x8){lo[0], lo[1], lo[2], lo[3], hh[0], hh[1], hh[2], hh[3]};
}
__device__ __forceinline__ bf16x8 pack8(const f32x16& x, int s) {
    u32x4 p; p.x = pk2(x[8 * s], x[8 * s + 1]); p.y = pk2(x[8 * s + 2], x[8 * s + 3]); p.z = pk2(x[8 * s + 4], x[8 * s + 5]); p.w = pk2(x[8 * s + 6], x[8 * s + 7]);
    return __builtin_bit_cast(bf16x8, p);
}
__device__ __forceinline__ void build_lut(LAS float* lut, const float* rel_bias, int col, int tid) {
    if (tid < 128) lut[tid] = rel_bias[kBucket[tid] * 8 + col] * LOG2E;
}

constexpr int LDS_AQ = 67072;
__device__ __forceinline__ void exp_block(f32x16& s, const LAS float* lut, bool interior, int kr0, int qrow, int hi, float& l) {
    if (interior) {
#pragma unroll
        for (int r = 0; r < 16; ++r) { s[r] = __builtin_amdgcn_exp2f(s[r]); l += s[r]; } }
    else {
#pragma unroll
        for (int r = 0; r < 16; ++r) { const int kr = kr0 + crow(r, hi), n = qrow - kr; const bool ok = (n >= 0) && (kr >= 48);
            const int idx = n < 0 ? 0 : (n > 127 ? 127 : n); const float e = __builtin_amdgcn_exp2f(s[r] + lut[idx]);
            s[r] = ok ? e : 0.f; l += s[r];
            if ((r & 3) == 3) asm volatile("" ::: "memory"); } }
}
__device__ __forceinline__ void attnA_unit(const Frame& F, CArgsP a, int b, int head, int qb8, float lam, int abl) {
    unsigned char* ws = a->ws; const int tid = F.tid, lane = F.lane, wid = F.wave, r32 = lane & 31, hi = lane >> 5;
    LAS unsigned char* lds = F.lds; LAS float* lut = (LAS float*)(lds + LDS_LUT);
    const int qrow0 = 64 + 256 * qb8 + 32 * wid, qrow = qrow0 + r32;
    const size_t gq = (size_t)b * SEQ + 256 * qb8 + 32 * wid + r32;
    const bf16* Kg = (const bf16*)(ws + WS_KA) + (size_t)b * KROWS * 512 + head * 128;
    const bf16* Vg = (const bf16*)(ws + WS_VA) + (size_t)b * KROWS * 512 + head * 128;
    const int nt = 4 * qb8 + 5, wlast = (qrow0 + 31) >> 6;
    tile_dma(Kg, Vg, lds, wid, lane);
    build_lut(lut, a->in[2], head, tid);
    { const bf16* qg = (const bf16*)(ws + WS_QA) + ((size_t)b * SEQ + 256 * qb8 + 32 * wid) * 512 + head * 128;
      const unsigned mq = (unsigned)__builtin_amdgcn_readfirstlane((int)(unsigned)(uintptr_t)(lds + LDS_AQ + 8 * wid * G4)); const unsigned vo = piece_src(lane, 1024u);
#pragma unroll
      for (int i = 0; i < 8; ++i) dma_piece(qg + (size_t)(4 * i) * 512, vo, mq + i * G4); }
    const int j4 = r32 & 3;
    const LAS unsigned char* qb_ = lds + LDS_AQ + (8 * wid + (r32 >> 2)) * G4 + j4 * 256;
    float l1 = 0.f, l2 = 0.f;
    f32x16 o1[4], o2[4];
#pragma unroll
    for (int dt = 0; dt < 4; ++dt) { o1[dt] = (f32x16){}; o2[dt] = (f32x16){}; }
    DMA_WAIT(); __syncthreads();
#pragma unroll 1
    for (int jt = 0; jt < nt; ++jt) {
        LAS unsigned char* cur = lds + (jt & 1) * BUFB; LAS unsigned char* nxt = lds + ((jt + 1) & 1) * BUFB;
        if (jt + 1 < nt && !(abl & 1)) tile_dma(Kg + (size_t)(jt + 1) * 64 * 512, Vg + (size_t)(jt + 1) * 64 * 512, nxt, wid, lane);
        if (jt <= wlast && !(abl & 2)) {
#pragma unroll 1
            for (int kb = 0; kb < 2; ++kb) { const int kr0 = 64 * jt + 32 * kb;
                if (kr0 <= qrow0 + 31) {
                    const LAS unsigned char* kbase = cur + (8 * kb + (r32 >> 2)) * G4 + j4 * 256;
                    const bool interior = (kr0 >= 64) && (kr0 + 31 + 113 <= qrow0);
                    bf16x8 p1a, p1b, p2a, p2b;
                    const float c0 = interior ? lut[127] : 0.f;
                    f32x16 s1, s2;
#pragma unroll
                    for (int r = 0; r < 16; ++r) { s1[r] = c0; s2[r] = c0; }
#pragma unroll
                    for (int s = 0; s < 4; ++s) { const unsigned x = xch(2 * s + hi, j4); const bf16x8 kf = *(const LAS bf16x8*)(kbase + x); const bf16x8 qf = *(const LAS bf16x8*)(qb_ + x); s1 = MFMA32(kf, qf, s1); }
#pragma unroll
                    for (int s = 0; s < 4; ++s) { const unsigned x = xch(8 + 2 * s + hi, j4); const bf16x8 kf = *(const LAS bf16x8*)(kbase + x); const bf16x8 qf = *(const LAS bf16x8*)(qb_ + x); s2 = MFMA32(kf, qf, s2); }
                    exp_block(s1, lut, interior, kr0, qrow, hi, l1); p1a = pack8(s1, 0); p1b = pack8(s1, 1);
                    exp_block(s2, lut, interior, kr0, qrow, hi, l2); p2a = pack8(s2, 0); p2b = pack8(s2, 1);
                    const LAS unsigned char* vb = cur + TILEB + kb * (8 * G4);
#pragma unroll
                    for (int dt = 0; dt < 4; ++dt) { const bf16x8 v0 = vfrag(vb, lane, 0, 0, dt), v1 = vfrag(vb, lane, 0, 1, dt);
                        o1[dt] = MFMA32(v0, p1a, o1[dt]); o2[dt] = MFMA32(v0, p2a, o2[dt]); o1[dt] = MFMA32(v1, p1b, o1[dt]); o2[dt] = MFMA32(v1, p2b, o2[dt]); }
                } }
        }
        DMA_WAIT(); __syncthreads();
    }
    l1 += __shfl_xor(l1, 32); l2 += __shfl_xor(l2, 32);
    const float c1 = 1.0f / l1, c2 = lam / l2;
    float sq = 0.f;
#pragma unroll
    for (int dt = 0; dt < 4; ++dt)
#pragma unroll
        for (int r = 0; r < 16; ++r) { o1[dt][r] = o1[dt][r] * c1 - o2[dt][r] * c2; sq += o1[dt][r] * o1[dt][r]; }
    sq += __shfl_xor(sq, 32);
    const float rs = SUBLN_SCALE / sqrtf(sq * (1.0f / 128.0f) + EPS);
    store_rows_via_lds(o1, rs, a->in[15], lds + wid * (32 * TROW), (bf16*)a->out + (gq - r32) * 1024 + head * 128, lane);
    __syncthreads();
}

__device__ __forceinline__ void attnB_unit(const Frame& F, CArgsP a, int b, int head, int qb8, int abl) {
    unsigned char* ws = a->ws; const int tid = F.tid, lane = F.lane, wid = F.wave, r32 = lane & 31, hi = lane >> 5;
    LAS unsigned char* lds = F.lds; LAS float* lut = (LAS float*)(lds + LDS_LUT);
    const int qrow0 = 64 + 256 * qb8 + 32 * wid, qrow = qrow0 + r32;
    const size_t gq = (size_t)b * SEQ + 256 * qb8 + 32 * wid + r32;
    const bf16* Kg = (const bf16*)(ws + WS_KK) + (size_t)b * KROWS * 512 + head * 128;
    const bf16* Vg = (const bf16*)(ws + WS_VV) + (size_t)b * KROWS * 512 + head * 128;
    const unsigned* selp = (const unsigned*)(ws + WS_SEL) + gq * SELW;
    const int nt = 4 * qb8 + 5, wlast = (qrow0 + 31) >> 6;
    tile_dma(Kg, Vg, lds, wid, lane);
    build_lut(lut, a->in[2], 4 + head, tid);
    const int j4 = r32 & 3;
    bf16x8 qf[8];
    { const bf16* qp = (const bf16*)(ws + WS_QB) + gq * 512 + head * 128 + 8 * hi;
#pragma unroll
      for (int s = 0; s < 8; ++s) qf[s] = *(const bf16x8*)(qp + 16 * s); }
    float ysq = 0.f;
    if (!(abl & 128)) {
        { const unsigned char* wg = ws + WS_WUKT + (size_t)head * 256 * 256 + (size_t)(32 * wid) * 256;
          const unsigned mb = (unsigned)__builtin_amdgcn_readfirstlane((int)(unsigned)(uintptr_t)(lds + LDS_AQ + 8 * wid * G4)); const unsigned vo = piece_src(lane, 256u);
#pragma unroll
          for (int i = 0; i < 8; ++i) dma_piece(wg + i * 4 * 256, vo, mb + i * G4); }
        DMA_WAIT(); __syncthreads();
        const LAS unsigned char* wb = lds + LDS_AQ + (r32 >> 2) * G4 + j4 * 256;
#pragma unroll 2
        for (int ct = 0; ct < 8; ++ct) { f32x16 y = (f32x16){};
#pragma unroll
            for (int s = 0; s < 8; ++s) { const bf16x8 wf = *(const LAS bf16x8*)(wb + ct * (8 * G4) + xch(2 * s + hi, j4)); y = MFMA32(wf, qf[s], y); }
#pragma unroll
            for (int r = 0; r < 16; ++r) ysq += y[r] * y[r]; }
    }
    ysq += __shfl_xor(ysq, 32);
    const float scq = B_QSCALE / sqrtf(ysq * (1.0f / 256.0f) + EPS);
    float l = 0.f;
    f32x16 o[4];
#pragma unroll
    for (int dt = 0; dt < 4; ++dt) o[dt] = (f32x16){};
    u32x2 mw = *(const u32x2*)(selp), mwn = mw;
    DMA_WAIT(); __syncthreads();
#pragma unroll 1
    for (int jt = 0; jt < nt; ++jt) {
        LAS unsigned char* cur = lds + (jt & 1) * BUFB; LAS unsigned char* nxt = lds + ((jt + 1) & 1) * BUFB;
        if (jt + 1 < nt) { if (!(abl & 1)) tile_dma(Kg + (size_t)(jt + 1) * 64 * 512, Vg + (size_t)(jt + 1) * 64 * 512, nxt, wid, lane); mwn = *(const u32x2*)(selp + 2 * (jt + 1)); }
        if (wid >= 4 && 64 * jt + 63 + 113 <= qrow0 && !(abl & 2)) {
            const LAS unsigned char* kb0 = cur + (r32 >> 2) * G4 + j4 * 256; const float bf = lut[127];
            f32x16 sa = (f32x16){}, sb = (f32x16){};
#pragma unroll
            for (int s = 0; s < 8; ++s) { const bf16x8 kf = *(const LAS bf16x8*)(kb0 + xch(2 * s + hi, j4)); sa = MFMA32(kf, qf[s], sa); }
#pragma unroll
            for (int s = 0; s < 8; ++s) { const bf16x8 kf = *(const LAS bf16x8*)(kb0 + 8 * G4 + xch(2 * s + hi, j4)); sb = MFMA32(kf, qf[s], sb); }
            const int mha = (int)(mw.x >> (4 * hi)), mhb = (int)(mw.y >> (4 * hi));
#pragma unroll
            for (int r = 0; r < 16; ++r) { const float e = __builtin_amdgcn_exp2f(sa[r] * scq + bf); sa[r] = __uint_as_float(__float_as_uint(e) & (unsigned)__builtin_amdgcn_sbfe(mha, (r & 3) + 8 * (r >> 2), 1)); l += sa[r]; }
            { const bf16x8 pa0 = pack8(sa, 0), pa1 = pack8(sa, 1); const LAS unsigned char* vb = cur + TILEB;
#pragma unroll
              for (int dt = 0; dt < 4; ++dt) { const bf16x8 v0 = vfrag(vb, lane, 0, 0, dt), v1 = vfrag(vb, lane, 0, 1, dt); o[dt] = MFMA32(v0, pa0, o[dt]); o[dt] = MFMA32(v1, pa1, o[dt]); } }
#pragma unroll
            for (int r = 0; r < 16; ++r) { const float e = __builtin_amdgcn_exp2f(sb[r] * scq + bf); sb[r] = __uint_as_float(__float_as_uint(e) & (unsigned)__builtin_amdgcn_sbfe(mhb, (r & 3) + 8 * (r >> 2), 1)); l += sb[r]; }
            { const bf16x8 pa0 = pack8(sb, 0), pa1 = pack8(sb, 1); const LAS unsigned char* vb = cur + TILEB + 8 * G4;
#pragma unroll
              for (int dt = 0; dt < 4; ++dt) { const bf16x8 v0 = vfrag(vb, lane, 0, 0, dt), v1 = vfrag(vb, lane, 0, 1, dt); o[dt] = MFMA32(v0, pa0, o[dt]); o[dt] = MFMA32(v1, pa1, o[dt]); } }
        } else
        if (jt <= wlast && !(abl & 2)) {
#pragma unroll
            for (int kb = 0; kb < 2; ++kb) { const int kr0 = 64 * jt + 32 * kb;
                if (kr0 <= qrow0 + 31) {
                    const LAS unsigned char* kbase = cur + (8 * kb + (r32 >> 2)) * G4 + j4 * 256;
                    f32x16 s1 = (f32x16){};
#pragma unroll
                    for (int s = 0; s < 8; ++s) { const bf16x8 kf = *(const LAS bf16x8*)(kbase + xch(2 * s + hi, j4)); s1 = MFMA32(kf, qf[s], s1); }
                    const int mh = (int)((kb ? mw.y : mw.x) >> (4 * hi));
                    const bool interior = (kr0 + 31 + 113 <= qrow0);
                    if (interior) { const float bf = lut[127];
#pragma unroll
                        for (int r = 0; r < 16; ++r) { const float e = __builtin_amdgcn_exp2f(s1[r] * scq + bf); s1[r] = __uint_as_float(__float_as_uint(e) & (unsigned)__builtin_amdgcn_sbfe(mh, (r & 3) + 8 * (r >> 2), 1)); } }
                    else {
#pragma unroll
                        for (int r = 0; r < 16; ++r) { const int kr = kr0 + crow(r, hi), n = qrow - kr; const int idx = n < 0 ? 0 : (n > 127 ? 127 : n);
                            const float e = __builtin_amdgcn_exp2f(s1[r] * scq + lut[idx]); s1[r] = __uint_as_float(__float_as_uint(e) & (unsigned)__builtin_amdgcn_sbfe(mh, (r & 3) + 8 * (r >> 2), 1)); } }
#pragma unroll
                    for (int r = 0; r < 16; ++r) l += s1[r];
                    const bf16x8 pa0 = pack8(s1, 0), pa1 = pack8(s1, 1);
                    const LAS unsigned char* vb = cur + TILEB + kb * (8 * G4);
#pragma unroll
                    for (int dt = 0; dt < 4; ++dt) { const bf16x8 v0 = vfrag(vb, lane, 0, 0, dt), v1 = vfrag(vb, lane, 0, 1, dt);
                        o[dt] = MFMA32(v0, pa0, o[dt]); o[dt] = MFMA32(v1, pa1, o[dt]); }
                } }
        }
        mw = mwn;
        DMA_WAIT(); __syncthreads();
    }
    l += __shfl_xor(l, 32);
    const float il = 1.0f / l;
    if (!(abl & 256)) store_rows_via_lds(o, il, nullptr, lds + wid * (32 * TROW), (bf16*)a->out + (gq - r32) * 1024 + 512 + head * 128, lane);
    __syncthreads();
}
__device__ __forceinline__ unsigned lanes_below(unsigned long long m) { return __builtin_amdgcn_mbcnt_hi((unsigned)(m >> 32), __builtin_amdgcn_mbcnt_lo((unsigned)m, 0u)); }
#define DPP_STEP(OP, v, ctrl, rmask, ident) { const int t_ = __builtin_amdgcn_update_dpp((int)(ident), (int)(v), (ctrl), (rmask), 0xf, false); v = OP(v, (decltype(v))t_); }
__device__ __forceinline__ unsigned umax2(unsigned a, unsigned b) { return a > b ? a : b; }
__device__ __forceinline__ unsigned umin2(unsigned a, unsigned b) { return a < b ? a : b; }
__device__ __forceinline__ int iadd2(int a, int b) { return a + b; }
__device__ __forceinline__ unsigned wave_umax(unsigned v) { DPP_STEP(umax2, v, 0x111, 0xf, 0u) DPP_STEP(umax2, v, 0x112, 0xf, 0u) DPP_STEP(umax2, v, 0x114, 0xf, 0u) DPP_STEP(umax2, v, 0x118, 0xf, 0u) DPP_STEP(umax2, v, 0x142, 0xa, 0u) DPP_STEP(umax2, v, 0x143, 0xc, 0u)
    return (unsigned)__builtin_amdgcn_readlane((int)v, 63); }
__device__ __forceinline__ unsigned wave_umin(unsigned v) { DPP_STEP(umin2, v, 0x111, 0xf, 0xffffffffu) DPP_STEP(umin2, v, 0x112, 0xf, 0xffffffffu) DPP_STEP(umin2, v, 0x114, 0xf, 0xffffffffu) DPP_STEP(umin2, v, 0x118, 0xf, 0xffffffffu) DPP_STEP(umin2, v, 0x142, 0xa, 0xffffffffu) DPP_STEP(umin2, v, 0x143, 0xc, 0xffffffffu)
    return (unsigned)__builtin_amdgcn_readlane((int)v, 63); }
__device__ __forceinline__ int wave_isum(int v) { DPP_STEP(iadd2, v, 0x111, 0xf, 0) DPP_STEP(iadd2, v, 0x112, 0xf, 0) DPP_STEP(iadd2, v, 0x114, 0xf, 0) DPP_STEP(iadd2, v, 0x118, 0xf, 0) DPP_STEP(iadd2, v, 0x142, 0xa, 0) DPP_STEP(iadd2, v, 0x143, 0xc, 0)
    return __builtin_amdgcn_readlane(v, 63); }
#define WRITELANE(src, l, old) do { const int s__ = __builtin_amdgcn_readfirstlane(src); asm volatile("s_nop 3\n\tv_writelane_b32 %0, %1, %2" : "+v"(old) : "s"(s__), "n"(l)); } while (0)
template <int NI> __device__ __forceinline__ void select8(unsigned char* ws, const float* sc, int b, int q0, int wid, int lane, int abl) {
    unsigned raw[NI];
    { const unsigned* srow = (const unsigned*)(sc + (size_t)(8 * wid) * SCP);
#pragma unroll
      for (int i = 0; i < NI; ++i) raw[i] = __hip_atomic_load(srow + 64 * i + lane, __ATOMIC_RELAXED, __HIP_MEMORY_SCOPE_AGENT); }
#pragma unroll 1
    for (int qq = 0; qq < 8; ++qq) { const int ql = 8 * wid + qq, t = q0 + ql, qrow = 64 + t, nvalid = t + 17;
        unsigned w[NI];
#pragma unroll
        for (int i = 0; i < NI; ++i) { const int kr = 64 * i + lane; w[i] = ((kr >= 48) && (kr <= qrow)) ? raw[i] : 0u; }
        if (qq < 7 && !(abl & 64)) { const unsigned* srow = (const unsigned*)(sc + (size_t)(ql + 1) * SCP);
#pragma unroll
            for (int i = 0; i < NI; ++i) raw[i] = __hip_atomic_load(srow + 64 * i + lane, __ATOMIC_RELAXED, __HIP_MEMORY_SCOPE_AGENT); }
        unsigned thr = 0u; int quota = 0;
        if (nvalid > 256 && !(abl & 16)) {
            unsigned mn = 0x7fffffffu, mx = 0u;
#pragma unroll
            for (int i = 0; i < NI; ++i) { mx = w[i] > mx ? w[i] : mx; const unsigned v = w[i] ? w[i] : 0x7fffffffu; mn = v < mn ? v : mn; }
            mx = wave_umax(mx); mn = wave_umin(mn);
            unsigned lo = mn, hi = mx + 1u; int chi = 0; bool exact = false;
#pragma unroll 1
            while (hi - lo > 1u) { const unsigned cand = lo + ((hi - lo) >> 1);
                unsigned acc0 = 0u, acc1 = 0u;
#pragma unroll
                for (int i = 0; i < NI; ++i) { const unsigned d = w[i] - cand; if (i & 1) acc1 = __builtin_amdgcn_alignbit(acc1, d, 31); else acc0 = __builtin_amdgcn_alignbit(acc0, d, 31); }
                const int lt = wave_isum(__popc(acc0) + __popc(acc1));
                const int cnt = 64 * NI - lt;
                if (cnt == 256) { lo = cand; exact = true; break; }
                if (cnt > 256) lo = cand; else { hi = cand; chi = cnt; } }
            if (exact) { thr = lo - 1u; quota = 0; } else { thr = lo; quota = 256 - chi; }
        }
        int wlo = 0, whi = 0;
        if (!(abl & 32)) {
            if (quota == 0) {
#pragma unroll
                for (int i = 0; i < NI; ++i) { const unsigned long long bs = __ballot(w[i] > thr);
                    WRITELANE((int)(unsigned)bs, i, wlo); WRITELANE((int)(unsigned)(bs >> 32), i, whi); } }
            else { int tiebase = 0;
#pragma unroll
                for (int i = 0; i < NI; ++i) { const bool gt = w[i] > thr, eq = (w[i] == thr);
                    const unsigned long long be = __ballot(eq); const int rank = tiebase + (int)lanes_below(be);
                    const unsigned long long bs = __ballot(gt || (eq && rank < quota));
                    WRITELANE((int)(unsigned)bs, i, wlo); WRITELANE((int)(unsigned)(bs >> 32), i, whi);
                    tiebase += __popcll(be); } } }
        if (lane < 33) { u32x2 w2; w2.x = (unsigned)wlo; w2.y = (unsigned)whi; *(u32x2*)((unsigned*)(ws + WS_SEL) + ((size_t)b * SEQ + t) * SELW + 2 * lane) = w2; }
    }
}
__device__ __forceinline__ void index_unit(const Frame& F, CArgsP a, int b, int j64, int abl) {
    unsigned char* ws = a->ws; const int lane = F.lane, wid = F.wave, r32 = lane & 31, hi = lane >> 5;
    float* sc = (float*)(ws + WS_SCR) + (size_t)blockIdx.x * 64 * SCP;
    const int q0 = 64 * j64;
    {
        const bf16* ip = (const bf16*)(ws + WS_IQ) + ((size_t)b * SEQ + q0) * 512;
#pragma unroll
        for (int i = 0; i < 8; ++i) { const int c = F.tid + 512 * i, row = c >> 6, ch = c & 63; *(LAS u32x4*)(F.lds + 1040 * row + 16 * ch) = *(const u32x4*)(ip + (size_t)row * 512 + ch * 8); }
    }
    __syncthreads();
    if (!(abl & 4)) {
        const int qi = wid & 1, kbq = wid >> 1, qrow0 = 64 + q0 + 32 * qi; const size_t gq = (size_t)b * SEQ + q0 + 32 * qi + r32;
        float wv[8];
        { const f32x4 w0 = *(const f32x4*)((const float*)(ws + WS_IW) + gq * 8), w1 = *(const f32x4*)((const float*)(ws + WS_IW) + gq * 8 + 4);
          wv[0] = w0[0]; wv[1] = w0[1]; wv[2] = w0[2]; wv[3] = w0[3]; wv[4] = w1[0]; wv[5] = w1[1]; wv[6] = w1[2]; wv[7] = w1[3]; }
        const LAS unsigned char* iql = F.lds + 1040 * (32 * qi + r32) + 16 * hi;
        const int ng = (q0 + 128 + 127) >> 7;
        const bf16* ikb = (const bf16*)(ws + WS_IK) + (size_t)b * KROWS * 64 + (size_t)r32 * 64 + 8 * hi;
        LAS unsigned char* stg = F.lds + 66560 + wid * 4608;
        bf16x8 ikn[4];
#pragma unroll
        for (int s = 0; s < 4; ++s) ikn[s] = *(const bf16x8*)(ikb + (size_t)(32 * kbq) * 64 + 16 * s);
#pragma unroll 1
        for (int g = 0; g < ng; ++g) { const int kr0 = 128 * g + 32 * kbq;
            if (kr0 > qrow0 + 31) break;
            asm volatile("" ::: "memory");
            bf16x8 ikf[4];
#pragma unroll
            for (int s = 0; s < 4; ++s) ikf[s] = ikn[s];
            { const int krn = kr0 + 128 <= KROWS - 32 ? kr0 + 128 : kr0;
#pragma unroll
              for (int s = 0; s < 4; ++s) ikn[s] = *(const bf16x8*)(ikb + (size_t)krn * 64 + 16 * s); }
            f32x16 score = (f32x16){};
#pragma unroll
            for (int h = 0; h < 8; ++h) { f32x16 acc = (f32x16){};
#pragma unroll
                for (int s = 0; s < 4; ++s) { const bf16x8 qf = *(const LAS bf16x8*)(iql + 128 * h + 32 * s); acc = MFMA32(ikf[s], qf, acc); }
#pragma unroll
                for (int r = 0; r < 16; ++r) score[r] += wv[h] * fmaxf(acc[r], 0.f);
                if (h & 1) __builtin_amdgcn_sched_barrier(0); }
#pragma unroll
            for (int g4 = 0; g4 < 4; ++g4) { u32x4 kv;
#pragma unroll
                for (int e = 0; e < 4; ++e) { unsigned bits = __float_as_uint(score[4 * g4 + e]); if (bits == 0x80000000u) bits = 0u; kv[e] = ((bits & 0x80000000u) ? ~bits : (bits | 0x80000000u)) >> 1; }
                *(LAS u32x4*)(stg + r32 * 144 + 32 * g4 + 16 * hi) = kv; }
            LDS_WAIT();
#pragma unroll
            for (int i = 0; i < 4; ++i) { const int row = 8 * i + (lane >> 3), ch = lane & 7; const u32x4 v = *(const LAS u32x4*)(stg + row * 144 + 16 * ch);
                *(u32x4*)(sc + (size_t)(32 * qi + row) * SCP + kr0 + 4 * ch) = v; }
            LDS_WAIT();
        }
    }
    VM_WAIT(); __syncthreads();
    if (!(abl & 8)) { const int ni = ((64 + q0 + 8 * wid + 7) >> 6) + 1;
      switch ((ni - 2) >> 2) {
        case 0: select8<5>(ws, sc, b, q0, wid, lane, abl); break;
        case 1: select8<9>(ws, sc, b, q0, wid, lane, abl); break;
        case 2: select8<13>(ws, sc, b, q0, wid, lane, abl); break;
        case 3: select8<17>(ws, sc, b, q0, wid, lane, abl); break;
        case 4: select8<21>(ws, sc, b, q0, wid, lane, abl); break;
        case 5: select8<25>(ws, sc, b, q0, wid, lane, abl); break;
        case 6: select8<29>(ws, sc, b, q0, wid, lane, abl); break;
        default: select8<33>(ws, sc, b, q0, wid, lane, abl); break;
      } }
    __syncthreads();
}

struct KvOrder : pg8::StaticOrder { __host__ __device__ int arow(int pm) const { return (pm >> 3) * KROWS + 64 + (pm & 7) * 256; } };
struct AblOrder : pg8::StaticOrder { int abl;
    __device__ bool next(int i, pg8::Unit& u) const { const bool r = pg8::StaticOrder::next(i, u); if (abl & 2) u.pm = 0; if (abl & 4) u.pn = 0; return r; } };
#ifndef PH
#define PH 0xFFFF
#endif
#ifndef DUP
#define DUP 0
#endif
#ifndef TIMING_KNOBS
#define TIMING_KNOBS 0
#endif
#if TIMING_KNOBS
#define PHASE(bit) _Pragma("unroll 1") for (int rep_ = 0, nrep_ = ((PH & (bit)) ? 1 + ((get_args()->dup & (bit)) ? 1 : 0) : 0); rep_ < nrep_; ++rep_)
#define ABL() ((nrep_ == 2 && rep_ == 0) ? (get_args()->dup >> 16) : 0)
#else
#define PHASE(bit) if (PH & (bit))
#define ABL() 0
#endif
#ifndef USE_XCD
#define USE_XCD 1
#endif
#if USE_XCD
#define GRID_SYNC() xcd_barrier(xbar)
#else
#define GRID_SYNC() grid.sync()
#endif
__global__ void __launch_bounds__(512, 2) fwd_megakernel(Args args_by_value) {
    extern __shared__ __attribute__((aligned(16))) unsigned char lds_raw[];
#if !USE_XCD
    cg::grid_group grid = cg::this_grid();
#endif
    LAS unsigned char* const lds0 = (LAS unsigned char*)lds_raw;
    const int wave_s = __builtin_amdgcn_readfirstlane((int)(threadIdx.x >> 6));
#if USE_XCD
    if (threadIdx.x < 4) ((LAS unsigned*)(lds0 + LDS_MISC))[threadIdx.x] = 0u;
    __syncthreads();
    XcdBarrier xbar = xcd_barrier_post((unsigned*)(get_args()->ws + WS_CTL), (volatile LAS unsigned*)(lds0 + LDS_MISC)); xbar.w = wave_s;
#endif
#define PHASE_VARS const Frame F = make_frame(lds0, wave_s); CArgsP a = get_args(); unsigned char* ws = a->ws; float* out = a->out; pg8::bf16_t* HB = (pg8::bf16_t*)(ws + WS_HB); pg8::bf16_t* ACT = (pg8::bf16_t*)(ws + WS_ACT); float* SSB = (float*)(ws + WS_SS); \
    PG8_LAS unsigned char* ring = (PG8_LAS unsigned char*)F.lds; (void)out; (void)HB; (void)ACT; (void)SSB; (void)ring
    PHASE(1) { PHASE_VARS; p0_prologue(F, a); }
    GRID_SYNC();
    PHASE(2) { PHASE_VARS; meta_p1(F, a);
      pg8::Gemm g{HB, (const pg8::bf16_t*)(ws + WS_WGU1), MX, NGU, DM}; AblOrder S; S.init(MX, NGU, F.G, (int)blockIdx.x); S.abl = ABL(); pg8::EpiGU<F8_D1> E{(unsigned char*)ACT, SSB, ABL(), 1.0f};
      pg8::gemm_phase<pg8::EpiGU<F8_D1>, AblOrder, true, true>(ring, g, S, E, wave_s); }
    GRID_SYNC();
    PHASE(4) { PHASE_VARS; meta_p2(F, a);
      pg8::Gemm g{ACT, (const pg8::bf16_t*)(ws + WS_WD1), MX, DM, F8_D1 ? FF / 2 : FF}; pg8::StaticOrder S; S.init(MX, DM, F.G, (int)blockIdx.x); pg8::EpiResB<false, true> E{HB, HB, nullptr, SSB, F8_D1 ? 0.5f / (ACT_SCALE * WD_SCALE) : 0.5f};
      pg8::gemm_phase<pg8::EpiResB<false, true>, pg8::StaticOrder, true, true, F8_D1>(ring, g, S, E, wave_s); }
    GRID_SYNC();
    PHASE(8) { PHASE_VARS; meta_p3(F, a);
      pg8::Gemm g{HB, (const pg8::bf16_t*)(ws + WS_WIN), MX, NINP, DM}; pg8::StaticOrder S; S.init(MX, NINP, F.G, (int)blockIdx.x);
      pg8::EpiIn E{(pg8::bf16_t*)(ws + WS_QA), (pg8::bf16_t*)(ws + WS_KA), (pg8::bf16_t*)(ws + WS_VA), (pg8::bf16_t*)(ws + WS_QB), (pg8::bf16_t*)(ws + WS_C), (pg8::bf16_t*)(ws + WS_IQ), (pg8::bf16_t*)(ws + WS_IK),
                   (float*)(ws + WS_IW), SSB, a->in[9], a->in[10], a->in[16], (PG8_LAS float*)(F.lds + LDS_XCH)};
      pg8::gemm_phase<pg8::EpiIn, pg8::StaticOrder, true, true>(ring, g, S, E, wave_s); }
    GRID_SYNC();
    PHASE(16) { PHASE_VARS; meta_p4(F, a);
      int kkv = 256; asm volatile("" : "+s"(kkv)); pg8::Gemm g{(const pg8::bf16_t*)(ws + WS_C), (const pg8::bf16_t*)(ws + WS_WKV), MX, 1024, kkv}; KvOrder S; S.init(MX, 1024, F.G, (int)blockIdx.x);
      pg8::EpiKV E{(pg8::bf16_t*)(ws + WS_KK), (pg8::bf16_t*)(ws + WS_VV)};
      pg8::gemm_phase<pg8::EpiKV, KvOrder, true, true>(ring, g, S, E, wave_s); }
    __syncthreads();
    PHASE(32) { _Pragma("unroll 1") for (int k = 0; k < 2; ++k) { const Frame F = make_frame(lds0, wave_s); CArgsP a = get_args(); const int b = F.vcu >> 4, s = F.vcu & 15; index_unit(F, a, b, k ? 31 - s : s, ABL()); } }
    PHASE(64) { float lam; { const int ln = pg8::lane_id(); CArgsP a = get_args(); const float d1 = wave_sum(a->in[11][ln] * a->in[12][ln]), d2 = wave_sum(a->in[13][ln] * a->in[14][ln]);
        lam = __uint_as_float((unsigned)__builtin_amdgcn_readfirstlane((int)__float_as_uint(__expf(d1) - __expf(d2) + LAM_INIT))); }
      _Pragma("unroll 1") for (int k = 0; k < 2; ++k) { const Frame F = make_frame(lds0, wave_s); CArgsP a = get_args(); const int bh = F.vcu >> 2, s = F.vcu & 3; attnA_unit(F, a, bh >> 2, bh & 3, k ? 7 - s : s, lam, ABL()); } }
    GRID_SYNC();
    PHASE(128) { _Pragma("unroll 1") for (int k = 0; k < 2; ++k) { const Frame F = make_frame(lds0, wave_s); CArgsP a = get_args(); const int bh = F.vcu >> 2, s = F.vcu & 3; attnB_unit(F, a, bh >> 2, bh & 3, k ? 7 - s : s, ABL()); } }
    GRID_SYNC();
    PHASE(256) { PHASE_VARS; pg8::Gemm g{(const pg8::bf16_t*)out, (const pg8::bf16_t*)(ws + WS_WOUT), MX, DM, DM}; pg8::StaticOrder S; S.init(MX, DM, F.G, (int)blockIdx.x); pg8::EpiResB<false, true, F8_G2> E{HB, (pg8::bf16_t*)(ws + WS_H2B), nullptr, SSB, 1.0f};
      pg8::gemm_phase<pg8::EpiResB<false, true, F8_G2>, pg8::StaticOrder, true, true>(ring, g, S, E, wave_s); }
    GRID_SYNC();
    PHASE(512) { PHASE_VARS; pg8::Gemm g{(const pg8::bf16_t*)(ws + (F8_G2 ? WS_H2Q : WS_H2B)), (const pg8::bf16_t*)(ws + WS_WGU2), MX, NGU, F8_G2 ? DM / 2 : DM}; pg8::StaticOrder S; S.init(MX, NGU, F.G, (int)blockIdx.x);
      pg8::EpiGU<F8_D2> E{(unsigned char*)ACT, SSB, ABL(), F8_G2 ? 1.0f / (H_SCALE * GU_SCALE) : 1.0f};
      pg8::gemm_phase<pg8::EpiGU<F8_D2>, pg8::StaticOrder, true, true, F8_G2>(ring, g, S, E, wave_s); }
    GRID_SYNC();
    PHASE(1024) { PHASE_VARS; pg8::Gemm g{ACT, (const pg8::bf16_t*)(ws + WS_WD2), MX, DM, F8_D2 ? FF / 2 : FF}; pg8::StaticOrder S; S.init(MX, DM, F.G, (int)blockIdx.x); pg8::EpiResB<true, false> E{(const pg8::bf16_t*)(ws + WS_H2B), nullptr, out, nullptr, F8_D2 ? 0.5f / (ACT_SCALE * WD_SCALE) : 0.5f};
      pg8::gemm_phase<pg8::EpiResB<true, false>, pg8::StaticOrder, true, true, F8_D2>(ring, g, S, E, wave_s); }
}

extern "C" void kernel_launch(void* const* d_in, const int* in_sizes, int n_in, void* d_out, int out_size, void* d_ws, size_t ws_size, hipStream_t stream) {
    static int grid = 0;
    if (grid == 0) {
        if (n_in != 25 || out_size != MX * DM || ws_size < WS_END) { fprintf(stderr, "kernel_launch: unexpected shapes (n_in %d out %d ws %zu)\n", n_in, out_size, ws_size); grid = -1; return; }
        int dev = 0, cus = 0, per_cu = 0;
        if (hipGetDevice(&dev) != hipSuccess || hipDeviceGetAttribute(&cus, hipDeviceAttributeMultiprocessorCount, dev) != hipSuccess) { grid = -1; return; }
        if (hipFuncSetAttribute((const void*)fwd_megakernel, hipFuncAttributeMaxDynamicSharedMemorySize, LDS_BYTES) != hipSuccess) { fprintf(stderr, "kernel_launch: hipFuncSetAttribute failed\n"); grid = -1; return; }
        if (hipOccupancyMaxActiveBlocksPerMultiprocessor(&per_cu, (const void*)fwd_megakernel, 512, LDS_BYTES) != hipSuccess || per_cu < 1) { fprintf(stderr, "kernel_launch: occupancy query says %d blocks per CU\n", per_cu); (void)hipGetLastError(); grid = -1; return; }
        grid = cus;
        if (grid != 256) fprintf(stderr, "kernel_launch: note: %d CUs\n", grid);
    }
    if (grid < 0) return;
    (void)hipMemsetAsync((char*)d_ws + WS_CTL, 0, 16384, stream);
    Args a{};
    for (int i = 0; i < 25; ++i) a.in[i] = (const float*)d_in[i];
    a.out = (float*)d_out; a.ws = (unsigned char*)d_ws; a.dup = DUP; a.pad = 0;
    void* args[] = {&a};
#ifndef PLAIN_LAUNCH
#define PLAIN_LAUNCH 0
#endif
#if PLAIN_LAUNCH
    (void)args; hipLaunchKernelGGL(fwd_megakernel, dim3(grid), dim3(512), LDS_BYTES, stream, a); hipError_t e = hipPeekAtLastError();
#else
    hipError_t e = hipLaunchCooperativeKernel((const void*)fwd_megakernel, dim3(grid), dim3(512), args, LDS_BYTES, stream);
#endif
    if (e != hipSuccess) fprintf(stderr, "kernel_launch: cooperative launch failed: %s\n", hipGetErrorString(e));
}
```

```cpp
#include <hip/hip_runtime.h>
#include <hip/hip_cooperative_groups.h>
#include <cstdio>
#include <cstdint>
namespace cg = cooperative_groups;

#define LAS __attribute__((address_space(3)))
typedef unsigned short bf16;
typedef short bf16x8 __attribute__((ext_vector_type(8)));
typedef short s16x4 __attribute__((ext_vector_type(4)));
typedef float f32x4 __attribute__((ext_vector_type(4)));
typedef float f32x16 __attribute__((ext_vector_type(16)));
typedef unsigned u32x4 __attribute__((ext_vector_type(4)));
typedef unsigned u32x2 __attribute__((ext_vector_type(2)));
typedef float f32x2_t __attribute__((ext_vector_type(2)));
typedef __bf16 bf16x2_t __attribute__((ext_vector_type(2)));

constexpr int DM = 1024, NB = 16, SEQ = 2048, MX = NB * SEQ, FF = 2816, NGU = 2 * FF, NINP = 3072, NIN = 2888;
#ifndef F8_D1
#define F8_D1 0
#endif
#ifndef F8_D2
#define F8_D2 1
#endif
#ifndef F8_G2
#define F8_G2 1
#endif
constexpr float H_SCALE = 16.0f, GU_SCALE = 1024.0f;
constexpr float ACT_SCALE = 8.0f, WD_SCALE = 2048.0f;
constexpr int KROWS = 2112, MK = NB * KROWS;
constexpr int SELW = 68;
constexpr int SCP = 2112;
constexpr float EPS = 1e-6f, LOG2E = 1.4426950408889634f;
constexpr float A_QSCALE = 0.125f * LOG2E;
constexpr float B_QSCALE = 0.0625f * LOG2E;
constexpr float IW_SCALE = 0.35355339059327373f * 0.125f;
constexpr float SUBLN_SCALE = 0.8f;
constexpr float LAM_INIT = 0.2f;

constexpr size_t MiB = 1u << 20;
constexpr size_t WS_CTL = 0, CTL_BYTES = 1 * MiB;
constexpr size_t WS_WGU1 = 1 * MiB, WS_WD1 = 12 * MiB, WS_WIN = WS_WD1 + (size_t)DM * FF * 2, WS_WKV = WS_WIN + (size_t)NINP * DM * 2, WS_WUKT = WS_WKV + 512 * 1024,
                 WS_WOUT = WS_WUKT + 256 * 1024, WS_WGU2 = WS_WOUT + 2 * MiB, WS_WD2 = WS_WGU2 + 11 * MiB;
constexpr size_t WS_SS = 43 * MiB, WS_IW = 45 * MiB, WS_META = 46 * MiB, WS_SCR = 48 * MiB, WS_HB = 180 * MiB, WS_ACT = 244 * MiB;
constexpr size_t WS_QA = WS_ACT, WS_QB = WS_QA + 32 * MiB, WS_IQ = WS_QB + 32 * MiB, WS_KA = WS_IQ + 32 * MiB, WS_VA = WS_KA + 33 * MiB, WS_SEL = WS_VA + 33 * MiB;
constexpr size_t WS_C = 420 * MiB, WS_IK = WS_C + (size_t)MK * 256 * 2, WS_KK = 441 * MiB, WS_VV = 474 * MiB, WS_H2B = 420 * MiB, WS_H2Q = WS_SCR  , WS_END = 512 * MiB;
static_assert(WS_WD2 + (size_t)DM * FF * 2 <= WS_SS, "weights");
static_assert(WS_SCR + (size_t)256 * 64 * SCP * 4 <= WS_HB, "scratch");
static_assert(WS_SEL + (size_t)MX * SELW * 4 <= WS_C && WS_IK + (size_t)MK * 64 * 2 <= WS_KK && WS_VV + (size_t)MK * 512 * 2 <= WS_END, "map");
constexpr size_t MO_HBM = 0, MO_SSM0 = 32 * 1024, MO_ACTM = 36 * 1024, MO_H1MB = 128 * 1024, MO_SSM1 = 160 * 1024;

constexpr int LDS_BYTES = 155648;
constexpr int LDS_XCH = 131072;
constexpr int LDS_LUT = 66560;
constexpr int LDS_QT = 103424;
constexpr int LDS_MISC = 150 * 1024;

static_assert(LDS_LUT + 512 <= 67072 && 67072 + 64 * 1040 <= LDS_MISC && 8 * 32 * 272 <= LDS_MISC && LDS_XCH + 4096 <= LDS_MISC && LDS_QT + 64 * 272 <= LDS_MISC && LDS_MISC + 64 <= LDS_BYTES && LDS_BYTES <= 160 * 1024, "LDS map");
#define LDS_WAIT() asm volatile("s_waitcnt lgkmcnt(0)" ::: "memory")
#define VM_WAIT() asm volatile("s_waitcnt vmcnt(0)" ::: "memory")
__device__ __forceinline__ unsigned pk2(float lo, float hi) { f32x2_t v = {lo, hi}; bf16x2_t b = __builtin_convertvector(v, bf16x2_t); return __builtin_bit_cast(unsigned, b); }
__device__ __forceinline__ float wave_sum(float v) {
#pragma unroll
    for (int o = 1; o < 64; o <<= 1) v += __shfl_xor(v, o);
    return v;
}
__device__ __forceinline__ float rsqrt_acc(float x) { return 1.0f / sqrtf(x); }
__device__ __forceinline__ int crow(int r, int hi) { return (r & 3) + 8 * (r >> 2) + 4 * hi; }
#define MFMA32(a, b, c) __builtin_amdgcn_mfma_f32_32x32x16_bf16((a), (b), (c), 0, 0, 0)
#define MFMA16(a, b, c) __builtin_amdgcn_mfma_f32_16x16x32_bf16((a), (b), (c), 0, 0, 0)
namespace pg8 {
#define PG8_LAS __attribute__((address_space(3)))
typedef unsigned short bf16_t;
typedef short bf16x8 __attribute__((ext_vector_type(8)));
typedef float f32x4 __attribute__((ext_vector_type(4)));
typedef unsigned u32x4 __attribute__((ext_vector_type(4)));
typedef int i32x8 __attribute__((ext_vector_type(8)));
__device__ __forceinline__ i32x8 cat8(bf16x8 a, bf16x8 b) { typedef short s16 __attribute__((ext_vector_type(16))); return __builtin_bit_cast(i32x8, __builtin_shufflevector(a, b, 0, 1, 2, 3, 4, 5, 6, 7, 8, 9, 10, 11, 12, 13, 14, 15)); }
constexpr int BM = 256, BK = 64, HALF = 128, HTB = HALF * BK * 2  , STAGE_BYTES = 8 * HTB, NXCD = 8, WGM = 8;

__host__ __device__ __forceinline__ int lds_byte(int r, int c) { const int st = (r >> 4) * 2 + (c >> 5), rr = r & 15, cc = c & 31, ob = rr * 64 + cc * 2; return st * 1024 + (ob ^ (((ob >> 9) & 1) << 5)); }
__host__ __device__ __forceinline__ void stage_rc(int b, int& R, int& C) { const int st = b / 1024, sb = b % 1024, swz = sb ^ (((sb >> 9) & 1) << 5); R = (st >> 1) * 16 + swz / 64; C = (st & 1) * 32 + (swz % 64) / 2; }
__host__ __device__ __forceinline__ int perm32(int rho) { const int n = rho >> 4, i = rho & 15; return 8 * (i >> 2) + 4 * n + (i & 3); }

__device__ __forceinline__ void mfma8(f32x4& c, const i32x8 a, const i32x8 b, int sc) {
    asm volatile("v_mfma_scale_f32_16x16x128_f8f6f4 %0, %1, %2, %0, %3, %3 op_sel_hi:[0,0,0]" : "+v"(c) : "v"(a), "v"(b), "v"(sc)); }
__device__ __forceinline__ int lane_id() { int l; asm volatile("v_mbcnt_lo_u32_b32 %0, -1, 0\n\tv_mbcnt_hi_u32_b32 %0, -1, %0" : "=v"(l)); return l; }
struct Unit { int pm, pn; };
struct Gemm { const bf16_t* A; const bf16_t* Bt; int M, N, K; };

struct StaticOrder {
    int nM, nN, nwg, G, c;
    __host__ __device__ void init(int M, int N, int G_, int c_) { nM = M / BM; nN = N / BM; nwg = nM * nN; G = G_; c = c_; }
    __host__ __device__ bool next(int i, Unit& u) const {
        const long L = (long)i * G + c; if (L >= nwg) return false;
        int wgid = (int)L; { const int q = nwg / NXCD, r = nwg % NXCD, xcd = wgid % NXCD, off = wgid / NXCD; wgid = (xcd < r ? xcd * (q + 1) : r * (q + 1) + (xcd - r) * q) + off; }
        const int nig = WGM * nN, gid = wgid / nig, fm = gid * WGM, gsz = (nM - fm) < WGM ? (nM - fm) : WGM;
        u.pm = fm + ((wgid % nig) % gsz); u.pn = (wgid % nig) / gsz; return true;
    }
    __host__ __device__ int arow(int pm) const { return pm * BM; }
    __device__ __forceinline__ void a_ready(const Unit&) const {}
    __device__ __forceinline__ void done(const Unit&) const {}
};
__device__ __forceinline__ unsigned cvt_pk_bf16(float lo, float hi) { unsigned r; asm volatile("v_cvt_pk_bf16_f32 %0, %1, %2" : "=v"(r) : "v"(lo), "v"(hi)); return r; }
template <class Epi, class Sched, bool ALIGN_EPI = false, bool SP2 = false, bool F8 = false>
__device__ __forceinline__ void gemm_phase(PG8_LAS unsigned char* lds, const Gemm g, const Sched& S, const Epi& E, int wave_s) {
    int tid_ = wave_s * 64 + lane_id(); asm volatile("" : "+v"(tid_));
    const int tid = tid_, wid = __builtin_amdgcn_readfirstlane(tid >> 6), lane = tid & 63, wr = wid >> 2, wc = wid & 3, fr = lane & 15, fq = lane >> 4;
    const int K = g.K, nt = K / BK;
    unsigned voffA[2], voffB[2];
#pragma unroll
    for (int i = 0; i < 2; ++i) { int R, C; stage_rc(tid * 16 + i * 8192, R, C); const int Rb = Epi::PERM ? ((R & ~31) + perm32(R & 31)) : R;
        voffA[i] = (unsigned)(R * K + C) * 2u; voffB[i] = (unsigned)(Rb * K + C) * 2u; }
    const size_t kstep = (size_t)(BK * 2);
    const size_t hstep = (size_t)HALF * K * 2;
    const size_t tstep = 2 * hstep;
    const unsigned ldsw = (unsigned)wid * 1024u;
    const int aoff = lds_byte(wr * 64 + fr, fq * 8), boff = lds_byte(wc * 32 + fr, fq * 8);
#define PG8_SA(b, h) (((b) * 2 + (h)) * HTB)
#define PG8_SB(b, h) ((4 + (b) * 2 + (h)) * HTB)
#define PG8_STAGE(bufoff, gbase, voff) do { _Pragma("unroll") for (int _i = 0; _i < 2; ++_i) \
        __builtin_amdgcn_global_load_lds((const unsigned*)((const char*)(gbase) + (voff)[_i]), (PG8_LAS unsigned*)(lds + (bufoff) + ldsw + _i * 8192), 16, 0, 0); } while (0)
#define PG8_LDA(dst, b, h) do { _Pragma("unroll") for (int m = 0; m < 4; ++m) _Pragma("unroll") for (int k = 0; k < 2; ++k) dst[m][k] = *(const PG8_LAS bf16x8*)(lds + PG8_SA(b, h) + aoff + m * 2048 + k * 1024); } while (0)
#define PG8_LDB(dst, b, h) do { _Pragma("unroll") for (int n = 0; n < 2; ++n) _Pragma("unroll") for (int k = 0; k < 2; ++k) dst[n][k] = *(const PG8_LAS bf16x8*)(lds + PG8_SB(b, h) + boff + n * 2048 + k * 1024); } while (0)
#define PG8_MMA(ai, bj, At, Bt) do { __builtin_amdgcn_s_setprio(1); _Pragma("unroll") for (int m = 0; m < 4; ++m) _Pragma("unroll") for (int n = 0; n < 2; ++n) { \
        if constexpr (F8) mfma8(acc[ai][bj][m][n], cat8(Bt[n][0], Bt[n][1]), cat8(At[m][0], At[m][1]), one8); \
        else { _Pragma("unroll") for (int k = 0; k < 2; ++k) acc[ai][bj][m][n] = __builtin_amdgcn_mfma_f32_16x16x32_bf16(Bt[n][k], At[m][k], acc[ai][bj][m][n], 0, 0, 0); } } __builtin_amdgcn_s_setprio(0); } while (0)
#define PG8_WAIT_V(n) asm volatile("s_waitcnt vmcnt(" #n ")" ::: "memory")
#define PG8_WAIT_L(n) asm volatile("s_waitcnt lgkmcnt(" #n ")" ::: "memory")
#define PG8_BAR __builtin_amdgcn_s_barrier()
#define PG8_SCHED __builtin_amdgcn_sched_barrier(0)
    Unit cur, nxt; int ui = 0;
    if (!S.next(0, cur)) return;
    int one8 = 0x7F7F7F7F; asm volatile("" : "+v"(one8));
    f32x4 acc[2][2][4][2];
#pragma unroll
    for (int a = 0; a < 2; ++a)
#pragma unroll
        for (int b = 0; b < 2; ++b)
#pragma unroll
            for (int m = 0; m < 4; ++m)
#pragma unroll
                for (int n = 0; n < 2; ++n) acc[a][b][m][n] = (f32x4){0.f, 0.f, 0.f, 0.f};
    bf16x8 At[4][2], B0[2][2], B1[2][2];
    const char* cA = (const char*)g.A + (size_t)S.arow(cur.pm) * K * 2; const char* cB = (const char*)g.Bt + (size_t)cur.pn * tstep;
    S.a_ready(cur);
    if constexpr (SP2) {
        PG8_STAGE(PG8_SB(0, 0), cB, voffB); PG8_STAGE(PG8_SB(0, 1), cB + hstep, voffB); PG8_STAGE(PG8_SA(0, 0), cA, voffA); PG8_STAGE(PG8_SA(0, 1), cA + hstep, voffA);
        if (wr == 1) PG8_BAR;
        PG8_WAIT_V(2); PG8_BAR;
        PG8_STAGE(PG8_SB(1, 0), cB + kstep, voffB); PG8_STAGE(PG8_SA(1, 0), cA + kstep, voffA); PG8_STAGE(PG8_SB(1, 1), cB + hstep + kstep, voffB);
        PG8_WAIT_V(6); PG8_BAR;
    } else {
        PG8_STAGE(PG8_SB(0, 0), cB, voffB); PG8_STAGE(PG8_SA(0, 0), cA, voffA); PG8_STAGE(PG8_SB(0, 1), cB + hstep, voffB); PG8_STAGE(PG8_SA(0, 1), cA + hstep, voffA);
        if (wr == 1) PG8_BAR;
        PG8_WAIT_V(4); PG8_BAR;
        PG8_STAGE(PG8_SB(1, 0), cB + kstep, voffB); PG8_STAGE(PG8_SA(1, 0), cA + kstep, voffA); PG8_STAGE(PG8_SB(1, 1), cB + hstep + kstep, voffB);
        PG8_WAIT_V(6); PG8_BAR;
    }
    for (;;) {
        const bool has_next = S.next(ui + 1, nxt);
        const char* nA = has_next ? (const char*)g.A + (size_t)S.arow(nxt.pm) * K * 2 : cA; const char* nB = has_next ? (const char*)g.Bt + (size_t)nxt.pn * tstep : cB;
        for (int t = 0; t < nt; t += 2) {
            const bool last = (t == nt - 2);
            const char* a1 = cA + (size_t)(t + 1) * kstep;
            const char* a2 = last ? nA : cA + (size_t)(t + 2) * kstep; const char* b2 = last ? nB : cB + (size_t)(t + 2) * kstep;
            const char* a3 = a2 + kstep; const char* b3 = b2 + kstep;
            if (last && has_next) S.a_ready(nxt);
            if constexpr (SP2) {
            PG8_LDB(B0, 0, 0); PG8_LDB(B1, 0, 1); PG8_SCHED; PG8_LDA(At, 0, 0); PG8_STAGE(PG8_SA(1, 1), a1 + hstep, voffA);
            PG8_WAIT_V(8); PG8_WAIT_L(0); PG8_BAR; PG8_MMA(0, 0, At, B0); PG8_MMA(0, 1, At, B1); PG8_BAR; PG8_SCHED;
            PG8_LDA(At, 0, 1); PG8_STAGE(PG8_SB(0, 0), b2, voffB); PG8_STAGE(PG8_SB(0, 1), b2 + hstep, voffB); PG8_STAGE(PG8_SA(0, 0), a2, voffA);
            PG8_WAIT_V(8); PG8_WAIT_L(0); PG8_BAR; PG8_MMA(1, 0, At, B0); PG8_MMA(1, 1, At, B1); PG8_BAR; PG8_SCHED;
            PG8_LDB(B0, 1, 0); PG8_LDB(B1, 1, 1); PG8_SCHED; PG8_LDA(At, 1, 0); PG8_STAGE(PG8_SA(0, 1), a2 + hstep, voffA);
            PG8_WAIT_V(8); PG8_WAIT_L(0); PG8_BAR; PG8_MMA(0, 0, At, B0); PG8_MMA(0, 1, At, B1); PG8_BAR; PG8_SCHED;
            PG8_LDA(At, 1, 1); PG8_STAGE(PG8_SB(1, 0), b3, voffB); PG8_STAGE(PG8_SB(1, 1), b3 + hstep, voffB); PG8_STAGE(PG8_SA(1, 0), a3, voffA);
            PG8_WAIT_V(8); PG8_WAIT_L(0); PG8_BAR; PG8_MMA(1, 0, At, B0); PG8_MMA(1, 1, At, B1); PG8_BAR; PG8_SCHED;
            } else {
            PG8_LDB(B0, 0, 0); PG8_SCHED; PG8_LDA(At, 0, 0); PG8_STAGE(PG8_SA(1, 1), a1 + hstep, voffA);
            PG8_WAIT_L(8); PG8_BAR; PG8_WAIT_L(0); PG8_MMA(0, 0, At, B0); PG8_BAR; PG8_SCHED;
            PG8_LDB(B1, 0, 1); PG8_STAGE(PG8_SB(0, 0), b2, voffB);
            PG8_BAR; PG8_WAIT_L(0); PG8_MMA(0, 1, At, B1); PG8_BAR;
            PG8_LDA(At, 0, 1); PG8_STAGE(PG8_SA(0, 0), a2, voffA);
            PG8_BAR; PG8_WAIT_L(0); PG8_MMA(1, 0, At, B0); PG8_BAR; PG8_SCHED;
            PG8_STAGE(PG8_SB(0, 1), b2 + hstep, voffB);
            PG8_WAIT_V(6); PG8_BAR; PG8_MMA(1, 1, At, B1); PG8_BAR;
            PG8_LDB(B0, 1, 0); PG8_SCHED; PG8_LDA(At, 1, 0); PG8_STAGE(PG8_SA(0, 1), a2 + hstep, voffA);
            PG8_WAIT_L(8); PG8_BAR; PG8_WAIT_L(0); PG8_MMA(0, 0, At, B0); PG8_BAR; PG8_SCHED;
            PG8_LDB(B1, 1, 1); PG8_STAGE(PG8_SB(1, 0), b3, voffB);
            PG8_BAR; PG8_WAIT_L(0); PG8_MMA(0, 1, At, B1); PG8_BAR;
            PG8_LDA(At, 1, 1); PG8_STAGE(PG8_SA(1, 0), a3, voffA);
            PG8_BAR; PG8_WAIT_L(0); PG8_MMA(1, 0, At, B0); PG8_BAR; PG8_SCHED;
            PG8_STAGE(PG8_SB(1, 1), b3 + hstep, voffB);
            PG8_WAIT_V(6); PG8_BAR; PG8_MMA(1, 1, At, B1); PG8_BAR;
            }
        }
        if constexpr (ALIGN_EPI) { if (wr == 0) PG8_BAR; }
        if constexpr (F8) asm volatile("s_nop 15\n\ts_nop 15" ::: "memory");
        if constexpr (!Epi::AFTER_DRAIN) { E(acc, cur, wr, wc, fr, fq); S.done(cur); }
        if (!has_next) break;
#pragma unroll
        for (int a = 0; a < 2; ++a)
#pragma unroll
            for (int b = 0; b < 2; ++b)
#pragma unroll
                for (int m = 0; m < 4; ++m)
#pragma unroll
                    for (int n = 0; n < 2; ++n) acc[a][b][m][n] = (f32x4){0.f, 0.f, 0.f, 0.f};
        cur = nxt; cA = nA; cB = nB; ++ui;
        if constexpr (ALIGN_EPI) { if (wr == 1) PG8_BAR; }
    }
    PG8_WAIT_V(0);
    if constexpr (!ALIGN_EPI) { if (wr == 0) PG8_BAR; }
    PG8_BAR;
    if constexpr (Epi::AFTER_DRAIN) { E.fused(acc, cur, wr, wc, fr, fq, lds, wid, lane); S.done(cur); }
#undef PG8_SA
#undef PG8_SB
#undef PG8_STAGE
#undef PG8_LDA
#undef PG8_LDB
#undef PG8_MMA
#undef PG8_WAIT_V
#undef PG8_WAIT_L
#undef PG8_BAR
#undef PG8_SCHED
}
__device__ __forceinline__ float rstd_slots(const float* ss, int row, int fq) {
    const f32x4 v = *(const f32x4*)(ss + (size_t)row * 16 + 4 * fq);
    float s = (v[0] + v[1]) + (v[2] + v[3]);
    s += __shfl_xor(s, 16); s += __shfl_xor(s, 32);
    return 1.0f / sqrtf(s * (1.0f / 1024.0f) + 1e-6f);
}
__device__ __forceinline__ f32x4 slots_load(const float* ss, int row, int fq) { return *(const f32x4*)(ss + (size_t)row * 16 + 4 * fq); }
__device__ __forceinline__ float slots_rstd(const f32x4 v) { float s = (v[0] + v[1]) + (v[2] + v[3]); s += __shfl_xor(s, 16); s += __shfl_xor(s, 32); return __builtin_amdgcn_rsqf(s * (1.0f / 1024.0f) + 1e-6f); }
__device__ __forceinline__ float silu_mul(float g, float u) { return g * __builtin_amdgcn_rcpf(1.0f + __builtin_amdgcn_exp2f(-1.4426950408889634f * g)) * u; }
__device__ __forceinline__ unsigned pk8(float a, float b, float c, float d) {
    a = __builtin_amdgcn_fmed3f(a, -448.f, 448.f); b = __builtin_amdgcn_fmed3f(b, -448.f, 448.f); c = __builtin_amdgcn_fmed3f(c, -448.f, 448.f); d = __builtin_amdgcn_fmed3f(d, -448.f, 448.f);
    const int p = __builtin_amdgcn_cvt_pk_fp8_f32(a, b, __builtin_bit_cast(int, a), false); return (unsigned)__builtin_amdgcn_cvt_pk_fp8_f32(c, d, p, true); }
__device__ __forceinline__ float silu_mul_f(float ag, float au, float c1, float c0, float rK) { return (ag * au) * __builtin_amdgcn_rcpf(__builtin_amdgcn_exp2f(__builtin_fmaf(ag, c1, c0)) + rK); }
__device__ __forceinline__ f32x4 silu_mul_v(const f32x4 ag, const f32x4 au, float c1, float c0, float rK) {
    const f32x4 x = __builtin_elementwise_fma(ag, (f32x4){c1, c1, c1, c1}, (f32x4){c0, c0, c0, c0});
    f32x4 d = {__builtin_amdgcn_exp2f(x[0]), __builtin_amdgcn_exp2f(x[1]), __builtin_amdgcn_exp2f(x[2]), __builtin_amdgcn_exp2f(x[3])};
    d = d + rK;
    const f32x4 r = {__builtin_amdgcn_rcpf(d[0]), __builtin_amdgcn_rcpf(d[1]), __builtin_amdgcn_rcpf(d[2]), __builtin_amdgcn_rcpf(d[3])};
    return (ag * au) * r; }
__device__ __forceinline__ unsigned pkbf(float lo, float hi) { typedef float v2f __attribute__((ext_vector_type(2))); typedef __bf16 v2b __attribute__((ext_vector_type(2))); v2f v = {lo, hi}; v2b b = __builtin_convertvector(v, v2b); return __builtin_bit_cast(unsigned, b); }

template <bool F8> struct EpiGU {
    static constexpr bool PERM = true, AFTER_DRAIN = false;
    unsigned char* act; const float* ss; int abl; float pre;
    __device__ __forceinline__ void operator()(const f32x4 (&acc)[2][2][4][2], const Unit& u, int wr, int wc, int fr, int fq) const {
        if (abl & 1) return;
        const int row0 = u.pm * BM + wr * 64 + fr, col0 = u.pn * 128 + wc * 32 + 8 * fq;
        f32x4 sv[2][4];
#pragma unroll
        for (int ai = 0; ai < 2; ++ai)
#pragma unroll
            for (int m = 0; m < 4; ++m) sv[ai][m] = slots_load(ss, row0 + ai * HALF + m * 16, fq);
#pragma unroll
        for (int ai = 0; ai < 2; ++ai)
#pragma unroll
            for (int m = 0; m < 4; ++m) { const int row = row0 + ai * HALF + m * 16; const float s = slots_rstd(sv[ai][m]) * pre, Ks = (F8 ? ACT_SCALE : 1.0f) * s * s;
                const float c1 = -1.4426950408889634f * s, c0 = -__builtin_amdgcn_logf(Ks), rK = __builtin_amdgcn_rcpf(Ks);
                const f32x4 g0 = acc[ai][0][m][0], g1 = acc[ai][0][m][1], u0 = acc[ai][1][m][0], u1 = acc[ai][1][m][1];
                const f32x4 a0 = silu_mul_v(g0, u0, c1, c0, rK), a1 = silu_mul_v(g1, u1, c1, c0, rK);
                if constexpr (F8) { typedef unsigned u32x2v __attribute__((ext_vector_type(2))); u32x2v w; w.x = pk8(a0[0], a0[1], a0[2], a0[3]); w.y = pk8(a1[0], a1[1], a1[2], a1[3]);
                    *(u32x2v*)(act + (size_t)row * 2816 + col0) = w; }
                else { u32x4 w; w.x = pkbf(a0[0], a0[1]); w.y = pkbf(a0[2], a0[3]); w.z = pkbf(a1[0], a1[1]); w.w = pkbf(a1[2], a1[3]);
                    *(u32x4*)((bf16_t*)act + (size_t)row * 2816 + col0) = w; }
            }
    }
};
template <bool HB, bool SS> struct EpiRes {
    static constexpr bool PERM = false, AFTER_DRAIN = false;
    const float* res; float* out; bf16_t* hb; float* ss; float alpha;
    __device__ __forceinline__ void operator()(const f32x4 (&acc)[2][2][4][2], const Unit& u, int wr, int wc, int fr, int fq) const {
        const int row0 = u.pm * BM + wr * 64 + fr, col0 = u.pn * BM + wc * 32 + 4 * fq;
#pragma unroll
        for (int ai = 0; ai < 2; ++ai)
#pragma unroll
            for (int m = 0; m < 4; ++m) { const int row = row0 + ai * HALF + m * 16; const size_t off = (size_t)row * 1024 + col0; float sq = 0.f;
#pragma unroll
                for (int bj = 0; bj < 2; ++bj)
#pragma unroll
                    for (int n = 0; n < 2; ++n) { const f32x4 r4 = *(const f32x4*)(res + off + bj * HALF + n * 16); const f32x4 v = r4 + acc[ai][bj][m][n] * alpha;
                        *(f32x4*)(out + off + bj * HALF + n * 16) = v;
                        if (HB) { typedef unsigned u32x2v __attribute__((ext_vector_type(2))); u32x2v w; w.x = pkbf(v[0], v[1]); w.y = pkbf(v[2], v[3]); *(u32x2v*)(hb + off + bj * HALF + n * 16) = w; }
                        if (SS) sq += (v[0] * v[0] + v[1] * v[1]) + (v[2] * v[2] + v[3] * v[3]); }
                if (SS) { sq += __shfl_xor(sq, 16); sq += __shfl_xor(sq, 32); if (fq == 0) ss[(size_t)row * 16 + u.pn * 4 + wc] = sq; }
                if (m == 3) asm volatile("" ::: "memory"); }
    }
};
template <bool OUTF32, bool SS, bool Q8 = false> struct EpiResB {
    static constexpr bool PERM = true, AFTER_DRAIN = false;
    const bf16_t* res; bf16_t* outb; float* outf; float* ss; float alpha;
    __device__ __forceinline__ void operator()(const f32x4 (&acc)[2][2][4][2], const Unit& u, int wr, int wc, int fr, int fq) const {
        const int row0 = u.pm * BM + wr * 64 + fr, col0 = u.pn * BM + wc * 32 + 8 * fq;
        u32x4 rv[2][4][2];
#pragma unroll
        for (int ai = 0; ai < 2; ++ai)
#pragma unroll
            for (int m = 0; m < 4; ++m)
#pragma unroll
                for (int bj = 0; bj < 2; ++bj) rv[ai][m][bj] = *(const u32x4*)(res + (size_t)(row0 + ai * HALF + m * 16) * 1024 + col0 + bj * HALF);
#pragma unroll
        for (int ai = 0; ai < 2; ++ai)
#pragma unroll
            for (int m = 0; m < 4; ++m) { const int row = row0 + ai * HALF + m * 16; const size_t off = (size_t)row * 1024 + col0; float sq = 0.f;
#pragma unroll
                for (int bj = 0; bj < 2; ++bj) { const u32x4 r = rv[ai][m][bj];
                    f32x4 v0, v1;
                    v0[0] = __uint_as_float(r.x << 16); v0[1] = __uint_as_float(r.x & 0xffff0000u); v0[2] = __uint_as_float(r.y << 16); v0[3] = __uint_as_float(r.y & 0xffff0000u);
                    v1[0] = __uint_as_float(r.z << 16); v1[1] = __uint_as_float(r.z & 0xffff0000u); v1[2] = __uint_as_float(r.w << 16); v1[3] = __uint_as_float(r.w & 0xffff0000u);
                    v0 = v0 + acc[ai][bj][m][0] * alpha; v1 = v1 + acc[ai][bj][m][1] * alpha;
                    if (OUTF32) { *(f32x4*)(outf + off + bj * HALF) = v0; *(f32x4*)(outf + off + bj * HALF + 4) = v1; }
                    else { u32x4 w; w.x = pkbf(v0[0], v0[1]); w.y = pkbf(v0[2], v0[3]); w.z = pkbf(v1[0], v1[1]); w.w = pkbf(v1[2], v1[3]); *(u32x4*)(outb + off + bj * HALF) = w; }
                    if constexpr (Q8) { typedef unsigned u32x2v __attribute__((ext_vector_type(2))); u32x2v w8; w8.x = pk8(v0[0] * H_SCALE, v0[1] * H_SCALE, v0[2] * H_SCALE, v0[3] * H_SCALE); w8.y = pk8(v1[0] * H_SCALE, v1[1] * H_SCALE, v1[2] * H_SCALE, v1[3] * H_SCALE);
                        *(u32x2v*)((unsigned char*)outb - (WS_H2B - WS_H2Q) + off + bj * HALF) = w8; }
                    if (SS) sq += ((v0[0] * v0[0] + v0[1] * v0[1]) + (v0[2] * v0[2] + v0[3] * v0[3])) + ((v1[0] * v1[0] + v1[1] * v1[1]) + (v1[2] * v1[2] + v1[3] * v1[3])); }
                if (SS) { sq += __shfl_xor(sq, 16); sq += __shfl_xor(sq, 32); if (fq == 0) ss[(size_t)row * 16 + u.pn * 4 + wc] = sq; } }
    }
};
struct EpiIn {
    static constexpr bool PERM = true, AFTER_DRAIN = false;
    bf16_t *qa, *ka, *va, *qb, *cc, *iq, *ik; float* iw; const float* ss; const float *g_aq, *g_ak, *g_kv; PG8_LAS float* xch;
    __device__ __forceinline__ void operator()(const f32x4 (&acc)[2][2][4][2], const Unit& u, int wr, int wc, int fr, int fq) const {
        const int row0 = u.pm * BM + wr * 64 + fr, pn = u.pn, lc0 = 64 * wc + 8 * fq;
        if (pn == 8) {
            float rsv[2][4]; f32x4 sv[2][4];
#pragma unroll
            for (int ai = 0; ai < 2; ++ai)
#pragma unroll
                for (int m = 0; m < 4; ++m) sv[ai][m] = slots_load(ss, row0 + ai * HALF + m * 16, fq);
#pragma unroll
            for (int ai = 0; ai < 2; ++ai)
#pragma unroll
                for (int m = 0; m < 4; ++m) { const float rs = slots_rstd(sv[ai][m]); rsv[ai][m] = rs; float sq = 0.f;
#pragma unroll
                    for (int bj = 0; bj < 2; ++bj)
#pragma unroll
                        for (int n = 0; n < 2; ++n) { const f32x4 v = acc[ai][bj][m][n] * rs; sq += (v[0] * v[0] + v[1] * v[1]) + (v[2] * v[2] + v[3] * v[3]); }
                    sq += __shfl_xor(sq, 16); sq += __shfl_xor(sq, 32);
                    if (fq == 0) xch[(ai * HALF + wr * 64 + m * 16 + fr) * 4 + wc] = sq; }
            asm volatile("s_waitcnt lgkmcnt(0)" ::: "memory"); __builtin_amdgcn_s_barrier(); asm volatile("" ::: "memory");
            f32x4 gv[2][2];
#pragma unroll
            for (int bj = 0; bj < 2; ++bj)
#pragma unroll
                for (int n = 0; n < 2; ++n) gv[bj][n] = *(const f32x4*)(g_kv + lc0 + 32 * bj + 4 * n);
#pragma unroll
            for (int ai = 0; ai < 2; ++ai)
#pragma unroll
                for (int m = 0; m < 4; ++m) { const int row = row0 + ai * HALF + m * 16, rl = ai * HALF + wr * 64 + m * 16 + fr; const f32x4 t = *(const PG8_LAS f32x4*)(xch + rl * 4);
                    const float r2 = rsv[ai][m] / sqrtf(((t[0] + t[1]) + (t[2] + t[3])) * (1.0f / 256.0f) + 1e-6f);
                    const size_t kr = (size_t)(row >> 11) * 2112 + 64 + (row & 2047);
#pragma unroll
                    for (int bj = 0; bj < 2; ++bj) { const f32x4 a = acc[ai][bj][m][0] * r2 * gv[bj][0], b = acc[ai][bj][m][1] * r2 * gv[bj][1];
                        u32x4 w; w.x = pkbf(a[0], a[1]); w.y = pkbf(a[2], a[3]); w.z = pkbf(b[0], b[1]); w.w = pkbf(b[2], b[3]);
                        *(u32x4*)(cc + kr * 256 + lc0 + 32 * bj) = w; } }
            asm volatile("s_waitcnt lgkmcnt(0)" ::: "memory"); __builtin_amdgcn_s_barrier(); asm volatile("" ::: "memory");
            return;
        }
        const bool headnorm = pn < 4;
        f32x4 gv[2][2];
        if (headnorm) { const float* gp = (pn < 2) ? g_aq : g_ak; const float sc = (pn < 2) ? (0.125f * 1.4426950408889634f) : 1.0f;
#pragma unroll
            for (int bj = 0; bj < 2; ++bj)
#pragma unroll
                for (int n = 0; n < 2; ++n) gv[bj][n] = *(const f32x4*)(gp + 32 * bj + 8 * fq + 4 * n) * sc; }
        f32x4 sv[2][4];
#pragma unroll
        for (int ai = 0; ai < 2; ++ai)
#pragma unroll
            for (int m = 0; m < 4; ++m) sv[ai][m] = slots_load(ss, row0 + ai * HALF + m * 16, fq);
#pragma unroll
        for (int ai = 0; ai < 2; ++ai)
#pragma unroll
            for (int m = 0; m < 4; ++m) { const int row = row0 + ai * HALF + m * 16; const float rs = slots_rstd(sv[ai][m]);
                const size_t kr = (size_t)(row >> 11) * 2112 + 64 + (row & 2047);
                f32x4 v[2][2];
#pragma unroll
                for (int bj = 0; bj < 2; ++bj)
#pragma unroll
                    for (int n = 0; n < 2; ++n) v[bj][n] = acc[ai][bj][m][n] * rs;
                if (headnorm) { float sq = 0.f;
#pragma unroll
                    for (int bj = 0; bj < 2; ++bj)
#pragma unroll
                        for (int n = 0; n < 2; ++n) sq += (v[bj][n][0] * v[bj][n][0] + v[bj][n][1] * v[bj][n][1]) + (v[bj][n][2] * v[bj][n][2] + v[bj][n][3] * v[bj][n][3]);
                    sq += __shfl_xor(sq, 16); sq += __shfl_xor(sq, 32);
                    const float r2 = 1.0f / sqrtf(sq * (1.0f / 64.0f) + 1e-6f);
#pragma unroll
                    for (int bj = 0; bj < 2; ++bj)
#pragma unroll
                        for (int n = 0; n < 2; ++n) v[bj][n] = v[bj][n] * r2 * gv[bj][n]; }
                bf16_t* dst; bool st = true;
                if (pn < 2) dst = qa + (size_t)row * 512 + pn * 256 + lc0;
                else if (pn < 4) dst = ka + kr * 512 + (pn - 2) * 256 + lc0;
                else if (pn < 6) dst = va + kr * 512 + (pn - 4) * 256 + lc0;
                else if (pn < 8) dst = qb + (size_t)row * 512 + (pn - 6) * 256 + lc0;
                else if (pn < 11) dst = iq + (size_t)row * 512 + (pn - 9) * 256 + lc0;
                else { dst = ik + kr * 64 + lc0; st = (wc == 0);
                    if (wc == 1 && fq == 0) { const float s = 0.35355339059327373f * 0.125f; *(f32x4*)(iw + (size_t)row * 8) = v[0][0] * s; *(f32x4*)(iw + (size_t)row * 8 + 4) = v[0][1] * s; } }
                if (st) {
#pragma unroll
                    for (int bj = 0; bj < 2; ++bj) { u32x4 w; w.x = pkbf(v[bj][0][0], v[bj][0][1]); w.y = pkbf(v[bj][0][2], v[bj][0][3]); w.z = pkbf(v[bj][1][0], v[bj][1][1]); w.w = pkbf(v[bj][1][2], v[bj][1][3]);
                        *(u32x4*)(dst + 32 * bj) = w; } } }
    }
};
struct EpiKV {
    static constexpr bool PERM = true, AFTER_DRAIN = false;
    bf16_t *kk, *vv;
    __device__ __forceinline__ void operator()(const f32x4 (&acc)[2][2][4][2], const Unit& u, int wr, int wc, int fr, int fq) const {
        const int row0 = (u.pm >> 3) * 2112 + 64 + (u.pm & 7) * BM + wr * 64 + fr; bf16_t* base = (u.pn < 2 ? kk : vv) + (u.pn & 1) * 256 + wc * 32 + 8 * fq;
#pragma unroll
        for (int ai = 0; ai < 2; ++ai)
#pragma unroll
            for (int m = 0; m < 4; ++m) { bf16_t* rowp = base + (size_t)(row0 + ai * HALF + m * 16) * 512;
#pragma unroll
                for (int bj = 0; bj < 2; ++bj) { const f32x4 a = acc[ai][bj][m][0], b = acc[ai][bj][m][1];
                    u32x4 w; w.x = pkbf(a[0], a[1]); w.y = pkbf(a[2], a[3]); w.z = pkbf(b[0], b[1]); w.w = pkbf(b[2], b[3]);
                    *(u32x4*)(rowp + bj * HALF) = w; } }
    }
};
}
struct Args {
    const float* in[25]; float* out; unsigned char* ws; int dup; int pad;
};
typedef const __attribute__((address_space(4))) Args* CArgsP;
__device__ __forceinline__ CArgsP get_args() { CArgsP p = (CArgsP)__builtin_amdgcn_kernarg_segment_ptr(); asm volatile("" : "+s"(p)); return p; }
struct Frame {
    LAS unsigned char* lds; int tid, lane, wave, G, vcu;
};

__device__ __forceinline__ Frame make_frame(LAS unsigned char* lds, int wave_s) {
    Frame F; int t = wave_s * 64 + pg8::lane_id(); asm volatile("" : "+v"(t));
    F.lds = lds; F.tid = t; F.lane = t & 63; F.wave = __builtin_amdgcn_readfirstlane(t >> 6);
    F.G = gridDim.x; { const int bx = blockIdx.x; F.vcu = (F.G % 8 == 0) ? (bx % 8) * (F.G / 8) + bx / 8 : bx; }
    return F;
}
__device__ __forceinline__ void tr_item(const float* __restrict__ W, int ld, int col, int nvalid, const float* __restrict__ gain, int k0, bf16* out, int Kpitch, LAS float* scr, int lane) {
    const int c = lane & 31; const bool okc = c < nvalid;
    const float* wp = W + (size_t)(k0 + (lane >> 5)) * ld + col + (okc ? c : 0);
    float v[32];
#pragma unroll
    for (int i = 0; i < 32; ++i) v[i] = okc ? wp[(size_t)(2 * i) * ld] : 0.f;
    if (gain) {
#pragma unroll
        for (int i = 0; i < 32; ++i) v[i] *= gain[k0 + 2 * i + (lane >> 5)]; }
#pragma unroll
    for (int i = 0; i < 32; ++i) scr[(2 * i + (lane >> 5)) * 33 + c] = v[i];
    LDS_WAIT(); asm volatile("" ::: "memory");
    const int c8 = lane & 7;
#pragma unroll
    for (int j = 0; j < 4; ++j) { const int n = (lane >> 3) + 8 * j; const LAS float* s = scr + (8 * c8) * 33 + n;
        u32x4 o; o.x = pk2(s[0 * 33], s[1 * 33]); o.y = pk2(s[2 * 33], s[3 * 33]); o.z = pk2(s[4 * 33], s[5 * 33]); o.w = pk2(s[6 * 33], s[7 * 33]);
        *(u32x4*)(out + (size_t)n * Kpitch + 8 * c8) = o; }
    LDS_WAIT(); asm volatile("" ::: "memory");
}
__device__ __forceinline__ void p0_gu_item(const float* Wg, const float* Wu, const float* gain, bf16* WT, int r, LAS float* scr, int lane) {
    const int kb = r / 176, nb = r % 176, n0 = 32 * nb, pn = n0 >> 8, j = n0 & 255, bj = j >> 7, jj = j & 127;
    tr_item(bj ? Wu : Wg, FF, 128 * pn + jj, 32, gain, 64 * kb, WT + (size_t)n0 * DM + 64 * kb, DM, scr, lane);
}
__device__ __forceinline__ void p0_plain_item(const float* W, int K, int N, const float* gain, bf16* WT, int r, LAS float* scr, int lane) {
    const int nblk = N / 32, kb = r / nblk, nb = r % nblk;
    tr_item(W, N, 32 * nb, 32, gain, 64 * kb, WT + (size_t)(32 * nb) * K + 64 * kb, K, scr, lane);
}
__device__ __forceinline__ void tr_item8(const float* __restrict__ W, int ld, int col, float scale, int k0, unsigned char* out8, int Kpitch, LAS float* scr, int lane, const float* __restrict__ gain = nullptr) {
    const int c = lane & 31;
    const float* wp = W + (size_t)(k0 + (lane >> 5)) * ld + col + c;
    float v[32];
#pragma unroll
    for (int i = 0; i < 32; ++i) v[i] = wp[(size_t)(2 * i) * ld];
#pragma unroll
    for (int i = 0; i < 32; ++i) scr[(2 * i + (lane >> 5)) * 33 + c] = v[i] * (gain ? scale * gain[k0 + 2 * i + (lane >> 5)] : scale);
    LDS_WAIT(); asm volatile("" ::: "memory");
    const int n = lane >> 1, kh = 32 * (lane & 1); const LAS float* s = scr + kh * 33 + n;
#pragma unroll
    for (int j = 0; j < 2; ++j) { u32x4 o;
        o.x = pg8::pk8(s[(16 * j + 0) * 33], s[(16 * j + 1) * 33], s[(16 * j + 2) * 33], s[(16 * j + 3) * 33]); o.y = pg8::pk8(s[(16 * j + 4) * 33], s[(16 * j + 5) * 33], s[(16 * j + 6) * 33], s[(16 * j + 7) * 33]);
        o.z = pg8::pk8(s[(16 * j + 8) * 33], s[(16 * j + 9) * 33], s[(16 * j + 10) * 33], s[(16 * j + 11) * 33]); o.w = pg8::pk8(s[(16 * j + 12) * 33], s[(16 * j + 13) * 33], s[(16 * j + 14) * 33], s[(16 * j + 15) * 33]);
        *(u32x4*)(out8 + (size_t)n * Kpitch + kh + 16 * j) = o; }
    LDS_WAIT(); asm volatile("" ::: "memory");
}
__device__ __forceinline__ void p0_plain_item8(const float* W, int K, int N, float scale, unsigned char* WT8, int r, LAS float* scr, int lane) {
    const int nblk = N / 32, kb = r / nblk, nb = r % nblk;
    tr_item8(W, N, 32 * nb, scale, 64 * kb, WT8 + (size_t)(32 * nb) * K + 64 * kb, K, scr, lane);
}
__device__ __forceinline__ void p0_gu_item8(const float* Wg, const float* Wu, const float* gain, unsigned char* WT8, int r, LAS float* scr, int lane) {
    const int kb = r / 176, nb = r % 176, n0 = 32 * nb, pn = n0 >> 8, j = n0 & 255, bj = j >> 7, jj = j & 127;
    tr_item8(bj ? Wu : Wg, FF, 128 * pn + jj, GU_SCALE, 64 * kb, WT8 + (size_t)n0 * DM + 64 * kb, DM, scr, lane, gain);
}
__device__ __forceinline__ void p0_in_item(const float* W, const float* gain, bf16* WT, int r, LAS float* scr, int lane) {
    const int kb = r / 96, nb = r % 96, n0 = 32 * nb, pn = n0 >> 8, j = n0 & 255, bj = j >> 7, wc = (j >> 5) & 3, L = 256 * pn + 64 * wc + 32 * bj;
    int nv = NIN - L; nv = nv < 0 ? 0 : (nv > 32 ? 32 : nv);
    tr_item(W, NIN, L, nv, gain, 64 * kb, WT + (size_t)n0 * DM + 64 * kb, DM, scr, lane);
}
__device__ __forceinline__ void row_to_bf16(const float* xrow, bf16* orow, float* ssrow, int lane) {
    const f32x4* xr = (const f32x4*)xrow + lane; f32x4 v[4]; float s = 0.f;
#pragma unroll
    for (int j = 0; j < 4; ++j) { v[j] = xr[64 * j]; s += (v[j][0] * v[j][0] + v[j][1] * v[j][1]) + (v[j][2] * v[j][2] + v[j][3] * v[j][3]); }
    u32x2* o8 = (u32x2*)orow + lane;
#pragma unroll
    for (int j = 0; j < 4; ++j) { u32x2 w; w.x = pk2(v[j][0], v[j][1]); w.y = pk2(v[j][2], v[j][3]); o8[64 * j] = w; }
    const float tot = wave_sum(s);
    if (lane < 16) ssrow[lane] = (lane == 0) ? tot : 0.f;
}
__device__ __forceinline__ void p0_prologue(const Frame& F, CArgsP a) {
    unsigned char* ws = a->ws;
    LAS float* scr = (LAS float*)(F.lds + F.wave * 16384);
    const int gw = F.vcu * 8 + F.wave, NGW = F.G * 8, lane = F.lane;
    constexpr int I0 = 2816, I1 = 1408, I2 = 1536, I3 = 512, I4 = 2816, I5 = 1408, I6 = 64, I7 = 64, NIT = I0 + I1 + I2 + I3 + I4 + I5 + I6 + I7;
    for (int it = gw; it < NIT; it += NGW) {
        int r = it;
        if (r < I0) { p0_gu_item(a->in[4], a->in[5], a->in[3], (bf16*)(ws + WS_WGU1), r, scr, lane); continue; } r -= I0;
        if (r < I1) { if (F8_D1) p0_plain_item8(a->in[6], FF, DM, WD_SCALE, ws + WS_WD1, r, scr, lane); else p0_plain_item(a->in[6], FF, DM, nullptr, (bf16*)(ws + WS_WD1), r, scr, lane); continue; } r -= I1;
        if (r < I2) { p0_in_item(a->in[8], a->in[7], (bf16*)(ws + WS_WIN), r, scr, lane); continue; } r -= I2;
        if (r < I3) { p0_plain_item(a->in[20], DM, DM, nullptr, (bf16*)(ws + WS_WOUT), r, scr, lane); continue; } r -= I3;
        if (r < I4) { if (F8_G2) p0_gu_item8(a->in[22], a->in[23], a->in[21], ws + WS_WGU2, r, scr, lane); else p0_gu_item(a->in[22], a->in[23], a->in[21], (bf16*)(ws + WS_WGU2), r, scr, lane); continue; } r -= I4;
        if (r < I5) { if (F8_D2) p0_plain_item8(a->in[24], FF, DM, WD_SCALE, ws + WS_WD2, r, scr, lane); else p0_plain_item(a->in[24], FF, DM, nullptr, (bf16*)(ws + WS_WD2), r, scr, lane); continue; } r -= I5;
        if (r < I6) { const int h = r >> 4, q = r & 15, kb = q >> 2, nb = q & 3;
            tr_item(a->in[19] + (size_t)h * 256 * 128, 128, 32 * nb, 32, nullptr, 64 * kb, (bf16*)(ws + WS_WKV) + (size_t)(512 + 128 * h + 32 * nb) * 256 + 64 * kb, 256, scr, lane); continue; } r -= I6;
        { const int h = r >> 4, q = r & 15, kb = q >> 3, nb = q & 7;
            tr_item(a->in[17] + (size_t)h * 128 * 256, 256, 32 * nb, 32, nullptr, 64 * kb, (bf16*)(ws + WS_WUKT) + (size_t)h * 256 * 128 + (size_t)(32 * nb) * 128 + 64 * kb, 128, scr, lane); }
    }
    {
        const int gid = F.vcu * 512 + F.tid;
        for (int e = gid; e < 512 * 256 / 2; e += F.G * 512) { const int i = 2 * e, c = i & 255; const float* w = a->in[17] + i; const float* g = a->in[18] + c;
            ((unsigned*)(ws + WS_WKV))[e] = pk2(w[0] * g[0], w[1] * g[1]); }
    }
    {
        f32x4 v[2][4][4];
        auto xload = [&](f32x4 (&d)[4][4], int m0) {
#pragma unroll
            for (int r = 0; r < 4; ++r) { const f32x4* xr = (const f32x4*)(a->in[0] + (size_t)(m0 + r) * DM) + lane;
#pragma unroll
                for (int j = 0; j < 4; ++j) d[r][j] = __builtin_nontemporal_load(xr + 64 * j); } };
        auto xstore = [&](const f32x4 (&d)[4][4], int m0) { float sq[4];
#pragma unroll
            for (int r = 0; r < 4; ++r) { float s = 0.f; u32x2* o8 = (u32x2*)((bf16*)(ws + WS_HB) + (size_t)(m0 + r) * DM) + lane;
#pragma unroll
                for (int j = 0; j < 4; ++j) { s += (d[r][j][0] * d[r][j][0] + d[r][j][1] * d[r][j][1]) + (d[r][j][2] * d[r][j][2] + d[r][j][3] * d[r][j][3]);
                    u32x2 w; w.x = pk2(d[r][j][0], d[r][j][1]); w.y = pk2(d[r][j][2], d[r][j][3]); o8[64 * j] = w; }
                sq[r] = wave_sum(s); }
#pragma unroll
            for (int r = 0; r < 4; ++r) if (lane < 16) ((float*)(ws + WS_SS))[(size_t)(m0 + r) * 16 + lane] = (lane == 0) ? sq[r] : 0.f; };
        const int step = NGW * 4; int m0 = gw * 4;
        if (m0 < MX) xload(v[0], m0);
#pragma unroll 1
        for (; m0 < MX; m0 += 2 * step) {
            if (m0 + step < MX) xload(v[1], m0 + step);
            xstore(v[0], m0);
            if (m0 + step < MX) { if (m0 + 2 * step < MX) xload(v[0], m0 + 2 * step); xstore(v[1], m0 + step); }
        }
    }
    if (gw < 16) row_to_bf16(a->in[1] + (size_t)gw * DM, (bf16*)(ws + WS_META + MO_HBM) + (size_t)gw * DM, (float*)(ws + WS_META + MO_SSM0) + gw * 16, lane);
    {
        const int gid = F.vcu * 512 + F.tid, NT = F.G * 512; const u32x4 z = {0u, 0u, 0u, 0u};
        for (int e = gid; e < NB * 48 * 64; e += NT) { const int b = e / (48 * 64), q = e % (48 * 64); const size_t o = ((size_t)b * KROWS) * 1024 + (size_t)q * 16;
            *(u32x4*)(ws + WS_KA + o) = z; *(u32x4*)(ws + WS_VA + o) = z; *(u32x4*)(ws + WS_KK + o) = z; *(u32x4*)(ws + WS_VV + o) = z; }
        for (int e = gid; e < NB * 48 * 32; e += NT) { const int b = e / (48 * 32), q = e % (48 * 32); *(u32x4*)(ws + WS_C + ((size_t)b * KROWS) * 512 + (size_t)q * 16) = z; }
        for (int e = gid; e < NB * 48 * 8; e += NT) { const int b = e / (48 * 8), q = e % (48 * 8); *(u32x4*)(ws + WS_IK + ((size_t)b * KROWS) * 128 + (size_t)q * 16) = z; }
    }
}

template <int KS, int NT, int BS> __device__ __forceinline__ void meta_block_mm(const Frame& F, const bf16* __restrict__ A16, const bf16* __restrict__ Bt, const int (&prow)[NT], int K, float (&v)[4][NT]) {
    const int lane = F.lane, col = lane & 15, kq = lane >> 4, k0 = F.wave * KS * 32;
    const bf16* ap = A16 + (size_t)col * K + k0 + 8 * kq;
    const bf16* bp[NT]; f32x4 acc[NT];
#pragma unroll
    for (int j = 0; j < NT; ++j) { bp[j] = Bt + (size_t)(prow[j] + col) * K + k0 + 8 * kq; acc[j] = (f32x4){0.f, 0.f, 0.f, 0.f}; }
#pragma unroll
    for (int s0 = 0; s0 < KS; s0 += BS) {
        bf16x8 av[BS], bv[NT][BS];
#pragma unroll
        for (int s = 0; s < BS; ++s) if (s0 + s < KS) { av[s] = *(const bf16x8*)(ap + 32 * (s0 + s));
#pragma unroll
            for (int j = 0; j < NT; ++j) bv[j][s] = *(const bf16x8*)(bp[j] + 32 * (s0 + s)); }
#pragma unroll
        for (int s = 0; s < BS; ++s) if (s0 + s < KS) {
#pragma unroll
            for (int j = 0; j < NT; ++j) acc[j] = MFMA16(av[s], bv[j][s], acc[j]); }
    }
    LAS float* red = (LAS float*)F.lds;
#pragma unroll
    for (int j = 0; j < NT; ++j)
#pragma unroll
        for (int r = 0; r < 4; ++r) red[(F.wave * 16 + 4 * kq + r) * (16 * NT) + 16 * j + col] = acc[j][r];
    __syncthreads();
    if (F.wave == 0) {
#pragma unroll
        for (int r = 0; r < 4; ++r)
#pragma unroll
            for (int j = 0; j < NT; ++j) { float t = 0.f;
#pragma unroll
                for (int w = 0; w < 8; ++w) t += red[(w * 16 + 4 * kq + r) * (16 * NT) + 16 * j + col];
                v[r][j] = t; } }
    __syncthreads();
}
template <int N> __device__ __forceinline__ float meta_rstd(const float* ssm, int row) { float s = 0.f;
#pragma unroll
    for (int i = 0; i < N; ++i) s += ssm[row * N + i];
    return 1.0f / sqrtf(s * (1.0f / 1024.0f) + EPS); }
__device__ __forceinline__ void meta_store_rows(const Frame& F, const float (&v)[4][4], bf16* dst, int pitch, int cb, int nb) {
    const int lane = F.lane; LAS unsigned char* st = F.lds + 96 * 1024;
#pragma unroll
    for (int r = 0; r < 4; ++r)
#pragma unroll
        for (int j = 0; j < 4; ++j) *(LAS bf16*)(st + (4 * (lane >> 4) + r) * 144 + 2 * (16 * j + (lane & 15))) = (bf16)(pk2(v[r][j], 0.f) & 0xffffu);
    LDS_WAIT();
#pragma unroll
    for (int i = 0; i < 2; ++i) { const int c = lane + 64 * i, row = c >> 3, ch = c & 7; const u32x4 x = *(const LAS u32x4*)(st + row * 144 + 16 * ch);
        for (int b = 0; b < nb; ++b) *(u32x4*)(dst + ((size_t)b * KROWS + 48 + row) * pitch + cb + 8 * ch) = x; }
    LDS_WAIT();
}
__device__ __forceinline__ void meta_p1(const Frame& F, CArgsP a) {
    unsigned char* ws = a->ws;
    const int t = F.vcu; if (t >= 88) return;
    const int lane = F.lane, f0 = 32 * t, pn = f0 >> 7, jj = f0 & 127; const int prow[4] = {256 * pn + jj, 256 * pn + jj + 16, 256 * pn + 128 + jj, 256 * pn + 128 + jj + 16};
    float v[4][4]; meta_block_mm<4, 4, 4>(F, (const bf16*)(ws + WS_META + MO_HBM), (const bf16*)(ws + WS_WGU1), prow, DM, v);
    if (F.wave != 0) return;
    unsigned char* actm = ws + WS_META + MO_ACTM; const float* ssm = (const float*)(ws + WS_META + MO_SSM0);
#pragma unroll
    for (int r = 0; r < 4; ++r) { const int row = 4 * (lane >> 4) + r; const float rs = meta_rstd<16>(ssm, row);
        const float ru = F8_D1 ? rs * ACT_SCALE : rs; const float a0 = pg8::silu_mul(v[r][0] * rs, v[r][2] * ru), a1 = pg8::silu_mul(v[r][1] * rs, v[r][3] * ru);
        if (F8_D1) { const unsigned p = pg8::pk8(a0, a0, a1, a1);
            actm[row * FF + f0 + (lane & 15)] = (unsigned char)(p & 0xffu); actm[row * FF + f0 + 16 + (lane & 15)] = (unsigned char)((p >> 16) & 0xffu); }
        else { ((bf16*)actm)[row * FF + f0 + (lane & 15)] = (bf16)(pk2(a0, 0.f) & 0xffffu); ((bf16*)actm)[row * FF + f0 + 16 + (lane & 15)] = (bf16)(pk2(a1, 0.f) & 0xffffu); } }
}
#if F8_D1
__device__ __forceinline__ void meta_p2(const Frame& F, CArgsP a) {
    unsigned char* ws = a->ws;
    if (F.vcu >= 64) return;
    const int t = F.vcu, lane = F.lane, col = lane & 15, kq = lane >> 4;
    const unsigned char* ap = ws + WS_META + MO_ACTM + (size_t)col * FF + 32 * kq; const unsigned char* bp = ws + WS_WD1 + (size_t)(16 * t + col) * FF + 32 * kq;
    u32x4 av[3][2], bv[3][2];
#pragma unroll
    for (int i = 0; i < 3; ++i) { const int s = F.wave + 8 * i; if (s < 22) { av[i][0] = *(const u32x4*)(ap + 128 * s); av[i][1] = *(const u32x4*)(ap + 128 * s + 16); bv[i][0] = *(const u32x4*)(bp + 128 * s); bv[i][1] = *(const u32x4*)(bp + 128 * s + 16); } }
    f32x4 acc = {0.f, 0.f, 0.f, 0.f};
#pragma unroll
    for (int i = 0; i < 3; ++i) if (F.wave + 8 * i < 22) { typedef int i32x8 __attribute__((ext_vector_type(8)));
        const i32x8 A = {(int)av[i][0].x, (int)av[i][0].y, (int)av[i][0].z, (int)av[i][0].w, (int)av[i][1].x, (int)av[i][1].y, (int)av[i][1].z, (int)av[i][1].w};
        const i32x8 B = {(int)bv[i][0].x, (int)bv[i][0].y, (int)bv[i][0].z, (int)bv[i][0].w, (int)bv[i][1].x, (int)bv[i][1].y, (int)bv[i][1].z, (int)bv[i][1].w};
        acc = __builtin_amdgcn_mfma_scale_f32_16x16x128_f8f6f4(A, B, acc, 0, 0, 0, 0x7F7F7F7F, 0, 0x7F7F7F7F); }
    LAS float* red = (LAS float*)F.lds;
#pragma unroll
    for (int r = 0; r < 4; ++r) red[(F.wave * 16 + 4 * kq + r) * 16 + col] = acc[r];
    __syncthreads();
    if (F.wave == 0) {
        bf16* h1mb = (bf16*)(ws + WS_META + MO_H1MB); float* ssm1 = (float*)(ws + WS_META + MO_SSM1);
#pragma unroll
        for (int r = 0; r < 4; ++r) { const int row = 4 * kq + r; const int c = 16 * t + col; float d = 0.f;
#pragma unroll
            for (int w = 0; w < 8; ++w) d += red[(w * 16 + row) * 16 + col];
            const float h = a->in[1][row * DM + c] + d * (0.5f / (ACT_SCALE * WD_SCALE)); float sq = h * h; h1mb[row * DM + c] = (bf16)(pk2(h, 0.f) & 0xffffu);
            sq += __shfl_xor(sq, 1); sq += __shfl_xor(sq, 2); sq += __shfl_xor(sq, 4); sq += __shfl_xor(sq, 8);
            if (col == 0) ssm1[row * 64 + t] = sq; } }
    __syncthreads();
}
#else
__device__ __forceinline__ void meta_p2(const Frame& F, CArgsP a) {
    unsigned char* ws = a->ws;
    if (F.vcu >= 64) return;
    const int t = F.vcu, lane = F.lane; const int prow[1] = {16 * t};
    float v[4][1]; meta_block_mm<11, 1, 11>(F, (const bf16*)(ws + WS_META + MO_ACTM), (const bf16*)(ws + WS_WD1), prow, FF, v);
    if (F.wave != 0) return;
    bf16* h1mb = (bf16*)(ws + WS_META + MO_H1MB); float* ssm1 = (float*)(ws + WS_META + MO_SSM1);
#pragma unroll
    for (int r = 0; r < 4; ++r) { const int row = 4 * (lane >> 4) + r; const int c = 16 * t + (lane & 15);
        const float h = a->in[1][row * DM + c] + 0.5f * v[r][0]; float sq = h * h; h1mb[row * DM + c] = (bf16)(pk2(h, 0.f) & 0xffffu);
        sq += __shfl_xor(sq, 1); sq += __shfl_xor(sq, 2); sq += __shfl_xor(sq, 4); sq += __shfl_xor(sq, 8);
        if ((lane & 15) == 0) ssm1[row * 64 + t] = sq; }
}
#endif
__device__ __forceinline__ void meta_p3(const Frame& F, CArgsP a) {
    unsigned char* ws = a->ws; const int lane = F.lane;
    if (F.vcu > 17) return;
    const bf16* A16 = (const bf16*)(ws + WS_META + MO_H1MB); const bf16* Wt = (const bf16*)(ws + WS_WIN); const float* ssm1 = (const float*)(ws + WS_META + MO_SSM1);
    if (F.vcu < 17) { const int t = F.vcu; int L, kind; if (t < 8) { L = 512 + 64 * t; kind = 1; } else if (t < 16) { L = 1024 + 64 * (t - 8); kind = 2; } else { L = 2816; kind = 3; }
        const int pn = L >> 8, wc = (L & 255) >> 6, base = 256 * pn + 32 * wc; const int prow[4] = {base, base + 16, base + 128, base + 144};
        float v[4][4]; meta_block_mm<4, 4, 4>(F, A16, Wt, prow, DM, v);
        if (F.wave != 0) return;
#pragma unroll
        for (int r = 0; r < 4; ++r) { const float rs = meta_rstd<64>(ssm1, 4 * (lane >> 4) + r);
#pragma unroll
            for (int j = 0; j < 4; ++j) v[r][j] *= rs;
            if (kind == 1) { float sq = (v[r][0] * v[r][0] + v[r][1] * v[r][1]) + (v[r][2] * v[r][2] + v[r][3] * v[r][3]);
                sq += __shfl_xor(sq, 1); sq += __shfl_xor(sq, 2); sq += __shfl_xor(sq, 4); sq += __shfl_xor(sq, 8);
                const float r2 = 1.0f / sqrtf(sq * (1.0f / 64.0f) + EPS);
#pragma unroll
                for (int j = 0; j < 4; ++j) v[r][j] *= r2 * a->in[10][16 * j + (lane & 15)]; } }
        if (kind == 1) meta_store_rows(F, v, (bf16*)(ws + WS_KA), 512, L - 512, NB);
        else if (kind == 2) meta_store_rows(F, v, (bf16*)(ws + WS_VA), 512, L - 1024, NB);
        else meta_store_rows(F, v, (bf16*)(ws + WS_IK), 64, 0, NB);
    } else {
        float v8[2][4][8]; float sq[4] = {0.f, 0.f, 0.f, 0.f};
#pragma unroll
        for (int c = 0; c < 2; ++c) { const int b0 = 2048 + 32 * (2 * c), b1 = 2048 + 32 * (2 * c + 1); const int prow[8] = {b0, b0 + 16, b0 + 128, b0 + 144, b1, b1 + 16, b1 + 128, b1 + 144};
            meta_block_mm<4, 8, 4>(F, A16, Wt, prow, DM, v8[c]); }
        if (F.wave != 0) return;
        float v[4][4][4];
#pragma unroll
        for (int r = 0; r < 4; ++r) { const float rs = meta_rstd<64>(ssm1, 4 * (lane >> 4) + r);
#pragma unroll
            for (int g = 0; g < 4; ++g)
#pragma unroll
                for (int j = 0; j < 4; ++j) { v[g][r][j] = v8[g >> 1][r][4 * (g & 1) + j] * rs; sq[r] += v[g][r][j] * v[g][r][j]; }
            sq[r] += __shfl_xor(sq[r], 1); sq[r] += __shfl_xor(sq[r], 2); sq[r] += __shfl_xor(sq[r], 4); sq[r] += __shfl_xor(sq[r], 8);
            const float r2 = 1.0f / sqrtf(sq[r] * (1.0f / 256.0f) + EPS);
#pragma unroll
            for (int g = 0; g < 4; ++g)
#pragma unroll
                for (int j = 0; j < 4; ++j) v[g][r][j] *= r2 * a->in[16][64 * g + 16 * j + (lane & 15)]; }
#pragma unroll
        for (int g = 0; g < 4; ++g) meta_store_rows(F, v[g], (bf16*)(ws + WS_C), 256, 64 * g, 1);
    }
}

__device__ __forceinline__ void meta_p4(const Frame& F, CArgsP a) {
    unsigned char* ws = a->ws; const int lane = F.lane;
    if (F.vcu >= 16) return;
    const int t = F.vcu; const int prow[4] = {64 * t, 64 * t + 16, 64 * t + 32, 64 * t + 48};
    float v[4][4]; meta_block_mm<1, 4, 1>(F, (const bf16*)(ws + WS_C) + (size_t)48 * 256, (const bf16*)(ws + WS_WKV), prow, 256, v);
    if (F.wave != 0) return;
    meta_store_rows(F, v, (bf16*)(ws + (t < 8 ? WS_KK : WS_VV)), 512, 64 * (t & 7), NB);
}

#define XB_TMO      128
#define XB_XCNT(j)  (256  + 64 * (j))
#define XB_XSUB(j)  (1280 + 64 * (j))
#define XB_XGEN(j)  (2304 + 64 * (j))
#define XB_TOP      3328
#define XB_TOPGEN   3392
#define XCD_BAR_WORDS 3456
#define XB_SPIN_CAP (1u << 18)

__device__ __forceinline__ unsigned xb_ld(unsigned* p)              { return __hip_atomic_load(p, __ATOMIC_RELAXED, __HIP_MEMORY_SCOPE_AGENT); }
__device__ __forceinline__ unsigned xb_add(unsigned* p, unsigned v) { return __hip_atomic_fetch_add(p, v, __ATOMIC_RELAXED, __HIP_MEMORY_SCOPE_AGENT); }
__device__ __forceinline__ unsigned xb_xcc_id() { return (unsigned)__builtin_amdgcn_s_getreg((3 << 11) | 20) & 0xFu; }
#define XB_SPIN(cond, bar) do { unsigned _sp = 0; while (cond) { __builtin_amdgcn_s_sleep(1); \
    if ((++_sp & 255u) == 0u) { if (xb_ld(&(bar)[XB_TMO])) break; if (_sp > XB_SPIN_CAP) { atomicAdd(&(bar)[XB_TMO], 1u); break; } } } } while (0)

struct XcdBarrier {
    unsigned* bar; unsigned x; int w;
    volatile LAS unsigned* st;
};

__device__ __forceinline__ XcdBarrier xcd_barrier_post(unsigned* bar, volatile LAS unsigned* st) {
    XcdBarrier b; b.bar = bar; b.x = xb_xcc_id(); b.st = st;
    if (threadIdx.x == 0) (void)xb_add(&bar[XB_XCNT(b.x)], 1u);
    return b;
}
__device__ __forceinline__ void xcd_barrier_complete(unsigned* bar, unsigned x, unsigned& nloc, unsigned& nx) {
    const unsigned G = gridDim.x * gridDim.y * gridDim.z;
    unsigned sum, cnt, mine, sp = 0u;
    for (;;) {
        sum = 0u; cnt = 0u; mine = 0u;
#pragma unroll
        for (unsigned j = 0; j < 16; ++j) { const unsigned c = xb_ld(&bar[XB_XCNT(j)]); sum += c; cnt += (c > 0u) ? 1u : 0u; mine = (j == x) ? c : mine; }
        if (sum == G) break;
        __builtin_amdgcn_s_sleep(1);
        if ((++sp & 255u) == 0u) { if (xb_ld(&bar[XB_TMO])) break; if (sp > XB_SPIN_CAP) { atomicAdd(&bar[XB_TMO], 1u); break; } }
    }
    nloc = mine > 0u ? mine : 1u; nx = cnt > 0u ? cnt : 1u;
}

__device__ __forceinline__ void xcd_barrier(const XcdBarrier& b) {
    asm volatile("s_waitcnt vmcnt(0)" ::: "memory");
    __syncthreads();
    if (b.w == 0 && pg8::lane_id() == 0) {
        unsigned* bar = b.bar;
        __builtin_amdgcn_s_waitcnt(0);
        unsigned nloc = b.st[0], nx = b.st[1];
        if (nloc == 0u) { xcd_barrier_complete(bar, b.x, nloc, nx); b.st[0] = nloc; b.st[1] = nx; }
        const unsigned old = xb_add(&bar[XB_XSUB(b.x)], 1u);
        const unsigned gen = old / nloc;
        if (old + 1u == (gen + 1u) * nloc) {
            __builtin_amdgcn_fence(__ATOMIC_RELEASE, "agent");
            asm volatile("s_waitcnt vmcnt(0)" ::: "memory");
            const unsigned og = xb_add(&bar[XB_TOP], 1u);
            const unsigned tg = og / nx;
            if (og + 1u == (tg + 1u) * nx) xb_add(&bar[XB_TOPGEN], 1u);
            else XB_SPIN(xb_ld(&bar[XB_TOPGEN]) == tg, bar);
            __builtin_amdgcn_fence(__ATOMIC_ACQUIRE, "agent");
            xb_add(&bar[XB_XGEN(b.x)], 1u);
            asm volatile("s_waitcnt vmcnt(0)" ::: "memory");
        } else {
            XB_SPIN(xb_ld(&bar[XB_XGEN(b.x)]) == gen, bar);
            __builtin_amdgcn_fence(__ATOMIC_ACQUIRE, "agent");
            asm volatile("s_waitcnt vmcnt(0)" ::: "memory");
        }
    }
    __syncthreads();
}
constexpr int G4 = 1040, TROW = 272, TILEB = 16 * G4  , BUFB = 2 * TILEB  ;
__device__ __forceinline__ unsigned offg(unsigned row, unsigned ch) { return (row >> 2) * (unsigned)G4 + (row & 3u) * 256u + 16u * (ch ^ (4u * (row & 3u))); }
__device__ __constant__ unsigned char kBucket[128] = {
    0, 1, 2, 3, 4, 5, 6, 7, 8, 9, 10, 11, 12, 13, 14, 15, 16, 16, 16, 17, 17, 18, 18, 18, 19, 19, 19, 20, 20, 20, 20, 21, 21, 21, 21, 22, 22, 22, 22, 22, 23, 23, 23, 23, 23, 23, 24, 24, 24, 24, 24, 24,
    25, 25, 25, 25, 25, 25, 25, 26, 26, 26, 26, 26, 26, 26, 26, 27, 27, 27, 27, 27, 27, 27, 27, 27, 27, 28, 28, 28, 28, 28, 28, 28, 28, 28, 28, 29, 29, 29, 29, 29, 29, 29, 29, 29, 29, 29, 29,
    30, 30, 30, 30, 30, 30, 30, 30, 30, 30, 30, 30, 30, 30, 31, 31, 31, 31, 31, 31, 31, 31, 31, 31, 31, 31, 31, 31, 31};
__device__ __forceinline__ unsigned piece_src(int lane, unsigned RP) { const unsigned j = (unsigned)lane >> 4; return j * RP + 16u * (((unsigned)lane & 15u) ^ (4u * j)); }
__device__ __forceinline__ void dma_piece(const void* gbase  , unsigned voff, unsigned m0v  ) {
    unsigned keep;
    asm volatile("s_mov_b32 %0, m0\n\ts_mov_b32 m0, %3\n\ts_nop 0\n\tglobal_load_lds_dwordx4 %1, %2\n\ts_mov_b32 m0, %0" : "=&s"(keep) : "v"(voff), "s"(gbase), "s"(m0v) : "memory");
}
__device__ __forceinline__ void tile_dma(const bf16* Kg, const bf16* Vg, LAS unsigned char* buf, int wid, int lane) {
    const bf16* k0 = Kg + (size_t)(8 * wid) * 512; const bf16* k1 = k0 + 4 * 512; const bf16* v0 = Vg + (size_t)(8 * wid) * 512; const bf16* v1 = v0 + 4 * 512;
    const unsigned mk = (unsigned)__builtin_amdgcn_readfirstlane((int)(unsigned)(uintptr_t)(buf + 2 * wid * G4)), mv = mk + TILEB;
    const unsigned vo = piece_src(lane, 1024u); unsigned keep;
    asm volatile("s_mov_b32 %0, m0\n\t"
                 "s_mov_b32 m0, %6\n\ts_nop 0\n\tglobal_load_lds_dwordx4 %1, %2\n\t"
                 "s_add_u32 m0, m0, 0x410\n\ts_nop 0\n\tglobal_load_lds_dwordx4 %1, %3\n\t"
                 "s_mov_b32 m0, %7\n\ts_nop 0\n\tglobal_load_lds_dwordx4 %1, %4\n\t"
                 "s_add_u32 m0, m0, 0x410\n\ts_nop 0\n\tglobal_load_lds_dwordx4 %1, %5\n\t"
                 "s_mov_b32 m0, %0"
                 : "=&s"(keep) : "v"(vo), "s"(k0), "s"(k1), "s"(v0), "s"(v1), "s"(mk), "s"(mv) : "memory", "scc");
}
#define DMA_WAIT() asm volatile("s_waitcnt vmcnt(0)" ::: "memory")
__device__ __forceinline__ void store_rows_via_lds(const f32x16 (&o)[4], float sc, const float* gain, LAS unsigned char* stage, bf16* grow0  , int lane) {
    const int r32 = lane & 31, hi = lane >> 5;
#pragma unroll
    for (int dt = 0; dt < 4; ++dt)
#pragma unroll
        for (int g = 0; g < 4; ++g) { const int d0 = 32 * dt + 8 * g + 4 * hi; f32x4 gn = {1.f, 1.f, 1.f, 1.f}; if (gain) gn = *(const f32x4*)(gain + d0);
            u32x2 w; w.x = pk2(o[dt][4 * g] * sc * gn[0], o[dt][4 * g + 1] * sc * gn[1]); w.y = pk2(o[dt][4 * g + 2] * sc * gn[2], o[dt][4 * g + 3] * sc * gn[3]);
            *(LAS u32x2*)(stage + r32 * TROW + d0 * 2) = w; }
    LDS_WAIT();
#pragma unroll
    for (int i = 0; i < 8; ++i) { const int row = 4 * i + (lane >> 4), ch = lane & 15; const u32x4 v = *(const LAS u32x4*)(stage + row * TROW + ch * 16);
        *(u32x4*)(grow0 + (size_t)row * 1024 + ch * 8) = v; }
}
__device__ __forceinline__ unsigned xch(int c, int j) { return 16u * (unsigned)(c ^ (4 * j)); }
typedef short v4i16_t __attribute__((ext_vector_type(4)));
__device__ __forceinline__ s16x4 vtr(const LAS unsigned char* p) { return __builtin_bit_cast(s16x4, __builtin_amdgcn_ds_read_tr16_b64_v4i16((LAS v4i16_t*)p)); }
__device__ __forceinline__ bf16x8 vfrag(const LAS unsigned char* Vb, int lane, int kb, int sp, int dt) {
    const int hi = lane >> 5, blk = (lane >> 4) & 1, qq = (lane & 15) >> 2, p = lane & 3;
    const unsigned ch = 4 * dt + 2 * blk + (p >> 1);
    const unsigned r0 = 32 * kb + 16 * sp + 4 * hi + qq;
    const s16x4 lo = vtr(Vb + offg(r0, ch) + 8 * (p & 1)), hh = vtr(Vb + offg(r0 + 8, ch) + 8 * (p & 1));
    return (bf16x8){lo[0], lo[1], lo[2], lo[3], hh[0], hh[1], hh[2], hh[3]};
}
__device__ __forceinline__ bf16x8 pack8(const f32x16& x, int s) {
    u32x4 p; p.x = pk2(x[8 * s], x[8 * s + 1]); p.y = pk2(x[8 * s + 2], x[8 * s + 3]); p.z = pk2(x[8 * s + 4], x[8 * s + 5]); p.w = pk2(x[8 * s + 6], x[8 * s + 7]);
    return __builtin_bit_cast(bf16x8, p);
}
__device__ __forceinline__ void build_lut(LAS float* lut, const float* rel_bias, int col, int tid) {
    if (tid < 128) lut[tid] = (rel_bias[kBucket[tid] * 8 + col] - rel_bias[kBucket[127] * 8 + col]) * LOG2E;
}

constexpr int LDS_AQ = 67072;
__device__ __forceinline__ void exp_block(f32x16& s, const LAS float* lut, bool interior, int kr0, int qrow, int hi, float& l) {
    if (interior) {
#pragma unroll
        for (int r = 0; r < 16; ++r) { s[r] = __builtin_amdgcn_exp2f(s[r]); l += s[r]; } }
    else {
#pragma unroll
        for (int r = 0; r < 16; ++r) { const int kr = kr0 + crow(r, hi), n = qrow - kr; const bool ok = (n >= 0) && (kr >= 48);
            const int idx = n < 0 ? 0 : (n > 127 ? 127 : n); const float e = __builtin_amdgcn_exp2f(s[r] + lut[idx]);
            s[r] = ok ? e : 0.f; l += s[r];
            } }
}
__device__ __forceinline__ void attnA_unit(const Frame& F, CArgsP a, int b, int head, int qb8, float lam, int abl) {
    unsigned char* ws = a->ws; const int tid = F.tid, lane = F.lane, wid = F.wave, r32 = lane & 31, hi = lane >> 5;
    LAS unsigned char* lds = F.lds; LAS float* lut = (LAS float*)(lds + LDS_LUT);
    const int qrow0 = 64 + 256 * qb8 + 32 * wid, qrow = qrow0 + r32;
    const size_t gq = (size_t)b * SEQ + 256 * qb8 + 32 * wid + r32;
    const bf16* Kg = (const bf16*)(ws + WS_KA) + (size_t)b * KROWS * 512 + head * 128;
    const bf16* Vg = (const bf16*)(ws + WS_VA) + (size_t)b * KROWS * 512 + head * 128;
    const int nt = 4 * qb8 + 5, wlast = (qrow0 + 31) >> 6;
    tile_dma(Kg, Vg, lds, wid, lane);
    build_lut(lut, a->in[2], head, tid);
    { const bf16* qg = (const bf16*)(ws + WS_QA) + ((size_t)b * SEQ + 256 * qb8 + 32 * wid) * 512 + head * 128;
      const unsigned mq = (unsigned)__builtin_amdgcn_readfirstlane((int)(unsigned)(uintptr_t)(lds + LDS_AQ + 8 * wid * G4)); const unsigned vo = piece_src(lane, 1024u);
#pragma unroll
      for (int i = 0; i < 8; ++i) dma_piece(qg + (size_t)(4 * i) * 512, vo, mq + i * G4); }
    const int j4 = r32 & 3;
    const LAS unsigned char* qb_ = lds + LDS_AQ + (8 * wid + (r32 >> 2)) * G4 + j4 * 256;
    float l1 = 0.f, l2 = 0.f;
    f32x16 o1[4], o2[4];
#pragma unroll
    for (int dt = 0; dt < 4; ++dt) { o1[dt] = (f32x16){}; o2[dt] = (f32x16){}; }
    DMA_WAIT(); __syncthreads();
#pragma unroll 2
    for (int jt = 0; jt < nt; ++jt) {
        LAS unsigned char* cur = lds + (jt & 1) * BUFB; LAS unsigned char* nxt = lds + ((jt + 1) & 1) * BUFB;
        if (jt + 1 < nt && !(abl & 1)) tile_dma(Kg + (size_t)(jt + 1) * 64 * 512, Vg + (size_t)(jt + 1) * 64 * 512, nxt, wid, lane);
        if (jt <= wlast && !(abl & 2)) {
#pragma unroll
            for (int kb = 0; kb < 2; ++kb) { const int kr0 = 64 * jt + 32 * kb;
                if (kr0 <= qrow0 + 31) {
                    const LAS unsigned char* kbase = cur + (8 * kb + (r32 >> 2)) * G4 + j4 * 256;
                    const bool interior = (kr0 >= 64) && (kr0 + 31 + 113 <= qrow0);
                    bf16x8 p1a, p1b, p2a, p2b;
                    f32x16 s1 = (f32x16){}, s2 = (f32x16){};
#pragma unroll
                    for (int s = 0; s < 4; ++s) { const unsigned x = xch(2 * s + hi, j4); const bf16x8 kf = *(const LAS bf16x8*)(kbase + x); const bf16x8 qf = *(const LAS bf16x8*)(qb_ + x); s1 = MFMA32(kf, qf, s1); }
#pragma unroll
                    for (int s = 0; s < 4; ++s) { const unsigned x = xch(8 + 2 * s + hi, j4); const bf16x8 kf = *(const LAS bf16x8*)(kbase + x); const bf16x8 qf = *(const LAS bf16x8*)(qb_ + x); s2 = MFMA32(kf, qf, s2); }
                    exp_block(s1, lut, interior, kr0, qrow, hi, l1); p1a = pack8(s1, 0); p1b = pack8(s1, 1);
                    exp_block(s2, lut, interior, kr0, qrow, hi, l2); p2a = pack8(s2, 0); p2b = pack8(s2, 1);
                    const LAS unsigned char* vb = cur + TILEB + kb * (8 * G4);
#pragma unroll
                    for (int dt = 0; dt < 4; ++dt) { const bf16x8 v0 = vfrag(vb, lane, 0, 0, dt), v1 = vfrag(vb, lane, 0, 1, dt);
                        o1[dt] = MFMA32(v0, p1a, o1[dt]); o2[dt] = MFMA32(v0, p2a, o2[dt]); o1[dt] = MFMA32(v1, p1b, o1[dt]); o2[dt] = MFMA32(v1, p2b, o2[dt]); }
                } }
        }
        DMA_WAIT(); __syncthreads();
    }
    l1 += __shfl_xor(l1, 32); l2 += __shfl_xor(l2, 32);
    const float c1 = 1.0f / l1, c2 = lam / l2;
    float sq = 0.f;
#pragma unroll
    for (int dt = 0; dt < 4; ++dt)
#pragma unroll
        for (int r = 0; r < 16; ++r) { o1[dt][r] = o1[dt][r] * c1 - o2[dt][r] * c2; sq += o1[dt][r] * o1[dt][r]; }
    sq += __shfl_xor(sq, 32);
    const float rs = SUBLN_SCALE / sqrtf(sq * (1.0f / 128.0f) + EPS);
    store_rows_via_lds(o1, rs, a->in[15], lds + wid * (32 * TROW), (bf16*)a->out + (gq - r32) * 1024 + head * 128, lane);
    __syncthreads();
}

__device__ __forceinline__ void attnB_unit(const Frame& F, CArgsP a, int b, int head, int qb8, int abl) {
    unsigned char* ws = a->ws; const int tid = F.tid, lane = F.lane, wid = F.wave, r32 = lane & 31, hi = lane >> 5;
    LAS unsigned char* lds = F.lds; LAS float* lut = (LAS float*)(lds + LDS_LUT);
    const int qrow0 = 64 + 256 * qb8 + 32 * wid, qrow = qrow0 + r32;
    const size_t gq = (size_t)b * SEQ + 256 * qb8 + 32 * wid + r32;
    const bf16* Kg = (const bf16*)(ws + WS_KK) + (size_t)b * KROWS * 512 + head * 128;
    const bf16* Vg = (const bf16*)(ws + WS_VV) + (size_t)b * KROWS * 512 + head * 128;
    const unsigned* selp = (const unsigned*)(ws + WS_SEL) + gq * SELW;
    const int nt = 4 * qb8 + 5, wlast = (qrow0 + 31) >> 6;
    tile_dma(Kg, Vg, lds, wid, lane);
    build_lut(lut, a->in[2], 4 + head, tid);
    const int j4 = r32 & 3;
    bf16x8 qf[8];
    { const bf16* qp = (const bf16*)(ws + WS_QB) + gq * 512 + head * 128 + 8 * hi;
#pragma unroll
      for (int s = 0; s < 8; ++s) qf[s] = *(const bf16x8*)(qp + 16 * s); }
    float ysq = 0.f;
    if (!(abl & 128)) {
        { const unsigned char* wg = ws + WS_WUKT + (size_t)head * 256 * 256 + (size_t)(32 * wid) * 256;
          const unsigned mb = (unsigned)__builtin_amdgcn_readfirstlane((int)(unsigned)(uintptr_t)(lds + LDS_AQ + 8 * wid * G4)); const unsigned vo = piece_src(lane, 256u);
#pragma unroll
          for (int i = 0; i < 8; ++i) dma_piece(wg + i * 4 * 256, vo, mb + i * G4); }
        DMA_WAIT(); __syncthreads();
        const LAS unsigned char* wb = lds + LDS_AQ + (r32 >> 2) * G4 + j4 * 256;
#pragma unroll 2
        for (int ct = 0; ct < 8; ++ct) { f32x16 y = (f32x16){};
#pragma unroll
            for (int s = 0; s < 8; ++s) { const bf16x8 wf = *(const LAS bf16x8*)(wb + ct * (8 * G4) + xch(2 * s + hi, j4)); y = MFMA32(wf, qf[s], y); }
#pragma unroll
            for (int r = 0; r < 16; ++r) ysq += y[r] * y[r]; }
    }
    ysq += __shfl_xor(ysq, 32);
    const float scq = B_QSCALE / sqrtf(ysq * (1.0f / 256.0f) + EPS);
    float l = 0.f;
    f32x16 o[4];
#pragma unroll
    for (int dt = 0; dt < 4; ++dt) o[dt] = (f32x16){};
    u32x2 mw = *(const u32x2*)(selp), mwn = mw;
    DMA_WAIT(); __syncthreads();
#pragma unroll 1
    for (int jt = 0; jt < nt; ++jt) {
        LAS unsigned char* cur = lds + (jt & 1) * BUFB; LAS unsigned char* nxt = lds + ((jt + 1) & 1) * BUFB;
        if (jt + 1 < nt) { if (!(abl & 1)) tile_dma(Kg + (size_t)(jt + 1) * 64 * 512, Vg + (size_t)(jt + 1) * 64 * 512, nxt, wid, lane); mwn = *(const u32x2*)(selp + 2 * (jt + 1)); }
        if (64 * jt + 63 + 113 <= qrow0 && !(abl & 2)) {
            const LAS unsigned char* kb0 = cur + (r32 >> 2) * G4 + j4 * 256; const float bf = lut[127];
            f32x16 sa = (f32x16){}, sb = (f32x16){};
#pragma unroll
            for (int s = 0; s < 8; ++s) { const bf16x8 kf = *(const LAS bf16x8*)(kb0 + xch(2 * s + hi, j4)); sa = MFMA32(kf, qf[s], sa); }
#pragma unroll
            for (int s = 0; s < 8; ++s) { const bf16x8 kf = *(const LAS bf16x8*)(kb0 + 8 * G4 + xch(2 * s + hi, j4)); sb = MFMA32(kf, qf[s], sb); }
            const int mha = (int)(mw.x >> (4 * hi)), mhb = (int)(mw.y >> (4 * hi));
#pragma unroll
            for (int r = 0; r < 16; ++r) { const float e = __builtin_amdgcn_exp2f(sa[r] * scq + bf); sa[r] = __uint_as_float(__float_as_uint(e) & (unsigned)__builtin_amdgcn_sbfe(mha, (r & 3) + 8 * (r >> 2), 1)); l += sa[r]; }
            { const bf16x8 pa0 = pack8(sa, 0), pa1 = pack8(sa, 1); const LAS unsigned char* vb = cur + TILEB;
#pragma unroll
              for (int dt = 0; dt < 4; ++dt) { const bf16x8 v0 = vfrag(vb, lane, 0, 0, dt), v1 = vfrag(vb, lane, 0, 1, dt); o[dt] = MFMA32(v0, pa0, o[dt]); o[dt] = MFMA32(v1, pa1, o[dt]); } }
#pragma unroll
            for (int r = 0; r < 16; ++r) { const float e = __builtin_amdgcn_exp2f(sb[r] * scq + bf); sb[r] = __uint_as_float(__float_as_uint(e) & (unsigned)__builtin_amdgcn_sbfe(mhb, (r & 3) + 8 * (r >> 2), 1)); l += sb[r]; }
            { const bf16x8 pa0 = pack8(sb, 0), pa1 = pack8(sb, 1); const LAS unsigned char* vb = cur + TILEB + 8 * G4;
#pragma unroll
              for (int dt = 0; dt < 4; ++dt) { const bf16x8 v0 = vfrag(vb, lane, 0, 0, dt), v1 = vfrag(vb, lane, 0, 1, dt); o[dt] = MFMA32(v0, pa0, o[dt]); o[dt] = MFMA32(v1, pa1, o[dt]); } }
        } else
        if (jt <= wlast && !(abl & 2)) {
#pragma unroll
            for (int kb = 0; kb < 2; ++kb) { const int kr0 = 64 * jt + 32 * kb;
                if (kr0 <= qrow0 + 31) {
                    const LAS unsigned char* kbase = cur + (8 * kb + (r32 >> 2)) * G4 + j4 * 256;
                    f32x16 s1 = (f32x16){};
#pragma unroll
                    for (int s = 0; s < 8; ++s) { const bf16x8 kf = *(const LAS bf16x8*)(kbase + xch(2 * s + hi, j4)); s1 = MFMA32(kf, qf[s], s1); }
                    const int mh = (int)((kb ? mw.y : mw.x) >> (4 * hi));
                    const bool interior = (kr0 + 31 + 113 <= qrow0);
                    if (interior) { const float bf = lut[127];
#pragma unroll
                        for (int r = 0; r < 16; ++r) { const float e = __builtin_amdgcn_exp2f(s1[r] * scq + bf); s1[r] = __uint_as_float(__float_as_uint(e) & (unsigned)__builtin_amdgcn_sbfe(mh, (r & 3) + 8 * (r >> 2), 1)); } }
                    else {
#pragma unroll
                        for (int r = 0; r < 16; ++r) { const int kr = kr0 + crow(r, hi), n = qrow - kr; const int idx = n < 0 ? 0 : (n > 127 ? 127 : n);
                            const float e = __builtin_amdgcn_exp2f(s1[r] * scq + lut[idx]); s1[r] = __uint_as_float(__float_as_uint(e) & (unsigned)__builtin_amdgcn_sbfe(mh, (r & 3) + 8 * (r >> 2), 1)); } }
#pragma unroll
                    for (int r = 0; r < 16; ++r) l += s1[r];
                    const bf16x8 pa0 = pack8(s1, 0), pa1 = pack8(s1, 1);
                    const LAS unsigned char* vb = cur + TILEB + kb * (8 * G4);
#pragma unroll
                    for (int dt = 0; dt < 4; ++dt) { const bf16x8 v0 = vfrag(vb, lane, 0, 0, dt), v1 = vfrag(vb, lane, 0, 1, dt);
                        o[dt] = MFMA32(v0, pa0, o[dt]); o[dt] = MFMA32(v1, pa1, o[dt]); }
                } }
        }
        mw = mwn;
        DMA_WAIT(); __syncthreads();
    }
    l += __shfl_xor(l, 32);
    const float il = 1.0f / l;
    if (!(abl & 256)) store_rows_via_lds(o, il, nullptr, lds + wid * (32 * TROW), (bf16*)a->out + (gq - r32) * 1024 + 512 + head * 128, lane);
    __syncthreads();
}
__device__ __forceinline__ unsigned lanes_below(unsigned long long m) { return __builtin_amdgcn_mbcnt_hi((unsigned)(m >> 32), __builtin_amdgcn_mbcnt_lo((unsigned)m, 0u)); }
#define DPP_STEP(OP, v, ctrl, rmask, ident) { const int t_ = __builtin_amdgcn_update_dpp((int)(ident), (int)(v), (ctrl), (rmask), 0xf, false); v = OP(v, (decltype(v))t_); }
__device__ __forceinline__ unsigned umax2(unsigned a, unsigned b) { return a > b ? a : b; }
__device__ __forceinline__ unsigned umin2(unsigned a, unsigned b) { return a < b ? a : b; }
__device__ __forceinline__ int iadd2(int a, int b) { return a + b; }
__device__ __forceinline__ unsigned wave_umax(unsigned v) { DPP_STEP(umax2, v, 0x111, 0xf, 0u) DPP_STEP(umax2, v, 0x112, 0xf, 0u) DPP_STEP(umax2, v, 0x114, 0xf, 0u) DPP_STEP(umax2, v, 0x118, 0xf, 0u) DPP_STEP(umax2, v, 0x142, 0xa, 0u) DPP_STEP(umax2, v, 0x143, 0xc, 0u)
    return (unsigned)__builtin_amdgcn_readlane((int)v, 63); }
__device__ __forceinline__ unsigned wave_umin(unsigned v) { DPP_STEP(umin2, v, 0x111, 0xf, 0xffffffffu) DPP_STEP(umin2, v, 0x112, 0xf, 0xffffffffu) DPP_STEP(umin2, v, 0x114, 0xf, 0xffffffffu) DPP_STEP(umin2, v, 0x118, 0xf, 0xffffffffu) DPP_STEP(umin2, v, 0x142, 0xa, 0xffffffffu) DPP_STEP(umin2, v, 0x143, 0xc, 0xffffffffu)
    return (unsigned)__builtin_amdgcn_readlane((int)v, 63); }
__device__ __forceinline__ int wave_isum(int v) { DPP_STEP(iadd2, v, 0x111, 0xf, 0) DPP_STEP(iadd2, v, 0x112, 0xf, 0) DPP_STEP(iadd2, v, 0x114, 0xf, 0) DPP_STEP(iadd2, v, 0x118, 0xf, 0) DPP_STEP(iadd2, v, 0x142, 0xa, 0) DPP_STEP(iadd2, v, 0x143, 0xc, 0)
    return __builtin_amdgcn_readlane(v, 63); }
#define WRITELANE(src, l, old) do { const int s__ = __builtin_amdgcn_readfirstlane(src); asm volatile("s_nop 3\n\tv_writelane_b32 %0, %1, %2" : "+v"(old) : "s"(s__), "n"(l)); } while (0)
template <int NI> __device__ __forceinline__ void select8(unsigned char* ws, const float* sc, int b, int q0, int wid, int lane, int abl, LAS unsigned* slot) {
    unsigned raw[NI];
    { const unsigned* srow = (const unsigned*)(sc + (size_t)(8 * wid) * SCP);
#pragma unroll
      for (int i = 0; i < NI; ++i) raw[i] = __hip_atomic_load(srow + 64 * i + lane, __ATOMIC_RELAXED, __HIP_MEMORY_SCOPE_AGENT); }
#pragma unroll 1
    for (int qq = 0; qq < 8; ++qq) { const int ql = 8 * wid + qq, t = q0 + ql, qrow = 64 + t, nvalid = t + 17;
        unsigned w[NI];
#pragma unroll
        for (int i = 0; i < NI; ++i) { const int kr = 64 * i + lane; w[i] = ((kr >= 48) && (kr <= qrow)) ? raw[i] : 0u; }
        if (qq < 7 && !(abl & 64)) { const unsigned* srow = (const unsigned*)(sc + (size_t)(ql + 1) * SCP);
#pragma unroll
            for (int i = 0; i < NI; ++i) raw[i] = __hip_atomic_load(srow + 64 * i + lane, __ATOMIC_RELAXED, __HIP_MEMORY_SCOPE_AGENT); }
        unsigned thr = 0u; int quota = 0;
        if (nvalid > 256 && !(abl & 16)) {
            unsigned mn = 0x7fffffffu, mx = 0u;
#pragma unroll
            for (int i = 0; i < NI; ++i) { mx = w[i] > mx ? w[i] : mx; const unsigned v = w[i] - 1u; mn = v < mn ? v : mn; }
            mx = wave_umax(mx); mn = wave_umin(mn) + 1u;
            unsigned lo = mn, hi = mx + 1u; int chi = 0, clo = nvalid; bool exact = false;
#pragma unroll 1
            while (hi - lo > 1u && clo - chi > 64) { const unsigned cand = lo + ((hi - lo) >> 1);
                unsigned acc0 = 0u, acc1 = 0u;
#pragma unroll
                for (int i = 0; i < NI; ++i) { const unsigned d = w[i] - cand; if (i & 1) acc1 = __builtin_amdgcn_alignbit(acc1, d, 31); else acc0 = __builtin_amdgcn_alignbit(acc0, d, 31); }
                const int lt = wave_isum(__popc(acc0) + __popc(acc1));
                const int cnt = 64 * NI - lt;
                if (cnt == 256) { lo = cand; exact = true; break; }
                if (cnt > 256) { lo = cand; clo = cnt; } else { hi = cand; chi = cnt; } }
            if (!exact && hi - lo > 1u) {
                slot[lane] = 0u;
                int base = 0; const unsigned span = hi - lo; const int chi0 = chi;
#pragma unroll
                for (int i = 0; i < NI; ++i) { const bool inb = (w[i] - lo) < span;
                    const unsigned long long mk = __ballot(inb);
                    const unsigned p = __builtin_amdgcn_mbcnt_hi((unsigned)(mk >> 32), __builtin_amdgcn_mbcnt_lo((unsigned)mk, (unsigned)base));
                    if (inb) slot[p] = w[i];
                    base += __popcll(mk); }
                LDS_WAIT();
                const unsigned cw = slot[lane];
#pragma unroll 1
                while (hi - lo > 1u) { const unsigned cand = lo + ((hi - lo) >> 1);
                    const int cnt = chi0 + __popcll(__ballot(cw >= cand));
                    if (cnt == 256) { lo = cand; exact = true; break; }
                    if (cnt > 256) lo = cand; else { hi = cand; chi = cnt; } }
                LDS_WAIT(); }
            if (exact) { thr = lo - 1u; quota = 0; } else { thr = lo; quota = 256 - chi; }
        }
        int wlo = 0, whi = 0;
        if (!(abl & 32)) {
            if (quota == 0) {
#pragma unroll
                for (int i = 0; i < NI; ++i) { const unsigned long long bs = __ballot(w[i] > thr);
                    WRITELANE((int)(unsigned)bs, i, wlo); WRITELANE((int)(unsigned)(bs >> 32), i, whi); } }
            else { int tiebase = 0;
#pragma unroll
                for (int i = 0; i < NI; ++i) { const bool gt = w[i] > thr, eq = (w[i] == thr);
                    const unsigned long long be = __ballot(eq); const int rank = tiebase + (int)lanes_below(be);
                    const unsigned long long bs = __ballot(gt || (eq && rank < quota));
                    WRITELANE((int)(unsigned)bs, i, wlo); WRITELANE((int)(unsigned)(bs >> 32), i, whi);
                    tiebase += __popcll(be); } } }
        if (lane < 33) { u32x2 w2; w2.x = (unsigned)wlo; w2.y = (unsigned)whi; *(u32x2*)((unsigned*)(ws + WS_SEL) + ((size_t)b * SEQ + t) * SELW + 2 * lane) = w2; }
    }
}
__device__ __forceinline__ void index_unit(const Frame& F, CArgsP a, int b, int j64, int abl) {
    unsigned char* ws = a->ws; const int lane = F.lane, wid = F.wave, r32 = lane & 31, hi = lane >> 5;
    float* sc = (float*)(ws + WS_SCR) + (size_t)blockIdx.x * 64 * SCP;
    const int q0 = 64 * j64;
    {
        const bf16* ip = (const bf16*)(ws + WS_IQ) + ((size_t)b * SEQ + q0) * 512;
#pragma unroll
        for (int i = 0; i < 8; ++i) { const int c = F.tid + 512 * i, row = c >> 6, ch = c & 63; *(LAS u32x4*)(F.lds + 1040 * row + 16 * ch) = *(const u32x4*)(ip + (size_t)row * 512 + ch * 8); }
    }
    __syncthreads();
    {
        const int q = F.tid >> 3, d0 = 8 * (F.tid & 7); const float* wp = (const float*)(ws + WS_IW) + ((size_t)b * SEQ + q0 + q) * 8;
        const f32x4 w0 = *(const f32x4*)wp, w1 = *(const f32x4*)(wp + 4); const float wq[8] = {w0[0], w0[1], w0[2], w0[3], w1[0], w1[1], w1[2], w1[3]};
        float t[8] = {0.f, 0.f, 0.f, 0.f, 0.f, 0.f, 0.f, 0.f};
#pragma unroll
        for (int h = 0; h < 8; ++h) { const u32x4 v = *(const LAS u32x4*)(F.lds + 1040 * q + 128 * h + 2 * d0); const float wh = 0.5f * wq[h];
            t[0] += wh * __uint_as_float(v.x << 16); t[1] += wh * __uint_as_float(v.x & 0xffff0000u); t[2] += wh * __uint_as_float(v.y << 16); t[3] += wh * __uint_as_float(v.y & 0xffff0000u);
            t[4] += wh * __uint_as_float(v.z << 16); t[5] += wh * __uint_as_float(v.z & 0xffff0000u); t[6] += wh * __uint_as_float(v.w << 16); t[7] += wh * __uint_as_float(v.w & 0xffff0000u); }
        u32x4 hi4, lo4; unsigned* hp = (unsigned*)&hi4; unsigned* lp = (unsigned*)&lo4;
#pragma unroll
        for (int j = 0; j < 4; ++j) { const unsigned hb = pk2(t[2 * j], t[2 * j + 1]); hp[j] = hb; lp[j] = pk2(t[2 * j] - __uint_as_float(hb << 16), t[2 * j + 1] - __uint_as_float(hb & 0xffff0000u)); }
        *(LAS u32x4*)(F.lds + LDS_QT + 272 * q + 2 * d0) = hi4; *(LAS u32x4*)(F.lds + LDS_QT + 272 * q + 128 + 2 * d0) = lo4;
    }
    __syncthreads();
    if (!(abl & 4)) {
        const int qi = wid & 1, kbq = wid >> 1, qrow0 = 64 + q0 + 32 * qi; const size_t gq = (size_t)b * SEQ + q0 + 32 * qi + r32;
        float wv[8];
        { const f32x4 w0 = *(const f32x4*)((const float*)(ws + WS_IW) + gq * 8), w1 = *(const f32x4*)((const float*)(ws + WS_IW) + gq * 8 + 4);
          wv[0] = 0.5f * w0[0]; wv[1] = 0.5f * w0[1]; wv[2] = 0.5f * w0[2]; wv[3] = 0.5f * w0[3]; wv[4] = 0.5f * w1[0]; wv[5] = 0.5f * w1[1]; wv[6] = 0.5f * w1[2]; wv[7] = 0.5f * w1[3]; }
        const LAS unsigned char* qtl = F.lds + LDS_QT + 272 * (32 * qi + r32) + 16 * hi;
        const LAS unsigned char* iql = F.lds + 1040 * (32 * qi + r32) + 16 * hi;
        const int ng = (q0 + 128 + 127) >> 7;
        const bf16* ikb = (const bf16*)(ws + WS_IK) + (size_t)b * KROWS * 64 + (size_t)r32 * 64 + 8 * hi;
        LAS unsigned char* stg = F.lds + 66560 + wid * 4608;
        bf16x8 ikn[4];
#pragma unroll
        for (int s = 0; s < 4; ++s) ikn[s] = *(const bf16x8*)(ikb + (size_t)(32 * kbq) * 64 + 16 * s);
        constexpr int NRH = 8;
        bf16x8 qtr[8], qr[NRH][4];
#pragma unroll
        for (int s = 0; s < 4; ++s) { qtr[s] = *(const LAS bf16x8*)(qtl + 32 * s); qtr[4 + s] = *(const LAS bf16x8*)(qtl + 128 + 32 * s); }
#pragma unroll
        for (int h = 0; h < NRH; ++h)
#pragma unroll
            for (int s = 0; s < 4; ++s) qr[h][s] = *(const LAS bf16x8*)(iql + 128 * h + 32 * s);
#pragma unroll 1
        for (int g = 0; g < ng; ++g) { const int kr0 = 128 * g + 32 * kbq;
            if (kr0 > qrow0 + 31) break;
            bf16x8 ikf[4];
#pragma unroll
            for (int s = 0; s < 4; ++s) ikf[s] = ikn[s];
            { const int krn = kr0 + 128 <= KROWS - 32 ? kr0 + 128 : kr0;
#pragma unroll
              for (int s = 0; s < 4; ++s) ikn[s] = *(const bf16x8*)(ikb + (size_t)krn * 64 + 16 * s); }
            f32x16 score = (f32x16){};
            __builtin_amdgcn_s_setprio(1);
#pragma unroll
            for (int s = 0; s < 4; ++s) score = MFMA32(ikf[s], qtr[s], score);
#pragma unroll
            for (int s = 0; s < 4; ++s) score = MFMA32(ikf[s], qtr[4 + s], score);
#pragma unroll
            for (int h = 0; h < 8; ++h) { f32x16 acc = (f32x16){};
#pragma unroll
                for (int s = 0; s < 4; ++s) { bf16x8 qf; if (h < NRH) qf = qr[h < NRH ? h : 0][s]; else qf = *(const LAS bf16x8*)(iql + 128 * h + 32 * s); acc = MFMA32(ikf[s], qf, acc); }
#pragma unroll
                for (int r = 0; r < 16; ++r) { float sn = __builtin_fmaf(wv[h], __builtin_fabsf(acc[r]), score[r]); asm("" : "+v"(sn)); score[r] = sn; }
                if (h & 1) __builtin_amdgcn_sched_barrier(0); }
            __builtin_amdgcn_s_setprio(0);
#pragma unroll
            for (int g4 = 0; g4 < 4; ++g4) { u32x4 kv;
#pragma unroll
                for (int e = 0; e < 4; ++e) { const unsigned bits = __float_as_uint(score[4 * g4 + e] + 0.0f); kv[e] = (bits ^ ((unsigned)((int)bits >> 31) | 0x80000000u)) >> 1; }
                *(LAS u32x4*)(stg + r32 * 144 + 32 * g4 + 16 * hi) = kv; }
            LDS_WAIT();
#pragma unroll
            for (int i = 0; i < 4; ++i) { const int row = 8 * i + (lane >> 3), ch = lane & 7; const u32x4 v = *(const LAS u32x4*)(stg + row * 144 + 16 * ch);
                *(u32x4*)(sc + (size_t)(32 * qi + row) * SCP + kr0 + 4 * ch) = v; }
            LDS_WAIT();
        }
    }
    VM_WAIT(); __syncthreads();
    if (!(abl & 8)) { const int ni = ((64 + q0 + 8 * wid + 7) >> 6) + 1;
      switch ((ni - 2) >> 2) {
        case 0: select8<5>(ws, sc, b, q0, wid, lane, abl, (LAS unsigned*)(F.lds + 66560 + wid * 4608)); break;
        case 1: select8<9>(ws, sc, b, q0, wid, lane, abl, (LAS unsigned*)(F.lds + 66560 + wid * 4608)); break;
        case 2: select8<13>(ws, sc, b, q0, wid, lane, abl, (LAS unsigned*)(F.lds + 66560 + wid * 4608)); break;
        case 3: select8<17>(ws, sc, b, q0, wid, lane, abl, (LAS unsigned*)(F.lds + 66560 + wid * 4608)); break;
        case 4: select8<21>(ws, sc, b, q0, wid, lane, abl, (LAS unsigned*)(F.lds + 66560 + wid * 4608)); break;
        case 5: select8<25>(ws, sc, b, q0, wid, lane, abl, (LAS unsigned*)(F.lds + 66560 + wid * 4608)); break;
        case 6: select8<29>(ws, sc, b, q0, wid, lane, abl, (LAS unsigned*)(F.lds + 66560 + wid * 4608)); break;
        default: select8<33>(ws, sc, b, q0, wid, lane, abl, (LAS unsigned*)(F.lds + 66560 + wid * 4608)); break;
      } }
    __syncthreads();
}

struct KvOrder : pg8::StaticOrder { __host__ __device__ int arow(int pm) const { return (pm >> 3) * KROWS + 64 + (pm & 7) * 256; } };
struct AblOrder : pg8::StaticOrder { int abl;
    __device__ bool next(int i, pg8::Unit& u) const { const bool r = pg8::StaticOrder::next(i, u); if (abl & 2) u.pm = 0; if (abl & 4) u.pn = 0; return r; } };
#ifndef PH
#define PH 0xFFFF
#endif
#ifndef DUP
#define DUP 0
#endif
#ifndef TIMING_KNOBS
#define TIMING_KNOBS 0
#endif
#if TIMING_KNOBS
#define PHASE(bit) _Pragma("unroll 1") for (int rep_ = 0, nrep_ = ((PH & (bit)) ? 1 + ((get_args()->dup & (bit)) ? 1 : 0) : 0); rep_ < nrep_; ++rep_)
#define ABL() ((nrep_ == 2 && rep_ == 0) ? (get_args()->dup >> 16) : 0)
#else
#define PHASE(bit) if (PH & (bit))
#define ABL() 0
#endif
#ifndef USE_XCD
#define USE_XCD 1
#endif
#if USE_XCD
#define GRID_SYNC() xcd_barrier(xbar)
#else
#define GRID_SYNC() grid.sync()
#endif
__global__ void __launch_bounds__(512, 2) fwd_megakernel(Args args_by_value) {
    extern __shared__ __attribute__((aligned(16))) unsigned char lds_raw[];
#if !USE_XCD
    cg::grid_group grid = cg::this_grid();
#endif
    LAS unsigned char* const lds0 = (LAS unsigned char*)lds_raw;
    const int wave_s = __builtin_amdgcn_readfirstlane((int)(threadIdx.x >> 6));
#if USE_XCD
    if (threadIdx.x < 4) ((LAS unsigned*)(lds0 + LDS_MISC))[threadIdx.x] = 0u;
    __syncthreads();
    XcdBarrier xbar = xcd_barrier_post((unsigned*)(get_args()->ws + WS_CTL), (volatile LAS unsigned*)(lds0 + LDS_MISC)); xbar.w = wave_s;
#endif
#define PHASE_VARS const Frame F = make_frame(lds0, wave_s); CArgsP a = get_args(); unsigned char* ws = a->ws; float* out = a->out; pg8::bf16_t* HB = (pg8::bf16_t*)(ws + WS_HB); pg8::bf16_t* ACT = (pg8::bf16_t*)(ws + WS_ACT); float* SSB = (float*)(ws + WS_SS); \
    PG8_LAS unsigned char* ring = (PG8_LAS unsigned char*)F.lds; (void)out; (void)HB; (void)ACT; (void)SSB; (void)ring
    PHASE(1) { PHASE_VARS; p0_prologue(F, a); }
    GRID_SYNC();
    PHASE(2) { PHASE_VARS; meta_p1(F, a);
      pg8::Gemm g{HB, (const pg8::bf16_t*)(ws + WS_WGU1), MX, NGU, DM}; AblOrder S; S.init(MX, NGU, F.G, (int)blockIdx.x); S.abl = ABL(); pg8::EpiGU<F8_D1> E{(unsigned char*)ACT, SSB, ABL(), 1.0f};
      pg8::gemm_phase<pg8::EpiGU<F8_D1>, AblOrder, true, true>(ring, g, S, E, wave_s); }
    GRID_SYNC();
    PHASE(4) { PHASE_VARS; meta_p2(F, a);
      pg8::Gemm g{ACT, (const pg8::bf16_t*)(ws + WS_WD1), MX, DM, F8_D1 ? FF / 2 : FF}; pg8::StaticOrder S; S.init(MX, DM, F.G, (int)blockIdx.x); pg8::EpiResB<false, true> E{HB, HB, nullptr, SSB, F8_D1 ? 0.5f / (ACT_SCALE * WD_SCALE) : 0.5f};
      pg8::gemm_phase<pg8::EpiResB<false, true>, pg8::StaticOrder, true, true, F8_D1>(ring, g, S, E, wave_s); }
    GRID_SYNC();
    PHASE(8) { PHASE_VARS; meta_p3(F, a);
      pg8::Gemm g{HB, (const pg8::bf16_t*)(ws + WS_WIN), MX, NINP, DM}; pg8::StaticOrder S; S.init(MX, NINP, F.G, (int)blockIdx.x);
      pg8::EpiIn E{(pg8::bf16_t*)(ws + WS_QA), (pg8::bf16_t*)(ws + WS_KA), (pg8::bf16_t*)(ws + WS_VA), (pg8::bf16_t*)(ws + WS_QB), (pg8::bf16_t*)(ws + WS_C), (pg8::bf16_t*)(ws + WS_IQ), (pg8::bf16_t*)(ws + WS_IK),
                   (float*)(ws + WS_IW), SSB, a->in[9], a->in[10], a->in[16], (PG8_LAS float*)(F.lds + LDS_XCH)};
      pg8::gemm_phase<pg8::EpiIn, pg8::StaticOrder, true, true>(ring, g, S, E, wave_s); }
    GRID_SYNC();
    PHASE(16) { PHASE_VARS; meta_p4(F, a);
      int kkv = 256; asm volatile("" : "+s"(kkv)); pg8::Gemm g{(const pg8::bf16_t*)(ws + WS_C), (const pg8::bf16_t*)(ws + WS_WKV), MX, 1024, kkv}; KvOrder S; S.init(MX, 1024, F.G, (int)blockIdx.x);
      pg8::EpiKV E{(pg8::bf16_t*)(ws + WS_KK), (pg8::bf16_t*)(ws + WS_VV)};
      pg8::gemm_phase<pg8::EpiKV, KvOrder, true, true>(ring, g, S, E, wave_s); }
    __syncthreads();
    PHASE(32) { _Pragma("unroll 1") for (int k = 0; k < 2; ++k) { const Frame F = make_frame(lds0, wave_s); CArgsP a = get_args(); const int b = F.vcu >> 4, s = F.vcu & 15; index_unit(F, a, b, k ? 31 - s : s, ABL()); } }
    PHASE(64) { float lam; { const int ln = pg8::lane_id(); CArgsP a = get_args(); const float d1 = wave_sum(a->in[11][ln] * a->in[12][ln]), d2 = wave_sum(a->in[13][ln] * a->in[14][ln]);
        lam = __uint_as_float((unsigned)__builtin_amdgcn_readfirstlane((int)__float_as_uint(__expf(d1) - __expf(d2) + LAM_INIT))); }
      _Pragma("unroll 1") for (int k = 0; k < 2; ++k) { const Frame F = make_frame(lds0, wave_s); CArgsP a = get_args(); const int bh = F.vcu >> 2, s = F.vcu & 3; attnA_unit(F, a, bh >> 2, bh & 3, k ? 7 - s : s, lam, ABL()); } }
    GRID_SYNC();
    PHASE(128) { _Pragma("unroll 1") for (int k = 0; k < 2; ++k) { const Frame F = make_frame(lds0, wave_s); CArgsP a = get_args(); const int bh = F.vcu >> 2, s = F.vcu & 3; attnB_unit(F, a, bh >> 2, bh & 3, k ? 7 - s : s, ABL()); } }
    GRID_SYNC();
    PHASE(256) { PHASE_VARS; pg8::Gemm g{(const pg8::bf16_t*)out, (const pg8::bf16_t*)(ws + WS_WOUT), MX, DM, DM}; pg8::StaticOrder S; S.init(MX, DM, F.G, (int)blockIdx.x); pg8::EpiResB<false, true, F8_G2> E{HB, (pg8::bf16_t*)(ws + WS_H2B), nullptr, SSB, 1.0f};
      pg8::gemm_phase<pg8::EpiResB<false, true, F8_G2>, pg8::StaticOrder, true, true>(ring, g, S, E, wave_s); }
    GRID_SYNC();
    PHASE(512) { PHASE_VARS; pg8::Gemm g{(const pg8::bf16_t*)(ws + (F8_G2 ? WS_H2Q : WS_H2B)), (const pg8::bf16_t*)(ws + WS_WGU2), MX, NGU, F8_G2 ? DM / 2 : DM}; pg8::StaticOrder S; S.init(MX, NGU, F.G, (int)blockIdx.x);
      pg8::EpiGU<F8_D2> E{(unsigned char*)ACT, SSB, ABL(), F8_G2 ? 1.0f / (H_SCALE * GU_SCALE) : 1.0f};
      pg8::gemm_phase<pg8::EpiGU<F8_D2>, pg8::StaticOrder, true, true, F8_G2>(ring, g, S, E, wave_s); }
    GRID_SYNC();
    PHASE(1024) { PHASE_VARS; pg8::Gemm g{ACT, (const pg8::bf16_t*)(ws + WS_WD2), MX, DM, F8_D2 ? FF / 2 : FF}; pg8::StaticOrder S; S.init(MX, DM, F.G, (int)blockIdx.x); pg8::EpiResB<true, false> E{(const pg8::bf16_t*)(ws + WS_H2B), nullptr, out, nullptr, F8_D2 ? 0.5f / (ACT_SCALE * WD_SCALE) : 0.5f};
      pg8::gemm_phase<pg8::EpiResB<true, false>, pg8::StaticOrder, true, true, F8_D2>(ring, g, S, E, wave_s); }
}

extern "C" void kernel_launch(void* const* d_in, const int* in_sizes, int n_in, void* d_out, int out_size, void* d_ws, size_t ws_size, hipStream_t stream) {
    static int grid = 0;
    if (grid == 0) {
        if (n_in != 25 || out_size != MX * DM || ws_size < WS_END) { fprintf(stderr, "kernel_launch: unexpected shapes (n_in %d out %d ws %zu)\n", n_in, out_size, ws_size); grid = -1; return; }
        int dev = 0, cus = 0, per_cu = 0;
        if (hipGetDevice(&dev) != hipSuccess || hipDeviceGetAttribute(&cus, hipDeviceAttributeMultiprocessorCount, dev) != hipSuccess) { grid = -1; return; }
        if (hipFuncSetAttribute((const void*)fwd_megakernel, hipFuncAttributeMaxDynamicSharedMemorySize, LDS_BYTES) != hipSuccess) { fprintf(stderr, "kernel_launch: hipFuncSetAttribute failed\n"); grid = -1; return; }
        if (hipOccupancyMaxActiveBlocksPerMultiprocessor(&per_cu, (const void*)fwd_megakernel, 512, LDS_BYTES) != hipSuccess || per_cu < 1) { fprintf(stderr, "kernel_launch: occupancy query says %d blocks per CU\n", per_cu); (void)hipGetLastError(); grid = -1; return; }
        grid = cus;
        if (grid != 256) fprintf(stderr, "kernel_launch: note: %d CUs\n", grid);
    }
    if (grid < 0) return;
    (void)hipMemsetAsync((char*)d_ws + WS_CTL, 0, 16384, stream);
    Args a{};
    for (int i = 0; i < 25; ++i) a.in[i] = (const float*)d_in[i];
    a.out = (float*)d_out; a.ws = (unsigned char*)d_ws; a.dup = DUP; a.pad = 0;
    void* args[] = {&a};
#ifndef PLAIN_LAUNCH
#define PLAIN_LAUNCH 0
#endif
#if PLAIN_LAUNCH
    (void)args; hipLaunchKernelGGL(fwd_megakernel, dim3(grid), dim3(512), LDS_BYTES, stream, a); hipError_t e = hipPeekAtLastError();
#else
    hipError_t e = hipLaunchCooperativeKernel((const void*)fwd_megakernel, dim3(grid), dim3(512), args, LDS_BYTES, stream);
#endif
    if (e != hipSuccess) fprintf(stderr, "kernel_launch: cooperative launch failed: %s\n", hipGetErrorString(e));
}
```
